# Optimizing an MI355X kernel written in HIP

```python
import math
import jax, jax.numpy as jnp
from jax import lax
import numpy as np

D_MODEL = 1024
BATCH = 8
SEQ = 2048
DEPTH = 4

D_MIX = D_MODEL
N_MIXERS = 4
W_GRP = D_MIX // N_MIXERS
SGU_HEADS = 4
SGU_HEAD_DIM = W_GRP // SGU_HEADS
CHUNK = 128
POOL_WINDOWS = (2, 4, 8, 16)
POOL_GROUPS = len(POOL_WINDOWS)
POOL_GROUP_DIM = W_GRP // POOL_GROUPS
CONV_WIDTH = 3
S5_GROUP_CH = 16
S5_GROUPS = W_GRP // S5_GROUP_CH
S5_STATE = 64
P_IN = 2 * W_GRP + W_GRP + 3 * W_GRP + W_GRP
D_FF = ((8 * D_MODEL // 3 + 255) // 256) * 256
N_ADA = 9
EPS = 1e-6

kernel_name = "hybrid_parallel_mixer_trunk"


def rmsnorm(x, g):
    xf = x.astype(jnp.float32)
    y = xf * lax.rsqrt(jnp.mean(xf * xf, axis=-1, keepdims=True) + EPS)
    return (y * g.astype(jnp.float32)).astype(x.dtype)


def group_rmsnorm(y, g):
    b, s, _ = y.shape
    yf = y.astype(jnp.float32).reshape(b, s, N_MIXERS, W_GRP)
    yf = yf * lax.rsqrt(jnp.mean(yf * yf, axis=-1, keepdims=True) + EPS)
    return (yf.reshape(b, s, D_MIX) * g.astype(jnp.float32)).astype(y.dtype)


def modulate(h, shift, scale):
    return h * (1.0 + scale) + shift


def swiglu(h, w_in, w_out):
    a, b = jnp.split(h @ w_in, 2, axis=-1)
    return (jax.nn.silu(a) * b) @ w_out


def sgu_mixer(z, w_s, b_s):
    bsz, s, _ = z.shape
    z = jax.nn.gelu(z)
    u, v = jnp.split(z, 2, axis=-1)
    v = v.reshape(bsz, s // CHUNK, CHUNK, SGU_HEADS, SGU_HEAD_DIM)
    vf = v.astype(jnp.float32)
    mu = jnp.mean(vf, axis=-1, keepdims=True)
    var = jnp.mean(jnp.square(vf - mu), axis=-1, keepdims=True)
    v = ((vf - mu) * lax.rsqrt(var + EPS)).astype(z.dtype)
    mask = jnp.tril(jnp.ones((CHUNK, CHUNK), dtype=w_s.dtype))
    mixed = jnp.einsum('hts,bnshd->bnthd', w_s * mask, v)
    mixed = mixed + b_s.T[None, None, :, :, None]
    return u * mixed.reshape(bsz, s, W_GRP)


def pool_mixer(z, w_p, scale):
    bsz, s, _ = z.shape
    zf = z.astype(jnp.float32).reshape(bsz, s, POOL_GROUPS, POOL_GROUP_DIM)
    cs = jnp.concatenate([jnp.zeros_like(zf[:, :1]), jnp.cumsum(zf, axis=1)], axis=1)
    t = jnp.arange(s)
    win = jnp.array(POOL_WINDOWS, dtype=jnp.int32)
    lo = jnp.maximum(t[:, None] + 1 - win[None, :], 0)
    cnt = (t[:, None] + 1 - lo).astype(jnp.float32)
    lower = cs[:, lo, jnp.arange(POOL_GROUPS)[None, :]]
    mean = (cs[:, 1:] - lower) / cnt[None, :, :, None]
    p = (mean - zf).astype(z.dtype)
    out = jnp.einsum('bsgc,gcd->bsgd', p, w_p).reshape(bsz, s, W_GRP)
    return out * scale


def conv_mixer(z, conv_w):
    bg, cg, xh = jnp.split(z, 3, axis=-1)
    y = cg * xh
    y = lax.conv_general_dilated(
        y, conv_w[:, None, :], window_strides=(1,), padding=[(CONV_WIDTH - 1, 0)],
        dimension_numbers=('NWC', 'WIO', 'NWC'), feature_group_count=W_GRP)
    return bg * y


def s5_mixer(u, lam_re, lam_im, b_re, b_im, c_re, c_im, d, log_dt, glu_w, glu_b):
    bsz, s, _ = u.shape
    f32 = jnp.float32
    dt = jnp.exp(log_dt.astype(f32))[:, None]
    lre, lim = lam_re.astype(f32), lam_im.astype(f32)
    mag = jnp.exp(lre * dt)
    ang = lim * dt
    a_re, a_im = mag * jnp.cos(ang), mag * jnp.sin(ang)
    nr, ni = a_re - 1.0, a_im
    den = lre * lre + lim * lim
    k_re = (nr * lre + ni * lim) / den
    k_im = (ni * lre - nr * lim) / den
    br, bi = b_re.astype(f32), b_im.astype(f32)
    bb_re = k_re[..., None] * br - k_im[..., None] * bi
    bb_im = k_re[..., None] * bi + k_im[..., None] * br
    uf = u.astype(f32)
    ug = uf.reshape(bsz, s, S5_GROUPS, S5_GROUP_CH)
    bu_re = jnp.einsum('bsgc,gpc->bsgp', ug, bb_re)
    bu_im = jnp.einsum('bsgc,gpc->bsgp', ug, bb_im)
    ar = jnp.broadcast_to(a_re, bu_re.shape)
    ai = jnp.broadcast_to(a_im, bu_re.shape)

    def combine(e1, e2):
        a1r, a1i, b1r, b1i = e1
        a2r, a2i, b2r, b2i = e2
        return (a2r * a1r - a2i * a1i,
                a2r * a1i + a2i * a1r,
                a2r * b1r - a2i * b1i + b2r,
                a2r * b1i + a2i * b1r + b2i)

    _, _, xr, xi = lax.associative_scan(combine, (ar, ai, bu_re, bu_im), axis=1)
    y = (jnp.einsum('gcp,bsgp->bsgc', c_re.astype(f32), xr)
         - jnp.einsum('gcp,bsgp->bsgc', c_im.astype(f32), xi))
    y = y.reshape(bsz, s, W_GRP) + d.astype(f32) * uf
    y = jax.nn.gelu(y).astype(u.dtype)
    return y * jax.nn.sigmoid(y @ glu_w + glu_b)


def setup_inputs(seed: int = 0) -> dict:
    key = jax.random.key(seed)
    ks = jax.random.split(key, 32)
    f32 = jnp.float32
    L, D = DEPTH, D_MODEL

    def nrm(k, shape, scale):
        return jax.random.normal(k, shape, f32) * scale

    def gain(k, shape):
        return 1.0 + 0.05 * jax.random.normal(k, shape, f32)

    lam_im0 = jnp.broadcast_to(math.pi * jnp.arange(S5_STATE, dtype=f32), (L, S5_GROUPS, S5_STATE))
    return {
        "x": nrm(ks[0], (BATCH, SEQ, D), 1.0),
        "c": nrm(ks[1], (BATCH, D), 1.0),
        "ada_w": nrm(ks[2], (L, D, N_ADA * D), 0.5 * D ** -0.5),
        "ada_b": nrm(ks[3], (L, N_ADA * D), 0.01),
        "norm1_g": gain(ks[4], (L, D)),
        "ffn1_w_in": nrm(ks[5], (L, D, 2 * D_FF), D ** -0.5),
        "ffn1_w_out": nrm(ks[6], (L, D_FF, D), D_FF ** -0.5),
        "norm2_g": gain(ks[7], (L, D)),
        "w_mix_in": nrm(ks[8], (L, D, P_IN), D ** -0.5),
        "sgu_w": nrm(ks[9], (L, SGU_HEADS, CHUNK, CHUNK), CHUNK ** -0.5),
        "sgu_b": 1.0 + nrm(ks[10], (L, SGU_HEADS, CHUNK), 0.1),
        "pool_w": nrm(ks[11], (L, POOL_GROUPS, POOL_GROUP_DIM, POOL_GROUP_DIM), POOL_GROUP_DIM ** -0.5),
        "pool_scale": 1.0 + nrm(ks[12], (L, W_GRP), 0.1),
        "conv_w": nrm(ks[13], (L, CONV_WIDTH, W_GRP), CONV_WIDTH ** -0.5),
        "s5_lambda_re": -0.5 + nrm(ks[14], (L, S5_GROUPS, S5_STATE), 0.01),
        "s5_lambda_im": lam_im0 + nrm(ks[15], (L, S5_GROUPS, S5_STATE), 0.01),
        "s5_b_re": nrm(ks[16], (L, S5_GROUPS, S5_STATE, S5_GROUP_CH), (2 * S5_GROUP_CH) ** -0.5),
        "s5_b_im": nrm(ks[17], (L, S5_GROUPS, S5_STATE, S5_GROUP_CH), (2 * S5_GROUP_CH) ** -0.5),
        "s5_c_re": nrm(ks[18], (L, S5_GROUPS, S5_GROUP_CH, S5_STATE), (2 * S5_STATE) ** -0.5),
        "s5_c_im": nrm(ks[19], (L, S5_GROUPS, S5_GROUP_CH, S5_STATE), (2 * S5_STATE) ** -0.5),
        "s5_d": nrm(ks[20], (L, W_GRP), 1.0),
        "s5_log_dt": jax.random.uniform(ks[21], (L, S5_GROUPS), f32, math.log(1e-3), math.log(1e-1)),
        "s5_glu_w": nrm(ks[22], (L, W_GRP, W_GRP), W_GRP ** -0.5),
        "s5_glu_b": nrm(ks[23], (L, W_GRP), 0.01),
        "mix_norm_g": gain(ks[24], (L, D_MIX)),
        "w_mix_out": nrm(ks[25], (L, D_MIX, D), D_MIX ** -0.5),
        "norm3_g": gain(ks[26], (L, D)),
        "ffn2_w_in": nrm(ks[27], (L, D, 2 * D_FF), D ** -0.5),
        "ffn2_w_out": nrm(ks[28], (L, D_FF, D), D_FF ** -0.5),
        "final_norm_g": gain(ks[29], (D,)),
    }


def reference(x, c, ada_w, ada_b, norm1_g, ffn1_w_in, ffn1_w_out, norm2_g, w_mix_in,
              sgu_w, sgu_b, pool_w, pool_scale, conv_w, s5_lambda_re, s5_lambda_im,
              s5_b_re, s5_b_im, s5_c_re, s5_c_im, s5_d, s5_log_dt, s5_glu_w, s5_glu_b,
              mix_norm_g, w_mix_out, norm3_g, ffn2_w_in, ffn2_w_out, final_norm_g):
    c_act = jax.nn.silu(c)
    for l in range(DEPTH):
        cond = (c_act @ ada_w[l] + ada_b[l])[:, None, :]
        sh1, sc1, g1, sh2, sc2, g2, sh3, sc3, g3 = jnp.split(cond, N_ADA, axis=-1)

        h = modulate(rmsnorm(x, norm1_g[l]), sh1, sc1)
        x = x + 0.5 * g1 * swiglu(h, ffn1_w_in[l], ffn1_w_out[l])

        h = modulate(rmsnorm(x, norm2_g[l]), sh2, sc2)
        z = h @ w_mix_in[l]
        za, zb, zc, zd = jnp.split(z, [2 * W_GRP, 3 * W_GRP, 6 * W_GRP], axis=-1)
        ya = sgu_mixer(za, sgu_w[l], sgu_b[l])
        yb = pool_mixer(zb, pool_w[l], pool_scale[l])
        yc = conv_mixer(zc, conv_w[l])
        yd = s5_mixer(zd, s5_lambda_re[l], s5_lambda_im[l], s5_b_re[l], s5_b_im[l],
                      s5_c_re[l], s5_c_im[l], s5_d[l], s5_log_dt[l], s5_glu_w[l], s5_glu_b[l])
        y = group_rmsnorm(jnp.concatenate([ya, yb, yc, yd], axis=-1), mix_norm_g[l])
        x = x + g2 * (y @ w_mix_out[l])

        h = modulate(rmsnorm(x, norm3_g[l]), sh3, sc3)
        x = x + 0.5 * g3 * swiglu(h, ffn2_w_in[l], ffn2_w_out[l])
    return rmsnorm(x, final_norm_g)
```

```cpp
#include <hip/hip_runtime.h>
#include <hip/hip_cooperative_groups.h>
namespace cg = cooperative_groups;
namespace pg8 {
#define PG8_LAS __attribute__((address_space(3)))
typedef unsigned short bf16_t;
typedef short bf16x8 __attribute__((ext_vector_type(8)));
typedef float f32x4 __attribute__((ext_vector_type(4)));
typedef unsigned u32x4 __attribute__((ext_vector_type(4)));
constexpr int BM = 256, BK = 64, HALF = 128, HTB = HALF * BK * 2  , STAGE_BYTES = 8 * HTB, NXCD = 8, WGM = 8;

__host__ __device__ __forceinline__ int lds_byte(int r, int c) { const int st = (r >> 4) * 2 + (c >> 5), rr = r & 15, cc = c & 31, ob = rr * 64 + cc * 2; return st * 1024 + (ob ^ (((ob >> 9) & 1) << 5)); }
__host__ __device__ __forceinline__ void stage_rc(int b, int& R, int& C) { const int st = b / 1024, sb = b % 1024, swz = sb ^ (((sb >> 9) & 1) << 5); R = (st >> 1) * 16 + swz / 64; C = (st & 1) * 32 + (swz % 64) / 2; }
__host__ __device__ __forceinline__ int perm32(int rho) { const int n = rho >> 4, i = rho & 15; return 8 * (i >> 2) + 4 * n + (i & 3); }

struct Unit { int pm, pn; };
struct Gemm { const bf16_t* A; const bf16_t* Bt; int M, N, K; };

struct StaticOrder {
    int nM, nN, nwg, G, c;
    __host__ __device__ void init(int M, int N, int G_, int c_) { nM = M / BM; nN = N / BM; nwg = nM * nN; G = G_; c = c_; }
    __host__ __device__ bool next(int i, Unit& u) const {
        const long L = (long)i * G + c; if (L >= nwg) return false;
        int wgid = (int)L; { const int q = nwg / NXCD, r = nwg % NXCD, xcd = wgid % NXCD, off = wgid / NXCD; wgid = (xcd < r ? xcd * (q + 1) : r * (q + 1) + (xcd - r) * q) + off; }
        const int nig = WGM * nN, gid = wgid / nig, fm = gid * WGM, gsz = (nM - fm) < WGM ? (nM - fm) : WGM;
        u.pm = fm + ((wgid % nig) % gsz); u.pn = (wgid % nig) / gsz; return true;
    }
    __device__ __forceinline__ void a_ready(const Unit&) const {}
    __device__ __forceinline__ void done(const Unit&) const {}
};
__device__ __forceinline__ unsigned cvt_pk_bf16(float lo, float hi) { unsigned r; asm volatile("v_cvt_pk_bf16_f32 %0, %1, %2" : "=v"(r) : "v"(lo), "v"(hi)); return r; }
typedef float f32x2 __attribute__((ext_vector_type(2)));
typedef unsigned u32x2 __attribute__((ext_vector_type(2)));
__device__ __forceinline__ float silu_f(float a) { return a * __builtin_amdgcn_rcpf(1.0f + __expf(-a)); }
__device__ __forceinline__ float sigmoid_f(float a) { return __builtin_amdgcn_rcpf(1.0f + __expf(-a)); }
__device__ __forceinline__ float gelu_tanh(float y) { const float z = 1.5957691216f * (y + 0.044715f * y * y * y); return y * __builtin_amdgcn_rcpf(1.0f + __expf(-z)); }
__device__ __forceinline__ float bf_lo(unsigned w) { return __uint_as_float(w << 16); }
__device__ __forceinline__ float bf_hi(unsigned w) { return __uint_as_float(w & 0xffff0000u); }

struct EpiZ {
    static constexpr bool PERM = true, AFTER_DRAIN = false;
    bf16_t* O; int ldc;
    __device__ __forceinline__ void operator()(const f32x4 (&acc)[2][2][4][2], const Unit& u, int wr, int wc, int fr, int fq) const {
        const int row0 = u.pm * BM + wr * 64 + fr, col0 = u.pn * BM + wc * 32 + 8 * fq;
#pragma unroll
        for (int ai = 0; ai < 2; ++ai)
#pragma unroll
            for (int m = 0; m < 4; ++m) { bf16_t* rowp = O + (size_t)(row0 + ai * HALF + m * 16) * ldc + col0;
#pragma unroll
                for (int bj = 0; bj < 2; ++bj) { const f32x4 v0 = acc[ai][bj][m][0], v1 = acc[ai][bj][m][1];
                    u32x4 w; w.x = cvt_pk_bf16(v0[0], v0[1]); w.y = cvt_pk_bf16(v0[2], v0[3]); w.z = cvt_pk_bf16(v1[0], v1[1]); w.w = cvt_pk_bf16(v1[2], v1[3]);
                    *(u32x4*)(rowp + bj * HALF) = w; } }
    }
};
struct EpiSwiglu {
    static constexpr bool PERM = true, AFTER_DRAIN = false;
    bf16_t* O; int ldc;
    __device__ __forceinline__ void operator()(const f32x4 (&acc)[2][2][4][2], const Unit& u, int wr, int wc, int fr, int fq) const {
        const int row0 = u.pm * BM + wr * 64 + fr, col0 = u.pn * HALF + wc * 32 + 8 * fq;
#pragma unroll
        for (int ai = 0; ai < 2; ++ai)
#pragma unroll
            for (int m = 0; m < 4; ++m) { bf16_t* rowp = O + (size_t)(row0 + ai * HALF + m * 16) * ldc + col0;
                const f32x4 a0 = acc[ai][0][m][0], a1 = acc[ai][0][m][1], b0 = acc[ai][1][m][0], b1 = acc[ai][1][m][1];
                f32x4 v0, v1;
#pragma unroll
                for (int j = 0; j < 4; ++j) { v0[j] = silu_f(a0[j]) * b0[j]; v1[j] = silu_f(a1[j]) * b1[j]; }
                u32x4 w; w.x = cvt_pk_bf16(v0[0], v0[1]); w.y = cvt_pk_bf16(v0[2], v0[3]); w.z = cvt_pk_bf16(v1[0], v1[1]); w.w = cvt_pk_bf16(v1[2], v1[3]);
                *(u32x4*)rowp = w; }
    }
};
struct EpiResid {
    static constexpr bool PERM = false, AFTER_DRAIN = false;
    const float* xin; float* xout; const float* gate; float gs;
    __device__ __forceinline__ void operator()(const f32x4 (&acc)[2][2][4][2], const Unit& u, int wr, int wc, int fr, int fq) const {
        const int row0 = u.pm * BM + wr * 64 + fr, col0 = u.pn * BM + wc * 32 + 4 * fq;
        const float* gp = gate + (size_t)(u.pm >> 3) * 9216 + col0;
        f32x4 gv[2][2];
#pragma unroll
        for (int bj = 0; bj < 2; ++bj)
#pragma unroll
            for (int n = 0; n < 2; ++n) gv[bj][n] = *(const f32x4*)(gp + bj * HALF + n * 16) * gs;
#pragma unroll
        for (int ai = 0; ai < 2; ++ai)
#pragma unroll
            for (int m = 0; m < 4; ++m) { const size_t off = (size_t)(row0 + ai * HALF + m * 16) * 1024 + col0;
#pragma unroll
                for (int bj = 0; bj < 2; ++bj)
#pragma unroll
                    for (int n = 0; n < 2; ++n) { const f32x4 xi = *(const f32x4*)(xin + off + bj * HALF + n * 16);
                        *(f32x4*)(xout + off + bj * HALF + n * 16) = xi + gv[bj][n] * acc[ai][bj][m][n]; }
                asm volatile("" ::: "memory"); }
    }
};
struct EpiGlu {
    static constexpr bool PERM = false, AFTER_DRAIN = true;
    const bf16_t* yg; const float* glu_b; const float* gn; bf16_t* ycat;
    __device__ __forceinline__ void fused(f32x4 (&acc)[2][2][4][2], const Unit& u, int wr, int wc, int fr, int fq, PG8_LAS unsigned char* lds, int wid, int lane) const {
        PG8_LAS float* P = (PG8_LAS float*)lds;
        const int col0 = wc * 32 + 4 * fq;
        f32x4 gb[2][2];
#pragma unroll
        for (int bj = 0; bj < 2; ++bj)
#pragma unroll
            for (int n = 0; n < 2; ++n) gb[bj][n] = *(const f32x4*)(glu_b + col0 + bj * HALF + n * 16);
#pragma unroll
        for (int ai = 0; ai < 2; ++ai)
#pragma unroll
            for (int m = 0; m < 4; ++m) { const int r = ai * HALF + wr * 64 + m * 16 + fr; const bf16_t* yp = yg + (size_t)(u.pm * BM + r) * 256 + col0; float s = 0.f;
#pragma unroll
                for (int bj = 0; bj < 2; ++bj)
#pragma unroll
                    for (int n = 0; n < 2; ++n) { const u32x2 yw = *(const u32x2*)(yp + bj * HALF + n * 16);
                        const f32x4 y = (f32x4){bf_lo(yw.x), bf_hi(yw.x), bf_lo(yw.y), bf_hi(yw.y)}; const f32x4 a = acc[ai][bj][m][n] + gb[bj][n]; f32x4 o;
#pragma unroll
                        for (int j = 0; j < 4; ++j) { o[j] = y[j] * sigmoid_f(a[j]); s += o[j] * o[j]; }
                        acc[ai][bj][m][n] = o; }
                s += __shfl_xor(s, 16); s += __shfl_xor(s, 32);
                if (fq == 0) P[r * 4 + wc] = s; }
        asm volatile("s_waitcnt lgkmcnt(0)" ::: "memory"); __builtin_amdgcn_s_barrier(); asm volatile("" ::: "memory");
        f32x4 gg[2][2];
#pragma unroll
        for (int bj = 0; bj < 2; ++bj)
#pragma unroll
            for (int n = 0; n < 2; ++n) gg[bj][n] = *(const f32x4*)(gn + col0 + bj * HALF + n * 16);
#pragma unroll
        for (int ai = 0; ai < 2; ++ai)
#pragma unroll
            for (int m = 0; m < 4; ++m) { const int r = ai * HALF + wr * 64 + m * 16 + fr; const f32x4 pp = *(const PG8_LAS f32x4*)(P + r * 4);
                const float rstd = 1.0f / sqrtf(((pp[0] + pp[1]) + (pp[2] + pp[3])) * (1.0f / 256.0f) + 1e-6f);
                bf16_t* op = ycat + (size_t)(u.pm * BM + r) * 1024 + 768 + col0;
#pragma unroll
                for (int bj = 0; bj < 2; ++bj)
#pragma unroll
                    for (int n = 0; n < 2; ++n) { const f32x4 o = acc[ai][bj][m][n] * rstd * gg[bj][n]; u32x2 w; w.x = cvt_pk_bf16(o[0], o[1]); w.y = cvt_pk_bf16(o[2], o[3]);
                        *(u32x2*)(op + bj * HALF + n * 16) = w; } }
        asm volatile("s_waitcnt lgkmcnt(0)" ::: "memory"); __builtin_amdgcn_s_barrier(); asm volatile("" ::: "memory");
    }
};

template <class Epi, class Sched, bool STAMP = false>
__device__ __forceinline__ void gemm_phase(PG8_LAS unsigned char* lds, const Gemm g, const Sched& S, const Epi& E, unsigned long long* stamps, const int tid) {
    const int wid = __builtin_amdgcn_readfirstlane(tid >> 6), lane = tid & 63, wr = wid >> 2, wc = wid & 3, fr = lane & 15, fq = lane >> 4;
    const int K = g.K, nt = K / BK;
    int ts_lo = 0, ts_hi = 0, nts = 0; const unsigned long long rt_entry = STAMP ? (unsigned long long)wall_clock64() : 0ull;
#define PG8_STAMP() do { if (STAMP && wid == 0 && nts < 64) { const unsigned long long _c = (unsigned long long)clock64(); \
        ts_lo = (lane == nts) ? (int)(unsigned)_c : ts_lo; ts_hi = (lane == nts) ? (int)(unsigned)(_c >> 32) : ts_hi; ++nts; } } while (0)
    PG8_STAMP();
    unsigned voffA[2], voffB[2];
#pragma unroll
    for (int i = 0; i < 2; ++i) { int R, C; stage_rc(tid * 16 + i * 8192, R, C); const int Rb = Epi::PERM ? ((R & ~31) + perm32(R & 31)) : R;
        voffA[i] = (unsigned)(R * K + C) * 2u; voffB[i] = (unsigned)(Rb * K + C) * 2u; }
    const size_t kstep = (size_t)(BK * 2);
    const size_t hstep = (size_t)HALF * K * 2;
    const size_t tstep = 2 * hstep;
    const unsigned ldsw = (unsigned)wid * 1024u;
    const int aoff = lds_byte(wr * 64 + fr, fq * 8), boff = lds_byte(wc * 32 + fr, fq * 8);
#define PG8_SA(b, h) (((b) * 2 + (h)) * HTB)
#define PG8_SB(b, h) ((4 + (b) * 2 + (h)) * HTB)
#define PG8_STAGE(bufoff, gbase, voff) do { _Pragma("unroll") for (int _i = 0; _i < 2; ++_i) \
        __builtin_amdgcn_global_load_lds((const unsigned*)((const char*)(gbase) + (voff)[_i]), (PG8_LAS unsigned*)(lds + (bufoff) + ldsw + _i * 8192), 16, 0, 0); } while (0)
#define PG8_LDA(dst, b, h) do { _Pragma("unroll") for (int m = 0; m < 4; ++m) _Pragma("unroll") for (int k = 0; k < 2; ++k) dst[m][k] = *(const PG8_LAS bf16x8*)(lds + PG8_SA(b, h) + aoff + m * 2048 + k * 1024); } while (0)
#define PG8_LDB(dst, b, h) do { _Pragma("unroll") for (int n = 0; n < 2; ++n) _Pragma("unroll") for (int k = 0; k < 2; ++k) dst[n][k] = *(const PG8_LAS bf16x8*)(lds + PG8_SB(b, h) + boff + n * 2048 + k * 1024); } while (0)
#define PG8_MMA(ai, bj, At, Bt) do { __builtin_amdgcn_s_setprio(1); _Pragma("unroll") for (int m = 0; m < 4; ++m) _Pragma("unroll") for (int n = 0; n < 2; ++n) _Pragma("unroll") for (int k = 0; k < 2; ++k) \
        acc[ai][bj][m][n] = __builtin_amdgcn_mfma_f32_16x16x32_bf16(Bt[n][k], At[m][k], acc[ai][bj][m][n], 0, 0, 0); __builtin_amdgcn_s_setprio(0); } while (0)
#define PG8_WAIT_V(n) asm volatile("s_waitcnt vmcnt(" #n ")" ::: "memory")
#define PG8_WAIT_L(n) asm volatile("s_waitcnt lgkmcnt(" #n ")" ::: "memory")
#define PG8_BAR __builtin_amdgcn_s_barrier()
#define PG8_SCHED __builtin_amdgcn_sched_barrier(0)
    Unit cur, nxt; int ui = 0;
    if (!S.next(0, cur)) return;
    f32x4 acc[2][2][4][2];
#pragma unroll
    for (int a = 0; a < 2; ++a)
#pragma unroll
        for (int b = 0; b < 2; ++b)
#pragma unroll
            for (int m = 0; m < 4; ++m)
#pragma unroll
                for (int n = 0; n < 2; ++n) acc[a][b][m][n] = (f32x4){0.f, 0.f, 0.f, 0.f};
    bf16x8 At[4][2], B0[2][2], B1[2][2];
    const char* cA = (const char*)g.A + (size_t)cur.pm * tstep; const char* cB = (const char*)g.Bt + (size_t)cur.pn * tstep;
    S.a_ready(cur);
    PG8_STAGE(PG8_SB(0, 0), cB, voffB); PG8_STAGE(PG8_SA(0, 0), cA, voffA); PG8_STAGE(PG8_SB(0, 1), cB + hstep, voffB); PG8_STAGE(PG8_SA(0, 1), cA + hstep, voffA);
    if (wr == 1) PG8_BAR;
    PG8_WAIT_V(4); PG8_BAR;
    PG8_STAGE(PG8_SB(1, 0), cB + kstep, voffB); PG8_STAGE(PG8_SA(1, 0), cA + kstep, voffA); PG8_STAGE(PG8_SB(1, 1), cB + hstep + kstep, voffB);
    PG8_WAIT_V(6); PG8_BAR;
    PG8_STAMP();
    for (;;) {
        const bool has_next = S.next(ui + 1, nxt);
        const char* nA = has_next ? (const char*)g.A + (size_t)nxt.pm * tstep : cA; const char* nB = has_next ? (const char*)g.Bt + (size_t)nxt.pn * tstep : cB;
        for (int t = 0; t < nt; t += 2) {
            const bool last = (t == nt - 2);
            const char* a1 = cA + (size_t)(t + 1) * kstep;
            const char* a2 = last ? nA : cA + (size_t)(t + 2) * kstep; const char* b2 = last ? nB : cB + (size_t)(t + 2) * kstep;
            const char* a3 = a2 + kstep; const char* b3 = b2 + kstep;
            if (last && has_next) S.a_ready(nxt);
            PG8_LDB(B0, 0, 0); PG8_SCHED; PG8_LDA(At, 0, 0); PG8_STAGE(PG8_SA(1, 1), a1 + hstep, voffA);
            PG8_WAIT_L(8); PG8_BAR; PG8_WAIT_L(0); PG8_MMA(0, 0, At, B0); PG8_BAR; PG8_SCHED;
            PG8_LDB(B1, 0, 1); PG8_STAGE(PG8_SB(0, 0), b2, voffB);
            PG8_BAR; PG8_WAIT_L(0); PG8_MMA(0, 1, At, B1); PG8_BAR;
            PG8_LDA(At, 0, 1); PG8_STAGE(PG8_SA(0, 0), a2, voffA);
            PG8_BAR; PG8_WAIT_L(0); PG8_MMA(1, 0, At, B0); PG8_BAR; PG8_SCHED;
            PG8_STAGE(PG8_SB(0, 1), b2 + hstep, voffB);
            PG8_WAIT_V(6); PG8_BAR; PG8_MMA(1, 1, At, B1); PG8_BAR;
            PG8_LDB(B0, 1, 0); PG8_SCHED; PG8_LDA(At, 1, 0); PG8_STAGE(PG8_SA(0, 1), a2 + hstep, voffA);
            PG8_WAIT_L(8); PG8_BAR; PG8_WAIT_L(0); PG8_MMA(0, 0, At, B0); PG8_BAR; PG8_SCHED;
            PG8_LDB(B1, 1, 1); PG8_STAGE(PG8_SB(1, 0), b3, voffB);
            PG8_BAR; PG8_WAIT_L(0); PG8_MMA(0, 1, At, B1); PG8_BAR;
            PG8_LDA(At, 1, 1); PG8_STAGE(PG8_SA(1, 0), a3, voffA);
            PG8_BAR; PG8_WAIT_L(0); PG8_MMA(1, 0, At, B0); PG8_BAR; PG8_SCHED;
            PG8_STAGE(PG8_SB(1, 1), b3 + hstep, voffB);
            PG8_WAIT_V(6); PG8_BAR; PG8_MMA(1, 1, At, B1); PG8_BAR;
        }
        PG8_STAMP();
        if constexpr (!Epi::AFTER_DRAIN) { E(acc, cur, wr, wc, fr, fq); S.done(cur); }
        PG8_STAMP();
        if (!has_next) break;
#pragma unroll
        for (int a = 0; a < 2; ++a)
#pragma unroll
            for (int b = 0; b < 2; ++b)
#pragma unroll
                for (int m = 0; m < 4; ++m)
#pragma unroll
                    for (int n = 0; n < 2; ++n) acc[a][b][m][n] = (f32x4){0.f, 0.f, 0.f, 0.f};
        cur = nxt; cA = nA; cB = nB; ++ui;
    }
    PG8_WAIT_V(0);
    if (wr == 0) PG8_BAR;
    PG8_BAR;
    if constexpr (Epi::AFTER_DRAIN) { E.fused(acc, cur, wr, wc, fr, fq, lds, wid, lane); S.done(cur); }
    PG8_STAMP();
    if (STAMP && wid == 0) { stamps[lane] = lane < nts ? (((unsigned long long)(unsigned)ts_hi << 32) | (unsigned)ts_lo) : 0ull;
        if (lane == 62) stamps[62] = rt_entry; if (lane == 63) stamps[63] = (unsigned long long)wall_clock64(); }
#undef PG8_STAMP
#undef PG8_SA
#undef PG8_SB
#undef PG8_STAGE
#undef PG8_LDA
#undef PG8_LDB
#undef PG8_MMA
#undef PG8_WAIT_V
#undef PG8_WAIT_L
#undef PG8_BAR
#undef PG8_SCHED
}
}

#define LAS __attribute__((address_space(3)))
typedef unsigned short bf16;
using pg8::f32x4; using pg8::bf16x8; using pg8::u32x4; using pg8::u32x2; using pg8::cvt_pk_bf16; using pg8::bf_lo; using pg8::bf_hi; using pg8::gelu_tanh;

constexpr int M = 16384, D = 1024, DFF = 2816, PIN = 1792, NL = 4, NCOND = 9216;
constexpr float EPS = 1e-6f;
constexpr size_t MiB = (size_t)1 << 20;
constexpr size_t WS_COND = 0, WS_E = 2 * MiB, WS_W = 8 * MiB, LW = 39 * MiB;
constexpr size_t OW_IN1 = 0, OW_OUT1 = 11 * MiB, OW_MIX = OW_OUT1 + 11 * MiB / 2, OW_MO = OW_MIX + 7 * MiB / 2, OW_IN2 = OW_MO + 2 * MiB, OW_OUT2 = OW_IN2 + 11 * MiB, OW_GLU = OW_OUT2 + 11 * MiB / 2;
static_assert(OW_GLU + 131072 <= LW, "weights per layer");
constexpr size_t WS_H = 164 * MiB, WS_ACT = 196 * MiB, WS_Z = 284 * MiB, WS_YG = 340 * MiB, WS_YCAT = 348 * MiB, WS_END = 380 * MiB;
constexpr int LDS_BYTES = 147456;
constexpr int NPH = 50;
constexpr int ITEMS_PER_LAYER = 2816 + 1408 + 768 + 512 + 2816 + 1408 + 32 + 128;

struct Args { const float* in[30]; float* out; unsigned char* ws; int ph_lo, ph_hi; };

__device__ __forceinline__ float wave_sum(float v) {
#pragma unroll
    for (int o = 1; o < 64; o <<= 1) v += __shfl_xor(v, o);
    return v;
}
#define LDS_WAIT() asm volatile("s_waitcnt lgkmcnt(0)" ::: "memory")

__device__ __forceinline__ void transpose_item(const float* W, int K, int N, bf16* WT, int dst_row0, int k0, int n0, LAS float* scr, int lane) {
#pragma unroll 8
    for (int i = 0; i < 32; ++i) { const int kk = 2 * i + (lane >> 5); scr[kk * 33 + (lane & 31)] = W[(size_t)(k0 + kk) * N + n0 + (lane & 31)]; }
    LDS_WAIT();
    const int c = lane & 7;
#pragma unroll
    for (int j = 0; j < 4; ++j) { const int n = (lane >> 3) + 8 * j; const LAS float* s = scr + (8 * c) * 33 + n;
        u32x4 o; o.x = cvt_pk_bf16(s[0 * 33], s[1 * 33]); o.y = cvt_pk_bf16(s[2 * 33], s[3 * 33]); o.z = cvt_pk_bf16(s[4 * 33], s[5 * 33]); o.w = cvt_pk_bf16(s[6 * 33], s[7 * 33]);
        *(u32x4*)(WT + (size_t)(dst_row0 + n) * K + k0 + 8 * c) = o; }
    LDS_WAIT();
}

__device__ __forceinline__ void prep_phase(const Args& a, LAS unsigned char* lds, int tid, int wave, int lane, int G) {
    LAS float* sc = (LAS float*)lds;
    LAS float* R = (LAS float*)(lds + 32768);
    LAS float* scr = (LAS float*)(lds + 49152 + wave * 8448);
    const float* c_in = a.in[1];
    for (int i = tid; i < 8 * 1024; i += 512) { const float v = c_in[i]; sc[i] = v / (1.0f + expf(-v)); }
    __syncthreads();
    float* cond = (float*)(a.ws + WS_COND);
    for (int it = blockIdx.x; it < NL * 144; it += G) {
        const int l = it / 144, n0 = 64 * (it % 144);
        const float* wp = a.in[2] + ((size_t)l * 1024 + 128 * wave) * NCOND + n0 + lane;
        float acc[8];
#pragma unroll
        for (int b = 0; b < 8; ++b) acc[b] = 0.f;
#pragma unroll 8
        for (int kk = 0; kk < 128; ++kk) { const float wv = wp[(size_t)kk * NCOND];
#pragma unroll
            for (int b = 0; b < 8; ++b) acc[b] += sc[b * 1024 + 128 * wave + kk] * wv; }
#pragma unroll
        for (int b = 0; b < 8; ++b) R[(wave * 8 + b) * 64 + lane] = acc[b];
        __syncthreads();
        { const int b = wave; float s = a.in[3][(size_t)l * NCOND + n0 + lane];
#pragma unroll
          for (int w = 0; w < 8; ++w) s += R[(w * 8 + b) * 64 + lane];
          cond[((size_t)l * 8 + b) * NCOND + n0 + lane] = s; }
        __syncthreads();
    }
    const int gw = blockIdx.x * 8 + wave, NGW = G * 8;
    for (int item = gw; item < NL * ITEMS_PER_LAYER; item += NGW) {
        const int l = item / ITEMS_PER_LAYER; int r = item % ITEMS_PER_LAYER;
        unsigned char* wl = a.ws + WS_W + (size_t)l * LW;
        if (r < 2816 + 1408 + 768 + 512 + 2816 + 1408 + 32) {
            const float* W; int K, N, kb, nb, dst; bf16* WT;
            if (r < 2816) { kb = r / 176; nb = r % 176; W = a.in[5] + (size_t)l * 1024 * 5632; K = 1024; N = 5632; WT = (bf16*)(wl + OW_IN1);
                const int n0 = 32 * nb; dst = n0 < DFF ? (n0 / 128) * 256 + (n0 % 128) : ((n0 - DFF) / 128) * 256 + 128 + ((n0 - DFF) % 128); }
            else if ((r -= 2816) < 1408) { kb = r / 32; nb = r % 32; W = a.in[6] + (size_t)l * DFF * 1024; K = DFF; N = 1024; WT = (bf16*)(wl + OW_OUT1); dst = 32 * nb; }
            else if ((r -= 1408) < 768) { kb = r / 48; const int idx = r % 48; nb = idx < 16 ? idx : idx + 8; W = a.in[8] + (size_t)l * 1024 * PIN; K = 1024; N = PIN; WT = (bf16*)(wl + OW_MIX); dst = 32 * nb; }
            else if ((r -= 768) < 512) { kb = r / 32; nb = r % 32; W = a.in[25] + (size_t)l * 1024 * 1024; K = 1024; N = 1024; WT = (bf16*)(wl + OW_MO); dst = 32 * nb; }
            else if ((r -= 512) < 2816) { kb = r / 176; nb = r % 176; W = a.in[27] + (size_t)l * 1024 * 5632; K = 1024; N = 5632; WT = (bf16*)(wl + OW_IN2);
                const int n0 = 32 * nb; dst = n0 < DFF ? (n0 / 128) * 256 + (n0 % 128) : ((n0 - DFF) / 128) * 256 + 128 + ((n0 - DFF) % 128); }
            else if ((r -= 2816) < 1408) { kb = r / 32; nb = r % 32; W = a.in[28] + (size_t)l * DFF * 1024; K = DFF; N = 1024; WT = (bf16*)(wl + OW_OUT2); dst = 32 * nb; }
            else { r -= 1408; kb = r / 8; nb = r % 8; W = a.in[22] + (size_t)l * 65536; K = 256; N = 256; WT = (bf16*)(wl + OW_GLU); dst = 32 * nb; }
            transpose_item(W, K, N, WT, dst, 64 * kb, 32 * nb, scr, lane);
        } else {
            r -= 2816 + 1408 + 768 + 512 + 2816 + 1408 + 32;
            const int kb = r / 8, nb = r % 8, g = nb >> 1, k = 64 * kb + lane;
            const float* wr = a.in[8] + ((size_t)l * 1024 + k) * PIN + 512 + 64 * g;
            float wrow[64];
#pragma unroll
            for (int j = 0; j < 16; ++j) { const f32x4 v = *(const f32x4*)(wr + 4 * j); wrow[4 * j] = v[0]; wrow[4 * j + 1] = v[1]; wrow[4 * j + 2] = v[2]; wrow[4 * j + 3] = v[3]; }
            const float* pw = a.in[11] + (size_t)(l * 4 + g) * 4096; const float* ps = a.in[12] + (size_t)l * 256 + 64 * g;
            bf16* WT = (bf16*)(wl + OW_MIX);
            for (int i = 0; i < 32; ++i) { const int d = 32 * (nb & 1) + i; float s = 0.f;
#pragma unroll
                for (int c = 0; c < 64; ++c) s += wrow[c] * pw[c * 64 + d];
                s *= ps[d];
                WT[(size_t)(512 + 32 * nb + i) * 1024 + k] = (bf16)(cvt_pk_bf16(s, 0.f) & 0xffffu); }
        }
    }
}

__device__ __forceinline__ void norm_phase(const float* x, const float* g, const float* sh, const float* scl, bf16* h, int gw, int NGW, int lane) {
    for (int row = gw; row < M; row += NGW) {
        const f32x4* xr = (const f32x4*)(x + (size_t)row * D) + lane;
        f32x4 v[4]; float s = 0.f;
#pragma unroll
        for (int j = 0; j < 4; ++j) { v[j] = xr[64 * j]; s += (v[j][0] * v[j][0] + v[j][1] * v[j][1]) + (v[j][2] * v[j][2] + v[j][3] * v[j][3]); }
        const float rstd = 1.0f / sqrtf(wave_sum(s) * (1.0f / D) + EPS);
        const size_t cb = (size_t)(row >> 11) * NCOND;
        u32x2* o = (u32x2*)(h + (size_t)row * D) + lane;
#pragma unroll
        for (int j = 0; j < 4; ++j) { const int col = 4 * lane + 256 * j;
            const f32x4 gg = *(const f32x4*)(g + col), ss = *(const f32x4*)(scl + cb + col), hh = *(const f32x4*)(sh + cb + col);
            const f32x4 y = (v[j] * rstd * gg) * (ss + 1.0f) + hh;
            u32x2 w; w.x = cvt_pk_bf16(y[0], y[1]); w.y = cvt_pk_bf16(y[2], y[3]); o[64 * j] = w; }
    }
}
__device__ __forceinline__ void final_norm_phase(float* x, const float* g, int gw, int NGW, int lane) {
    for (int row = gw; row < M; row += NGW) {
        f32x4* xr = (f32x4*)(x + (size_t)row * D) + lane;
        f32x4 v[4]; float s = 0.f;
#pragma unroll
        for (int j = 0; j < 4; ++j) { v[j] = xr[64 * j]; s += (v[j][0] * v[j][0] + v[j][1] * v[j][1]) + (v[j][2] * v[j][2] + v[j][3] * v[j][3]); }
        const float rstd = 1.0f / sqrtf(wave_sum(s) * (1.0f / D) + EPS);
#pragma unroll
        for (int j = 0; j < 4; ++j) { const f32x4 gg = *(const f32x4*)(g + 4 * lane + 256 * j); xr[64 * j] = v[j] * rstd * gg; }
    }
}

__device__ __forceinline__ f32x4 ld4bf(const bf16* p) { const u32x2 w = *(const u32x2*)p; return (f32x4){bf_lo(w.x), bf_hi(w.x), bf_lo(w.y), bf_hi(w.y)}; }
__device__ __forceinline__ void st4bf(bf16* p, f32x4 v) { u32x2 w; w.x = cvt_pk_bf16(v[0], v[1]); w.y = cvt_pk_bf16(v[2], v[3]); *(u32x2*)p = w; }
__device__ __forceinline__ bf16x8 pack8(f32x4 lo, f32x4 hi) { u32x4 w; w.x = cvt_pk_bf16(lo[0], lo[1]); w.y = cvt_pk_bf16(lo[2], lo[3]); w.z = cvt_pk_bf16(hi[0], hi[1]); w.w = cvt_pk_bf16(hi[2], hi[3]); return __builtin_bit_cast(bf16x8, w); }

__device__ __forceinline__ void sgu_item(const Args& a, int l, int it, LAS unsigned char* lds, int tid, int wave, int lane) {
    const bf16* z = (const bf16*)(a.ws + WS_Z); bf16* ycat = (bf16*)(a.ws + WS_YCAT);
    LAS bf16* vT = (LAS bf16*)lds;
    const int tok0 = it * 128;
    { const int s = tid >> 2, q = tid & 3;
#pragma unroll
      for (int h = 0; h < 4; ++h) {
          const bf16* zp = z + (size_t)(tok0 + s) * PIN + 256 + 64 * h + 16 * q;
          float v[16]; float sum = 0.f;
#pragma unroll
          for (int j = 0; j < 4; ++j) { const f32x4 t4 = ld4bf(zp + 4 * j);
#pragma unroll
              for (int e = 0; e < 4; ++e) { v[4 * j + e] = gelu_tanh(t4[e]); sum += v[4 * j + e]; } }
          sum += __shfl_xor(sum, 1); sum += __shfl_xor(sum, 2);
          const float mu = sum * (1.0f / 64.0f); float q2 = 0.f;
#pragma unroll
          for (int e = 0; e < 16; ++e) { v[e] -= mu; q2 += v[e] * v[e]; }
          q2 += __shfl_xor(q2, 1); q2 += __shfl_xor(q2, 2);
          const float rs = 1.0f / sqrtf(q2 * (1.0f / 64.0f) + EPS);
#pragma unroll
          for (int e = 0; e < 16; ++e) vT[(64 * h + 16 * q + e) * 136 + s] = (bf16)(cvt_pk_bf16(v[e] * rs, 0.f) & 0xffffu);
      } }
    __syncthreads();
    const int fr = lane & 15, fq = lane >> 4, t = 16 * wave + fr, nks = (wave >> 1) + 1;
    f32x4 acc[16];
#pragma unroll
    for (int i = 0; i < 16; ++i) acc[i] = (f32x4){0.f, 0.f, 0.f, 0.f};
#pragma unroll
    for (int h = 0; h < 4; ++h) {
        const float* wrow = a.in[9] + ((size_t)(l * 4 + h) * 128 + t) * 128 + 8 * fq;
        for (int ks = 0; ks < nks; ++ks) {
            f32x4 w0 = *(const f32x4*)(wrow + 32 * ks), w1 = *(const f32x4*)(wrow + 32 * ks + 4);
            const int s0 = 32 * ks + 8 * fq;
#pragma unroll
            for (int e = 0; e < 4; ++e) { if (s0 + e > t) w0[e] = 0.f; if (s0 + 4 + e > t) w1[e] = 0.f; }
            const bf16x8 wf = pack8(w0, w1);
#pragma unroll
            for (int dt = 0; dt < 4; ++dt) { const bf16x8 vf = *(const LAS bf16x8*)(vT + (64 * h + 16 * dt + fr) * 136 + 32 * ks + 8 * fq);
                acc[h * 4 + dt] = __builtin_amdgcn_mfma_f32_16x16x32_bf16(vf, wf, acc[h * 4 + dt], 0, 0, 0); }
        }
    }
    const size_t tok = (size_t)tok0 + t; float ss = 0.f;
#pragma unroll
    for (int h = 0; h < 4; ++h) { const float bias = a.in[10][(size_t)(l * 4 + h) * 128 + t];
#pragma unroll
        for (int dt = 0; dt < 4; ++dt) { const f32x4 u4 = ld4bf(z + tok * PIN + 64 * h + 16 * dt + 4 * fq); f32x4 o;
#pragma unroll
            for (int e = 0; e < 4; ++e) { o[e] = gelu_tanh(u4[e]) * (acc[h * 4 + dt][e] + bias); ss += o[e] * o[e]; }
            acc[h * 4 + dt] = o; } }
    ss += __shfl_xor(ss, 16); ss += __shfl_xor(ss, 32);
    const float rstd = 1.0f / sqrtf(ss * (1.0f / 256.0f) + EPS);
    const float* gn = a.in[24] + (size_t)l * 1024;
#pragma unroll
    for (int h = 0; h < 4; ++h)
#pragma unroll
        for (int dt = 0; dt < 4; ++dt) { const int ch = 64 * h + 16 * dt + 4 * fq; const f32x4 gg = *(const f32x4*)(gn + ch);
            st4bf(ycat + tok * 1024 + ch, acc[h * 4 + dt] * rstd * gg); }
    __syncthreads();
}

__device__ __forceinline__ void sincos_red(float ang, float& sn, float& cs) {
    const float n = rintf(ang * 0.15915494309189535f);
    float r = fmaf(-n, 6.2831854820251465f, ang); r = fmaf(-n, -1.7484556e-7f, r);
    const float h = 0.5f * r, h2 = h * h;
    const float s = h * (1.0f + h2 * (-1.6666667e-1f + h2 * (8.3333333e-3f + h2 * (-1.9841270e-4f + h2 * (2.7557319e-6f + h2 * (-2.5052108e-8f))))));
    const float c = 1.0f + h2 * (-0.5f + h2 * (4.1666667e-2f + h2 * (-1.3888889e-3f + h2 * (2.4801587e-5f + h2 * (-2.7557319e-7f + h2 * 2.0876757e-9f)))));
    sn = 2.0f * s * c; cs = 1.0f - 2.0f * s * s;
}

template <int PASS>
__device__ __forceinline__ void s5_item(const Args& a, int l, int idx, LAS unsigned char* ldsw, int lane) {
    const int g = idx & 15, ck = (idx >> 4) & 63, b = idx >> 10, p = lane;
    const bf16* z = (const bf16*)(a.ws + WS_Z); float* E = (float*)(a.ws + WS_E);
    const int lg = l * 16 + g;
    const float dt = expf(a.in[21][lg]);
    const float lre = a.in[14][(size_t)lg * 64 + p], lim = a.in[15][(size_t)lg * 64 + p];
    const float mag = expf(lre * dt); float sn, cs; sincos_red(lim * dt, sn, cs);
    const float are = mag * cs, aim = mag * sn, nr = are - 1.0f, ni = aim, den = lre * lre + lim * lim;
    const float kre = (nr * lre + ni * lim) / den, kim = (ni * lre - nr * lim) / den;
    float bbr[16], bbi[16];
    { const f32x4* brp = (const f32x4*)(a.in[16] + ((size_t)lg * 64 + p) * 16); const f32x4* bip = (const f32x4*)(a.in[17] + ((size_t)lg * 64 + p) * 16);
#pragma unroll
      for (int j = 0; j < 4; ++j) { const f32x4 br = brp[j], bi = bip[j];
#pragma unroll
          for (int e = 0; e < 4; ++e) { bbr[4 * j + e] = kre * br[e] - kim * bi[e]; bbi[4 * j + e] = kre * bi[e] + kim * br[e]; } } }
    const size_t tok0 = (size_t)b * 2048 + 32 * ck;
    int uw[8];
    { const u32x4* up = (const u32x4*)(z + (tok0 + (lane & 31)) * PIN + 1536 + 16 * g); const u32x4 u0 = up[0], u1 = up[1];
      uw[0] = (int)u0.x; uw[1] = (int)u0.y; uw[2] = (int)u0.z; uw[3] = (int)u0.w; uw[4] = (int)u1.x; uw[5] = (int)u1.y; uw[6] = (int)u1.z; uw[7] = (int)u1.w; }
    float xr = 0.f, xi = 0.f;
    if (PASS == 2) {
        float Ar = are, Ai = aim;
#pragma unroll
        for (int q = 0; q < 5; ++q) { const float tr = Ar * Ar - Ai * Ai, ti = 2.0f * Ar * Ai; Ar = tr; Ai = ti; }
        const float* Ep = E + ((size_t)(b * 64) * 16 + g) * 128 + p;
        for (int cc = 0; cc < ck; ++cc) { const float er = Ep[(size_t)cc * 2048], ei = Ep[(size_t)cc * 2048 + 64];
            const float tr = Ar * xr - Ai * xi + er, ti = Ar * xi + Ai * xr + ei; xr = tr; xi = ti; }
    }
    LAS bf16* Xs = (LAS bf16*)ldsw;
    for (int t = 0; t < 32; ++t) {
        float bur = 0.f, bui = 0.f;
#pragma unroll
        for (int c2 = 0; c2 < 8; ++c2) { const unsigned w = (unsigned)__builtin_amdgcn_readlane(uw[c2], t); const float u0 = bf_lo(w), u1 = bf_hi(w);
            bur += bbr[2 * c2] * u0; bur += bbr[2 * c2 + 1] * u1; bui += bbi[2 * c2] * u0; bui += bbi[2 * c2 + 1] * u1; }
        const float tr = are * xr - aim * xi + bur, ti = are * xi + aim * xr + bui; xr = tr; xi = ti;
        if (PASS == 2) { const unsigned w = cvt_pk_bf16(xr, xi); Xs[t * 136 + p] = (bf16)(w & 0xffffu); Xs[t * 136 + 64 + p] = (bf16)(w >> 16); }
    }
    if (PASS == 1) { float* Ep = E + ((size_t)(b * 64 + ck) * 16 + g) * 128 + p; Ep[0] = xr; Ep[64] = xi; }
    else {
        const int fr = lane & 15, fq = lane >> 4;
        bf16x8 cf[4];
#pragma unroll
        for (int ks = 0; ks < 4; ++ks) { const float* cp = (ks < 2 ? a.in[18] : a.in[19]) + ((size_t)lg * 16 + fr) * 64 + 32 * (ks & 1) + 8 * fq;
            f32x4 c0 = *(const f32x4*)cp, c1 = *(const f32x4*)(cp + 4); if (ks >= 2) { c0 = -c0; c1 = -c1; } cf[ks] = pack8(c0, c1); }
        LDS_WAIT();
        bf16* yg = (bf16*)(a.ws + WS_YG);
        const f32x4 dd = *(const f32x4*)(a.in[20] + (size_t)l * 256 + 16 * g + 4 * fq);
#pragma unroll
        for (int tt = 0; tt < 2; ++tt) { f32x4 acc = (f32x4){0.f, 0.f, 0.f, 0.f};
#pragma unroll
            for (int ks = 0; ks < 4; ++ks) { const bf16x8 xf = *(const LAS bf16x8*)(Xs + (16 * tt + fr) * 136 + 32 * ks + 8 * fq);
                acc = __builtin_amdgcn_mfma_f32_16x16x32_bf16(cf[ks], xf, acc, 0, 0, 0); }
            const size_t tok = tok0 + 16 * tt + fr; const f32x4 u4 = ld4bf(z + tok * PIN + 1536 + 16 * g + 4 * fq); f32x4 y;
#pragma unroll
            for (int e = 0; e < 4; ++e) y[e] = gelu_tanh(acc[e] + dd[e] * u4[e]);
            st4bf(yg + tok * 256 + 16 * g + 4 * fq, y); }
        LDS_WAIT();
    }
}

__device__ __forceinline__ void poolconv_item(const Args& a, int l, int token, int lane) {
    const bf16* z = (const bf16*)(a.ws + WS_Z); bf16* ycat = (bf16*)(a.ws + WS_YCAT);
    const int pos = token & 2047, ch = 4 * lane, w = 2 << (lane >> 4);
    const float* gn = a.in[24] + (size_t)l * 1024;
    { const bf16* zp = z + (size_t)token * PIN + 512 + ch; const f32x4 q0 = ld4bf(zp); f32x4 sum = q0;
      for (int j = 1; j < 16; ++j) if (j < w && j <= pos) sum += ld4bf(zp - (size_t)j * PIN);
      const int cnt = (pos + 1 < w) ? pos + 1 : w;
      const f32x4 o = sum * (1.0f / (float)cnt) - q0;
      const float ss = wave_sum((o[0] * o[0] + o[1] * o[1]) + (o[2] * o[2] + o[3] * o[3]));
      const float rstd = 1.0f / sqrtf(ss * (1.0f / 256.0f) + EPS);
      st4bf(ycat + (size_t)token * 1024 + 256 + ch, o * rstd * *(const f32x4*)(gn + 256 + ch)); }
    { const bf16* zp = z + (size_t)token * PIN + 768 + ch; const f32x4 bg = ld4bf(zp); f32x4 y = (f32x4){0.f, 0.f, 0.f, 0.f};
#pragma unroll
      for (int j = 0; j < 3; ++j) if (pos - 2 + j >= 0) { const bf16* zq = zp - (size_t)(2 - j) * PIN;
          y += *(const f32x4*)(a.in[13] + ((size_t)l * 3 + j) * 256 + ch) * (ld4bf(zq + 256) * ld4bf(zq + 512)); }
      const f32x4 o = bg * y;
      const float ss = wave_sum((o[0] * o[0] + o[1] * o[1]) + (o[2] * o[2] + o[3] * o[3]));
      const float rstd = 1.0f / sqrtf(ss * (1.0f / 256.0f) + EPS);
      st4bf(ycat + (size_t)token * 1024 + 512 + ch, o * rstd * *(const f32x4*)(gn + 512 + ch)); }
}

#ifndef PHM
#define PHM 0xfff
#endif
#ifndef PER_PHASE_LAUNCH
#define PER_PHASE_LAUNCH 0
#endif
__global__ void __launch_bounds__(512) mega(Args a) {
    extern __shared__ __attribute__((aligned(16))) unsigned char lds_raw[];
    LAS unsigned char* lds = (LAS unsigned char*)lds_raw;
    const int G = gridDim.x, NGW = G * 8;
    unsigned char* ws = a.ws;
    float* cond = (float*)(ws + WS_COND);
    bf16* H = (bf16*)(ws + WS_H); bf16* ACT = (bf16*)(ws + WS_ACT); bf16* Z = (bf16*)(ws + WS_Z); bf16* YG = (bf16*)(ws + WS_YG); bf16* YCAT = (bf16*)(ws + WS_YCAT);
    for (int ph = a.ph_lo; ph < a.ph_hi; ++ph) {
        int tid = threadIdx.x; asm volatile("" : "+v"(tid));
        const int lane = tid & 63, wave = __builtin_amdgcn_readfirstlane(tid >> 6), gw = blockIdx.x * 8 + wave;
        if (ph == 0) { if (PHM & 1) prep_phase(a, lds, tid, wave, lane, G); }
        else if (ph == NPH - 1) { if (PHM & 2) final_norm_phase(a.out, a.in[29], gw, NGW, lane); }
        else {
            const int l = (ph - 1) / 12, s = (ph - 1) % 12;
            unsigned char* wl = ws + WS_W + (size_t)l * LW;
            const float* cl = cond + (size_t)l * 8 * NCOND;
            if ((PHM & 4) && (s == 0 || s == 3 || s == 9)) {
                const float* xs = (l == 0 && s == 0) ? a.in[0] : a.out;
                const float* g = a.in[s == 0 ? 4 : (s == 3 ? 7 : 26)] + (size_t)l * D;
                const int kc = (s == 0) ? 0 : (s == 3 ? 3 : 6);
                norm_phase(xs, g, cl + kc * 1024, cl + (kc + 1) * 1024, H, gw, NGW, lane);
            } else if ((PHM & 8) && (s == 1 || s == 10)) {
                pg8::Gemm gm{H, (const bf16*)(wl + (s == 1 ? OW_IN1 : OW_IN2)), M, 2 * DFF, D}; pg8::StaticOrder S; S.init(M, 2 * DFF, G, (int)blockIdx.x);
                pg8::EpiSwiglu E{ACT, DFF};
                pg8::gemm_phase<pg8::EpiSwiglu, pg8::StaticOrder>(lds, gm, S, E, nullptr, tid);
            } else if ((PHM & 16) && (s == 2 || s == 8 || s == 11)) {
                const bf16* A = (s == 8) ? YCAT : ACT; const int K = (s == 8) ? D : DFF;
                const bf16* Bt = (const bf16*)(wl + (s == 2 ? OW_OUT1 : (s == 8 ? OW_MO : OW_OUT2)));
                pg8::Gemm gm{A, Bt, M, D, K}; pg8::StaticOrder S; S.init(M, D, G, (int)blockIdx.x);
                const float* xin = (l == 0 && s == 2) ? a.in[0] : a.out;
                pg8::EpiResid E{xin, a.out, cl + (s == 2 ? 2 : (s == 8 ? 5 : 8)) * 1024, s == 8 ? 1.0f : 0.5f};
                pg8::gemm_phase<pg8::EpiResid, pg8::StaticOrder>(lds, gm, S, E, nullptr, tid);
            } else if ((PHM & 32) && s == 4) {
                pg8::Gemm gm{H, (const bf16*)(wl + OW_MIX), M, PIN, D}; pg8::StaticOrder S; S.init(M, PIN, G, (int)blockIdx.x);
                pg8::EpiZ E{Z, PIN};
                pg8::gemm_phase<pg8::EpiZ, pg8::StaticOrder>(lds, gm, S, E, nullptr, tid);
            } else if ((PHM & 64) && s == 5) {
                for (int it = blockIdx.x; it < 128; it += G) sgu_item(a, l, it, lds, tid, wave, lane);
                for (int idx = gw; idx < 8192; idx += NGW) s5_item<1>(a, l, idx, lds, lane);
            } else if ((PHM & 128) && s == 6) {
                for (int idx = gw; idx < 8192; idx += NGW) s5_item<2>(a, l, idx, lds + wave * 8704, lane);
                for (int tk = gw; tk < M; tk += NGW) poolconv_item(a, l, tk, lane);
            } else if ((PHM & 256) && s == 7) {
                pg8::Gemm gm{YG, (const bf16*)(wl + OW_GLU), M, 256, 256}; pg8::StaticOrder S; S.init(M, 256, G, (int)blockIdx.x);
                pg8::EpiGlu E{YG, a.in[23] + (size_t)l * 256, a.in[24] + (size_t)l * 1024 + 768, YCAT};
                pg8::gemm_phase<pg8::EpiGlu, pg8::StaticOrder>(lds, gm, S, E, nullptr, tid);
            }
        }
        if (ph + 1 < a.ph_hi) cg::this_grid().sync();
    }
}

extern "C" void kernel_launch(void* const* d_in, const int* in_sizes, int n_in, void* d_out, int out_size, void* d_ws, size_t ws_size, hipStream_t stream) {
    static int grid = 0;
    if (grid == 0) {
        int dev = 0, cus = 0;
        if (n_in != 30 || ws_size < WS_END || hipGetDevice(&dev) != hipSuccess || hipDeviceGetAttribute(&cus, hipDeviceAttributeMultiprocessorCount, dev) != hipSuccess) { grid = -1; return; }
        if (hipFuncSetAttribute((const void*)mega, hipFuncAttributeMaxDynamicSharedMemorySize, LDS_BYTES) != hipSuccess) { grid = -1; return; }
        int per_cu = 0;
        if (hipOccupancyMaxActiveBlocksPerMultiprocessor(&per_cu, (const void*)mega, 512, LDS_BYTES) != hipSuccess || per_cu < 1) per_cu = 1;
        (void)hipGetLastError();
        grid = cus;
    }
    if (grid < 0) return;
    Args a{};
    for (int i = 0; i < 30; ++i) a.in[i] = (const float*)d_in[i];
    a.out = (float*)d_out; a.ws = (unsigned char*)d_ws;
#if PER_PHASE_LAUNCH
    for (int ph = 0; ph < NPH; ++ph) { a.ph_lo = ph; a.ph_hi = ph + 1; hipLaunchKernelGGL(mega, dim3(grid), dim3(512), LDS_BYTES, stream, a); }
#else
    a.ph_lo = 0; a.ph_hi = NPH;
    void* args[] = {&a};
    (void)hipLaunchCooperativeKernel((const void*)mega, dim3(grid), dim3(512), args, LDS_BYTES, stream);
#endif
}
```

```cpp
#include <hip/hip_runtime.h>
#include <hip/hip_cooperative_groups.h>
namespace cg = cooperative_groups;
namespace pg8 {
#define PG8_LAS __attribute__((address_space(3)))
typedef unsigned short bf16_t;
typedef short bf16x8 __attribute__((ext_vector_type(8)));
typedef float f32x4 __attribute__((ext_vector_type(4)));
typedef unsigned u32x4 __attribute__((ext_vector_type(4)));
constexpr int BM = 256, BK = 64, HALF = 128, HTB = HALF * BK * 2  , STAGE_BYTES = 8 * HTB, NXCD = 8, WGM = 8;

__host__ __device__ __forceinline__ int lds_byte(int r, int c) { const int st = (r >> 4) * 2 + (c >> 5), rr = r & 15, cc = c & 31, ob = rr * 64 + cc * 2; return st * 1024 + (ob ^ (((ob >> 9) & 1) << 5)); }
__host__ __device__ __forceinline__ void stage_rc(int b, int& R, int& C) { const int st = b / 1024, sb = b % 1024, swz = sb ^ (((sb >> 9) & 1) << 5); R = (st >> 1) * 16 + swz / 64; C = (st & 1) * 32 + (swz % 64) / 2; }
__host__ __device__ __forceinline__ int perm32(int rho) { const int n = rho >> 4, i = rho & 15; return 8 * (i >> 2) + 4 * n + (i & 3); }

struct Unit { int pm, pn; };
struct Gemm { const bf16_t* A; const bf16_t* Bt; int M, N, K; };

struct StaticOrder {
    int nM, nN, nwg, G, c;
    __host__ __device__ void init(int M, int N, int G_, int c_) { nM = M / BM; nN = N / BM; nwg = nM * nN; G = G_; c = c_; }
    __host__ __device__ bool next(int i, Unit& u) const {
        const long L = (long)i * G + c; if (L >= nwg) return false;
        int wgid = (int)L; { const int q = nwg / NXCD, r = nwg % NXCD, xcd = wgid % NXCD, off = wgid / NXCD; wgid = (xcd < r ? xcd * (q + 1) : r * (q + 1) + (xcd - r) * q) + off; }
        const int nig = WGM * nN, gid = wgid / nig, fm = gid * WGM, gsz = (nM - fm) < WGM ? (nM - fm) : WGM;
        u.pm = fm + ((wgid % nig) % gsz); u.pn = (wgid % nig) / gsz; return true;
    }
    __device__ __forceinline__ void a_ready(const Unit&) const {}
    __device__ __forceinline__ void done(const Unit&) const {}
};
__device__ __forceinline__ unsigned cvt_pk_bf16(float lo, float hi) { unsigned r; asm volatile("v_cvt_pk_bf16_f32 %0, %1, %2" : "=v"(r) : "v"(lo), "v"(hi)); return r; }
typedef float f32x2 __attribute__((ext_vector_type(2)));
typedef unsigned u32x2 __attribute__((ext_vector_type(2)));
__device__ __forceinline__ float silu_f(float a) { return a * __builtin_amdgcn_rcpf(1.0f + __expf(-a)); }
__device__ __forceinline__ float sigmoid_f(float a) { return __builtin_amdgcn_rcpf(1.0f + __expf(-a)); }
__device__ __forceinline__ float gelu_tanh(float y) { const float z = 1.5957691216f * (y + 0.044715f * y * y * y); return y * __builtin_amdgcn_rcpf(1.0f + __expf(-z)); }
__device__ __forceinline__ float bf_lo(unsigned w) { return __uint_as_float(w << 16); }
__device__ __forceinline__ float bf_hi(unsigned w) { return __uint_as_float(w & 0xffff0000u); }

struct EpiZ {
    static constexpr bool PERM = true, AFTER_DRAIN = false;
    bf16_t* O; int ldc;
    __device__ __forceinline__ void operator()(const f32x4 (&acc)[2][2][4][2], const Unit& u, int wr, int wc, int fr, int fq) const {
        const int row0 = u.pm * BM + wr * 64 + fr, col0 = u.pn * BM + wc * 32 + 8 * fq;
#pragma unroll
        for (int ai = 0; ai < 2; ++ai)
#pragma unroll
            for (int m = 0; m < 4; ++m) { bf16_t* rowp = O + (size_t)(row0 + ai * HALF + m * 16) * ldc + col0;
#pragma unroll
                for (int bj = 0; bj < 2; ++bj) { const f32x4 v0 = acc[ai][bj][m][0], v1 = acc[ai][bj][m][1];
                    u32x4 w; w.x = cvt_pk_bf16(v0[0], v0[1]); w.y = cvt_pk_bf16(v0[2], v0[3]); w.z = cvt_pk_bf16(v1[0], v1[1]); w.w = cvt_pk_bf16(v1[2], v1[3]);
                    *(u32x4*)(rowp + bj * HALF) = w; } }
    }
};
struct EpiSwiglu {
    static constexpr bool PERM = true, AFTER_DRAIN = false;
    bf16_t* O; int ldc;
    __device__ __forceinline__ void operator()(const f32x4 (&acc)[2][2][4][2], const Unit& u, int wr, int wc, int fr, int fq) const {
        const int row0 = u.pm * BM + wr * 64 + fr, col0 = u.pn * HALF + wc * 32 + 8 * fq;
#pragma unroll
        for (int ai = 0; ai < 2; ++ai)
#pragma unroll
            for (int m = 0; m < 4; ++m) { bf16_t* rowp = O + (size_t)(row0 + ai * HALF + m * 16) * ldc + col0;
                const f32x4 a0 = acc[ai][0][m][0], a1 = acc[ai][0][m][1], b0 = acc[ai][1][m][0], b1 = acc[ai][1][m][1];
                f32x4 v0, v1;
#pragma unroll
                for (int j = 0; j < 4; ++j) { v0[j] = silu_f(a0[j]) * b0[j]; v1[j] = silu_f(a1[j]) * b1[j]; }
                u32x4 w; w.x = cvt_pk_bf16(v0[0], v0[1]); w.y = cvt_pk_bf16(v0[2], v0[3]); w.z = cvt_pk_bf16(v1[0], v1[1]); w.w = cvt_pk_bf16(v1[2], v1[3]);
                __builtin_nontemporal_store(w, (u32x4*)rowp); }
    }
};
struct EpiResid {
    static constexpr bool PERM = true, AFTER_DRAIN = true;
    const bf16_t* xin; bf16_t* xout; float* fout; const float* gate; const float* gnext; const float* scnext; const float* shnext; bf16_t* xa; unsigned* xbuf; unsigned* cnt; float gs; unsigned need;
    __device__ __forceinline__ void fused(f32x4 (&acc)[2][2][4][2], const Unit& u, int wr, int wc, int fr, int fq, PG8_LAS unsigned char* lds, int wid, int lane) const {
        PG8_LAS float* P = (PG8_LAS float*)lds;
        PG8_LAS float* S = (PG8_LAS float*)(lds + 4096);
        const int row0 = u.pm * BM + wr * 64 + fr, col0 = u.pn * BM + wc * 32 + 8 * fq;
        const size_t cb = (size_t)(u.pm >> 3) * 9216 + col0;
        float sq[8];
#pragma unroll
        for (int i = 0; i < 8; ++i) sq[i] = 0.f;
#pragma unroll
        for (int bj = 0; bj < 2; ++bj) { const int co = bj * HALF;
            const f32x4 gv0 = *(const f32x4*)(gate + cb + co) * gs, gv1 = *(const f32x4*)(gate + cb + co + 4) * gs;
            u32x4 xwv[8];
#pragma unroll
            for (int i = 0; i < 8; ++i) xwv[i] = *(const u32x4*)(xin + (size_t)(row0 + (i >> 2) * HALF + (i & 3) * 16) * 1024 + col0 + co);
            asm volatile("" ::: "memory");
#pragma unroll
            for (int ai = 0; ai < 2; ++ai)
#pragma unroll
                for (int m = 0; m < 4; ++m) { const size_t off = (size_t)(row0 + ai * HALF + m * 16) * 1024 + col0 + co;
                    const u32x4 xw = xwv[ai * 4 + m];
                    const f32x4 xi0 = (f32x4){bf_lo(xw.x), bf_hi(xw.x), bf_lo(xw.y), bf_hi(xw.y)}, xi1 = (f32x4){bf_lo(xw.z), bf_hi(xw.z), bf_lo(xw.w), bf_hi(xw.w)};
                    const f32x4 xn0 = xi0 + gv0 * acc[ai][bj][m][0], xn1 = xi1 + gv1 * acc[ai][bj][m][1];
                    if (xa) { u32x4 ow; ow.x = cvt_pk_bf16(xn0[0], xn0[1]); ow.y = cvt_pk_bf16(xn0[2], xn0[3]); ow.z = cvt_pk_bf16(xn1[0], xn1[1]); ow.w = cvt_pk_bf16(xn1[2], xn1[3]);
                        *(u32x4*)(xout + off) = ow; }
                    acc[ai][bj][m][0] = xn0; acc[ai][bj][m][1] = xn1;
                    sq[ai * 4 + m] += ((xn0[0] * xn0[0] + xn0[1] * xn0[1]) + (xn0[2] * xn0[2] + xn0[3] * xn0[3])) + ((xn1[0] * xn1[0] + xn1[1] * xn1[1]) + (xn1[2] * xn1[2] + xn1[3] * xn1[3])); }
            asm volatile("" ::: "memory"); }
#pragma unroll
        for (int i = 0; i < 8; ++i) { float q = sq[i]; q += __shfl_xor(q, 16); q += __shfl_xor(q, 32);
            if (fq == 0) P[((i >> 2) * HALF + wr * 64 + (i & 3) * 16 + fr) * 4 + wc] = q; }
        asm volatile("s_waitcnt lgkmcnt(0)" ::: "memory"); __builtin_amdgcn_s_barrier(); asm volatile("" ::: "memory");
        const int row = wid * 32 + (lane & 31);
        if (lane < 32) { const f32x4 p = *(const PG8_LAS f32x4*)(P + row * 4); const float s = (p[0] + p[1]) + (p[2] + p[3]);
            __hip_atomic_store(xbuf + ((size_t)(u.pm * BM + row) * 4 + u.pn), __float_as_uint(s), __ATOMIC_RELAXED, __HIP_MEMORY_SCOPE_AGENT); }
        asm volatile("s_waitcnt vmcnt(0)" ::: "memory");
        if (lane == 0) __hip_atomic_fetch_add(cnt + 64 * u.pm, 1u, __ATOMIC_RELAXED, __HIP_MEMORY_SCOPE_AGENT);
        if (wid == 0) {
            unsigned spins = 0;
            while ((unsigned)__builtin_amdgcn_readfirstlane(__hip_atomic_load(cnt + 64 * u.pm, __ATOMIC_RELAXED, __HIP_MEMORY_SCOPE_AGENT)) < need) { __builtin_amdgcn_s_sleep(2); if (++spins > (1u << 22)) break; }
            __builtin_amdgcn_fence(__ATOMIC_ACQUIRE, "agent");
        }
        asm volatile("s_waitcnt vmcnt(0) lgkmcnt(0)" ::: "memory"); __builtin_amdgcn_s_barrier(); asm volatile("" ::: "memory");
        if (lane < 32) { const unsigned* slot = xbuf + (size_t)(u.pm * BM + row) * 4; float t = 0.f;
#pragma unroll
            for (int k = 0; k < 4; ++k) t += __uint_as_float(__hip_atomic_load(slot + k, __ATOMIC_RELAXED, __HIP_MEMORY_SCOPE_AGENT));
            S[row] = __builtin_amdgcn_rsqf(t * (1.0f / 1024.0f) + 1e-6f); }
        asm volatile("s_waitcnt vmcnt(0) lgkmcnt(0)" ::: "memory"); __builtin_amdgcn_s_barrier(); asm volatile("" ::: "memory");
        if (xa == nullptr) {
#pragma unroll
            for (int bj = 0; bj < 2; ++bj) { const int co = bj * HALF; const f32x4 g0 = *(const f32x4*)(gnext + col0 + co), g1 = *(const f32x4*)(gnext + col0 + co + 4);
#pragma unroll
                for (int ai = 0; ai < 2; ++ai)
#pragma unroll
                    for (int m = 0; m < 4; ++m) { const int r = ai * HALF + wr * 64 + m * 16 + fr; const float rs = S[r]; float* op = fout + (size_t)(u.pm * BM + r) * 1024 + col0 + co;
                        *(f32x4*)op = acc[ai][bj][m][0] * rs * g0; *(f32x4*)(op + 4) = acc[ai][bj][m][1] * rs * g1; } }
            asm volatile("s_waitcnt lgkmcnt(0)" ::: "memory"); __builtin_amdgcn_s_barrier(); asm volatile("" ::: "memory");
            return;
        }
#pragma unroll
        for (int bj = 0; bj < 2; ++bj) { const int co = bj * HALF;
            const f32x4 gm0 = *(const f32x4*)(gnext + col0 + co) * (*(const f32x4*)(scnext + cb + co) + 1.0f), gm1 = *(const f32x4*)(gnext + col0 + co + 4) * (*(const f32x4*)(scnext + cb + co + 4) + 1.0f);
            const f32x4 sh0 = *(const f32x4*)(shnext + cb + co), sh1 = *(const f32x4*)(shnext + cb + co + 4);
#pragma unroll
            for (int ai = 0; ai < 2; ++ai)
#pragma unroll
                for (int m = 0; m < 4; ++m) { const int r = ai * HALF + wr * 64 + m * 16 + fr; const float rs = S[r];
                    const f32x4 y0 = acc[ai][bj][m][0] * rs * gm0 + sh0, y1 = acc[ai][bj][m][1] * rs * gm1 + sh1;
                    u32x4 w; w.x = cvt_pk_bf16(y0[0], y0[1]); w.y = cvt_pk_bf16(y0[2], y0[3]); w.z = cvt_pk_bf16(y1[0], y1[1]); w.w = cvt_pk_bf16(y1[2], y1[3]);
                    *(u32x4*)(xa + (size_t)(u.pm * BM + r) * 1024 + col0 + co) = w; } }
        asm volatile("s_waitcnt lgkmcnt(0)" ::: "memory"); __builtin_amdgcn_s_barrier(); asm volatile("" ::: "memory");
    }
};
struct EpiGlu {
    static constexpr bool PERM = false, AFTER_DRAIN = true;
    const bf16_t* yg; const float* glu_b; const float* gn; bf16_t* ycat;
    __device__ __forceinline__ void fused(f32x4 (&acc)[2][2][4][2], const Unit& u, int wr, int wc, int fr, int fq, PG8_LAS unsigned char* lds, int wid, int lane) const {
        PG8_LAS float* P = (PG8_LAS float*)lds;
        const int col0 = wc * 32 + 4 * fq;
        f32x4 gb[2][2];
#pragma unroll
        for (int bj = 0; bj < 2; ++bj)
#pragma unroll
            for (int n = 0; n < 2; ++n) gb[bj][n] = *(const f32x4*)(glu_b + col0 + bj * HALF + n * 16);
#pragma unroll
        for (int ai = 0; ai < 2; ++ai)
#pragma unroll
            for (int m = 0; m < 4; ++m) { const int r = ai * HALF + wr * 64 + m * 16 + fr; const bf16_t* yp = yg + (size_t)(u.pm * BM + r) * 256 + col0; float s = 0.f;
#pragma unroll
                for (int bj = 0; bj < 2; ++bj)
#pragma unroll
                    for (int n = 0; n < 2; ++n) { const u32x2 yw = *(const u32x2*)(yp + bj * HALF + n * 16);
                        const f32x4 y = (f32x4){bf_lo(yw.x), bf_hi(yw.x), bf_lo(yw.y), bf_hi(yw.y)}; const f32x4 a = acc[ai][bj][m][n] + gb[bj][n]; f32x4 o;
#pragma unroll
                        for (int j = 0; j < 4; ++j) { o[j] = y[j] * sigmoid_f(a[j]); s += o[j] * o[j]; }
                        acc[ai][bj][m][n] = o; }
                s += __shfl_xor(s, 16); s += __shfl_xor(s, 32);
                if (fq == 0) P[r * 4 + wc] = s; }
        asm volatile("s_waitcnt lgkmcnt(0)" ::: "memory"); __builtin_amdgcn_s_barrier(); asm volatile("" ::: "memory");
        f32x4 gg[2][2];
#pragma unroll
        for (int bj = 0; bj < 2; ++bj)
#pragma unroll
            for (int n = 0; n < 2; ++n) gg[bj][n] = *(const f32x4*)(gn + col0 + bj * HALF + n * 16);
#pragma unroll
        for (int ai = 0; ai < 2; ++ai)
#pragma unroll
            for (int m = 0; m < 4; ++m) { const int r = ai * HALF + wr * 64 + m * 16 + fr; const f32x4 pp = *(const PG8_LAS f32x4*)(P + r * 4);
                const float rstd = 1.0f / sqrtf(((pp[0] + pp[1]) + (pp[2] + pp[3])) * (1.0f / 256.0f) + 1e-6f);
                bf16_t* op = ycat + (size_t)(u.pm * BM + r) * 1024 + 768 + col0;
#pragma unroll
                for (int bj = 0; bj < 2; ++bj)
#pragma unroll
                    for (int n = 0; n < 2; ++n) { const f32x4 o = acc[ai][bj][m][n] * rstd * gg[bj][n]; u32x2 w; w.x = cvt_pk_bf16(o[0], o[1]); w.y = cvt_pk_bf16(o[2], o[3]);
                        *(u32x2*)(op + bj * HALF + n * 16) = w; } }
        asm volatile("s_waitcnt lgkmcnt(0)" ::: "memory"); __builtin_amdgcn_s_barrier(); asm volatile("" ::: "memory");
    }
};

template <class Epi, class Sched, bool STAMP = false>
__device__ __forceinline__ void gemm_phase(PG8_LAS unsigned char* lds, const Gemm g, const Sched& S, const Epi& E, unsigned long long* stamps, const int tid) {
    const int wid = __builtin_amdgcn_readfirstlane(tid >> 6), lane = tid & 63, wr = wid >> 2, wc = wid & 3, fr = lane & 15, fq = lane >> 4;
    const int K = g.K, nt = K / BK;
    int ts_lo = 0, ts_hi = 0, nts = 0; const unsigned long long rt_entry = STAMP ? (unsigned long long)wall_clock64() : 0ull;
#define PG8_STAMP() do { if (STAMP && wid == 0 && nts < 64) { const unsigned long long _c = (unsigned long long)clock64(); \
        ts_lo = (lane == nts) ? (int)(unsigned)_c : ts_lo; ts_hi = (lane == nts) ? (int)(unsigned)(_c >> 32) : ts_hi; ++nts; } } while (0)
    PG8_STAMP();
    unsigned voffA[2], voffB[2];
#pragma unroll
    for (int i = 0; i < 2; ++i) { int R, C; stage_rc(tid * 16 + i * 8192, R, C); const int Rb = Epi::PERM ? ((R & ~31) + perm32(R & 31)) : R;
        voffA[i] = (unsigned)(R * K + C) * 2u; voffB[i] = (unsigned)(Rb * K + C) * 2u; }
    const size_t kstep = (size_t)(BK * 2);
    const size_t hstep = (size_t)HALF * K * 2;
    const size_t tstep = 2 * hstep;
    const unsigned ldsw = (unsigned)wid * 1024u;
    const int aoff = lds_byte(wr * 64 + fr, fq * 8), boff = lds_byte(wc * 32 + fr, fq * 8);
#define PG8_SA(b, h) (((b) * 2 + (h)) * HTB)
#define PG8_SB(b, h) ((4 + (b) * 2 + (h)) * HTB)
#define PG8_STAGE(bufoff, gbase, voff) do { _Pragma("unroll") for (int _i = 0; _i < 2; ++_i) \
        __builtin_amdgcn_global_load_lds((const unsigned*)((const char*)(gbase) + (voff)[_i]), (PG8_LAS unsigned*)(lds + (bufoff) + ldsw + _i * 8192), 16, 0, 0); } while (0)
#define PG8_LDA(dst, b, h) do { _Pragma("unroll") for (int m = 0; m < 4; ++m) _Pragma("unroll") for (int k = 0; k < 2; ++k) dst[m][k] = *(const PG8_LAS bf16x8*)(lds + PG8_SA(b, h) + aoff + m * 2048 + k * 1024); } while (0)
#define PG8_LDB(dst, b, h) do { _Pragma("unroll") for (int n = 0; n < 2; ++n) _Pragma("unroll") for (int k = 0; k < 2; ++k) dst[n][k] = *(const PG8_LAS bf16x8*)(lds + PG8_SB(b, h) + boff + n * 2048 + k * 1024); } while (0)
#define PG8_MMA(ai, bj, At, Bt) do { __builtin_amdgcn_s_setprio(1); _Pragma("unroll") for (int m = 0; m < 4; ++m) _Pragma("unroll") for (int n = 0; n < 2; ++n) _Pragma("unroll") for (int k = 0; k < 2; ++k) \
        acc[ai][bj][m][n] = __builtin_amdgcn_mfma_f32_16x16x32_bf16(Bt[n][k], At[m][k], acc[ai][bj][m][n], 0, 0, 0); __builtin_amdgcn_s_setprio(0); } while (0)
#define PG8_WAIT_V(n) asm volatile("s_waitcnt vmcnt(" #n ")" ::: "memory")
#define PG8_WAIT_L(n) asm volatile("s_waitcnt lgkmcnt(" #n ")" ::: "memory")
#define PG8_BAR __builtin_amdgcn_s_barrier()
#define PG8_SCHED __builtin_amdgcn_sched_barrier(0)
    Unit cur, nxt; int ui = 0;
    if (!S.next(0, cur)) return;
    f32x4 acc[2][2][4][2];
#pragma unroll
    for (int a = 0; a < 2; ++a)
#pragma unroll
        for (int b = 0; b < 2; ++b)
#pragma unroll
            for (int m = 0; m < 4; ++m)
#pragma unroll
                for (int n = 0; n < 2; ++n) acc[a][b][m][n] = (f32x4){0.f, 0.f, 0.f, 0.f};
    bf16x8 At[4][2], B0[2][2], B1[2][2];
    const char* cA = (const char*)g.A + (size_t)cur.pm * tstep; const char* cB = (const char*)g.Bt + (size_t)cur.pn * tstep;
    S.a_ready(cur);
    PG8_STAGE(PG8_SB(0, 0), cB, voffB); PG8_STAGE(PG8_SA(0, 0), cA, voffA); PG8_STAGE(PG8_SB(0, 1), cB + hstep, voffB); PG8_STAGE(PG8_SA(0, 1), cA + hstep, voffA);
    if (wr == 1) PG8_BAR;
    PG8_WAIT_V(4); PG8_BAR;
    PG8_STAGE(PG8_SB(1, 0), cB + kstep, voffB); PG8_STAGE(PG8_SA(1, 0), cA + kstep, voffA); PG8_STAGE(PG8_SB(1, 1), cB + hstep + kstep, voffB);
    PG8_WAIT_V(6); PG8_BAR;
    PG8_STAMP();
    for (;;) {
        const bool has_next = S.next(ui + 1, nxt);
        const char* nA = has_next ? (const char*)g.A + (size_t)nxt.pm * tstep : cA; const char* nB = has_next ? (const char*)g.Bt + (size_t)nxt.pn * tstep : cB;
        for (int t = 0; t < nt; t += 2) {
            const bool last = (t == nt - 2);
            const char* a1 = cA + (size_t)(t + 1) * kstep;
            const char* a2 = last ? nA : cA + (size_t)(t + 2) * kstep; const char* b2 = last ? nB : cB + (size_t)(t + 2) * kstep;
            const char* a3 = a2 + kstep; const char* b3 = b2 + kstep;
            if (last && has_next) S.a_ready(nxt);
            PG8_LDB(B0, 0, 0); PG8_SCHED; PG8_LDA(At, 0, 0); PG8_STAGE(PG8_SA(1, 1), a1 + hstep, voffA);
            PG8_WAIT_L(8); PG8_BAR; PG8_WAIT_L(0); PG8_MMA(0, 0, At, B0); PG8_BAR; PG8_SCHED;
            PG8_LDB(B1, 0, 1); PG8_STAGE(PG8_SB(0, 0), b2, voffB);
            PG8_BAR; PG8_WAIT_L(0); PG8_MMA(0, 1, At, B1); PG8_BAR;
            PG8_LDA(At, 0, 1); PG8_STAGE(PG8_SA(0, 0), a2, voffA);
            PG8_BAR; PG8_WAIT_L(0); PG8_MMA(1, 0, At, B0); PG8_BAR; PG8_SCHED;
            PG8_STAGE(PG8_SB(0, 1), b2 + hstep, voffB);
            PG8_WAIT_V(6); PG8_BAR; PG8_MMA(1, 1, At, B1); PG8_BAR;
            PG8_LDB(B0, 1, 0); PG8_SCHED; PG8_LDA(At, 1, 0); PG8_STAGE(PG8_SA(0, 1), a2 + hstep, voffA);
            PG8_WAIT_L(8); PG8_BAR; PG8_WAIT_L(0); PG8_MMA(0, 0, At, B0); PG8_BAR; PG8_SCHED;
            PG8_LDB(B1, 1, 1); PG8_STAGE(PG8_SB(1, 0), b3, voffB);
            PG8_BAR; PG8_WAIT_L(0); PG8_MMA(0, 1, At, B1); PG8_BAR;
            PG8_LDA(At, 1, 1); PG8_STAGE(PG8_SA(1, 0), a3, voffA);
            PG8_BAR; PG8_WAIT_L(0); PG8_MMA(1, 0, At, B0); PG8_BAR; PG8_SCHED;
            PG8_STAGE(PG8_SB(1, 1), b3 + hstep, voffB);
            PG8_WAIT_V(6); PG8_BAR; PG8_MMA(1, 1, At, B1); PG8_BAR;
        }
        PG8_STAMP();
        if constexpr (!Epi::AFTER_DRAIN) { E(acc, cur, wr, wc, fr, fq); S.done(cur); }
        PG8_STAMP();
        if (!has_next) break;
#pragma unroll
        for (int a = 0; a < 2; ++a)
#pragma unroll
            for (int b = 0; b < 2; ++b)
#pragma unroll
                for (int m = 0; m < 4; ++m)
#pragma unroll
                    for (int n = 0; n < 2; ++n) acc[a][b][m][n] = (f32x4){0.f, 0.f, 0.f, 0.f};
        cur = nxt; cA = nA; cB = nB; ++ui;
    }
    PG8_WAIT_V(0);
    if (wr == 0) PG8_BAR;
    PG8_BAR;
    if constexpr (Epi::AFTER_DRAIN) { E.fused(acc, cur, wr, wc, fr, fq, lds, wid, lane); S.done(cur); }
    PG8_STAMP();
    if (STAMP && wid == 0) { stamps[lane] = lane < nts ? (((unsigned long long)(unsigned)ts_hi << 32) | (unsigned)ts_lo) : 0ull;
        if (lane == 62) stamps[62] = rt_entry; if (lane == 63) stamps[63] = (unsigned long long)wall_clock64(); }
#undef PG8_STAMP
#undef PG8_SA
#undef PG8_SB
#undef PG8_STAGE
#undef PG8_LDA
#undef PG8_LDB
#undef PG8_MMA
#undef PG8_WAIT_V
#undef PG8_WAIT_L
#undef PG8_BAR
#undef PG8_SCHED
}
}

#define LAS __attribute__((address_space(3)))
typedef unsigned short bf16;
using pg8::f32x4; using pg8::bf16x8; using pg8::u32x4; using pg8::u32x2; using pg8::cvt_pk_bf16; using pg8::bf_lo; using pg8::bf_hi; using pg8::gelu_tanh;

constexpr int M = 16384, D = 1024, DFF = 2816, PIN = 1792, NL = 4, NCOND = 9216;
constexpr float EPS = 1e-6f;
constexpr size_t MiB = (size_t)1 << 20;
constexpr size_t WS_BAR = 7 * MiB, BAR_BYTES = 32768;
constexpr size_t WS_COND = 0, WS_E = 2 * MiB, WS_W = 8 * MiB, LW = 39 * MiB;
constexpr size_t OW_IN1 = 0, OW_OUT1 = 11 * MiB, OW_MIX = OW_OUT1 + 11 * MiB / 2, OW_MO = OW_MIX + 7 * MiB / 2, OW_IN2 = OW_MO + 2 * MiB, OW_OUT2 = OW_IN2 + 11 * MiB, OW_GLU = OW_OUT2 + 11 * MiB / 2;
static_assert(OW_GLU + 131072 <= LW, "weights per layer");
constexpr size_t WS_H = 164 * MiB, WS_ACT = 196 * MiB, WS_Z = 284 * MiB, WS_YG = 340 * MiB, WS_YCAT = 348 * MiB, WS_SHW = 380 * MiB, WS_SS = 383 * MiB, WS_XB = 384 * MiB, WS_END = 416 * MiB;
constexpr int LDS_BYTES = 147456;
#ifndef SGU_REP
#define SGU_REP 1
#endif
#ifndef S5_REP
#define S5_REP 1
#endif
#ifndef PC_REP
#define PC_REP 1
#endif
#ifndef PREP_REP
#define PREP_REP 1
#endif
#ifndef PREP_TILE_REP
#define PREP_TILE_REP 1
#endif
#ifndef TPROBE
#define TPROBE 0
#endif
#ifndef SLOT_MAP
#define SLOT_MAP 0x87653210ull
#define SLOT_REP 0u
#define NSLOT 8
#endif
constexpr int NPH = 2 + NL * NSLOT;
constexpr int TILES_PER_LAYER = 176 + 88 + 48 + 32 + 176 + 88 + 2;

struct Args { const float* in[30]; float* out; unsigned char* ws; int ph_lo, ph_hi; };
typedef const Args __attribute__((address_space(4)))& ArgsRef;

__device__ __forceinline__ float wave_sum(float v) {
#pragma unroll
    for (int o = 1; o < 64; o <<= 1) v += __shfl_xor(v, o);
    return v;
}
#define LDS_WAIT() asm volatile("s_waitcnt lgkmcnt(0)" ::: "memory")

struct TileDesc { const float* W; bf16* WT; int K, N, k0, n0, swiglu; };
__device__ __forceinline__ TileDesc tile_decode(ArgsRef a, int item) {
    const int l = item / TILES_PER_LAYER; int r = item % TILES_PER_LAYER;
    unsigned char* wl = a.ws + WS_W + (size_t)l * LW; TileDesc t;
    if (r < 176) t = TileDesc{a.in[5] + (size_t)l * 1024 * 5632, (bf16*)(wl + OW_IN1), 1024, 5632, 128 * (r / 22), 256 * (r % 22), 1};
    else if ((r -= 176) < 88) t = TileDesc{a.in[6] + (size_t)l * DFF * 1024, (bf16*)(wl + OW_OUT1), DFF, 1024, 128 * (r / 4), 256 * (r % 4), 0};
    else if ((r -= 88) < 48) { const int nb = r % 6; t = TileDesc{a.in[8] + (size_t)l * 1024 * PIN, (bf16*)(wl + OW_MIX), 1024, PIN, 128 * (r / 6), 256 * (nb < 2 ? nb : nb + 1), 0}; }
    else if ((r -= 48) < 32) t = TileDesc{a.in[25] + (size_t)l * 1024 * 1024, (bf16*)(wl + OW_MO), 1024, 1024, 128 * (r / 4), 256 * (r % 4), 0};
    else if ((r -= 32) < 176) t = TileDesc{a.in[27] + (size_t)l * 1024 * 5632, (bf16*)(wl + OW_IN2), 1024, 5632, 128 * (r / 22), 256 * (r % 22), 1};
    else if ((r -= 176) < 88) t = TileDesc{a.in[28] + (size_t)l * DFF * 1024, (bf16*)(wl + OW_OUT2), DFF, 1024, 128 * (r / 4), 256 * (r % 4), 0};
    else { r -= 88; t = TileDesc{a.in[22] + (size_t)l * 65536, (bf16*)(wl + OW_GLU), 256, 256, 128 * r, 0, 0}; }
    return t;
}
__device__ __forceinline__ void tile_load(const TileDesc& t, float (&v)[16][4], int wave, int lane) {
    const float* wp = t.W + (size_t)(t.k0 + 16 * wave) * t.N + t.n0 + lane;
#pragma unroll
    for (int r = 0; r < 16; ++r)
#pragma unroll
        for (int e = 0; e < 4; ++e) v[r][e] = __builtin_nontemporal_load(wp + (size_t)r * t.N + 64 * e);
}
__device__ __forceinline__ void tile_to_lds(const float (&v)[16][4], LAS unsigned char* lds, int wave, int lane) {
#pragma unroll
    for (int e = 0; e < 4; ++e)
#pragma unroll
        for (int hq = 0; hq < 2; ++hq) { u32x4 o; o.x = cvt_pk_bf16(v[8 * hq][e], v[8 * hq + 1][e]); o.y = cvt_pk_bf16(v[8 * hq + 2][e], v[8 * hq + 3][e]); o.z = cvt_pk_bf16(v[8 * hq + 4][e], v[8 * hq + 5][e]); o.w = cvt_pk_bf16(v[8 * hq + 6][e], v[8 * hq + 7][e]);
            *(LAS u32x4*)(lds + (lane + 64 * e) * 272 + (16 * wave + 8 * hq) * 2) = o; }
}
__device__ __forceinline__ void tile_store(const TileDesc& t, LAS unsigned char* lds, int wave, int lane) {
#pragma unroll
    for (int j = 0; j < 8; ++j) { const int nl = 32 * wave + 4 * j + (lane >> 4), n = t.n0 + nl;
        const u32x4 o = *(const LAS u32x4*)(lds + nl * 272 + 16 * (lane & 15));
        const int dsw = n < DFF ? (n >> 7) * 256 + (n & 127) : ((n - DFF) >> 7) * 256 + 128 + ((n - DFF) & 127);
        const int dst = t.swiglu ? dsw : n;
        *(u32x4*)(t.WT + (size_t)dst * t.K + t.k0 + 8 * (lane & 15)) = o; }
}

__device__ __forceinline__ void prep_phase(ArgsRef a, LAS unsigned char* lds, int tid, int wave, int lane, int G) {
    LAS float* sc = (LAS float*)lds;
    LAS float* R = (LAS float*)(lds + 32768);
    float* cond = (float*)(a.ws + WS_COND);
    const bool cond_blk = (G >= 256) ? (blockIdx.x < 144) : true;
    if (cond_blk) {
        const float* c_in = a.in[1];
        for (int i = tid; i < 8 * 1024; i += 512) { const float v = c_in[i]; sc[i] = v / (1.0f + expf(-v)); }
        __syncthreads();
        for (int it = blockIdx.x; it < NL * 36; it += (G >= 256 ? 144 : G)) {
            const int l = it / 36, n0 = 256 * (it % 36);
            const float* wp = a.in[2] + ((size_t)l * 1024 + 128 * wave) * NCOND + n0 + 4 * lane;
            f32x4 acc[8];
#pragma unroll
            for (int b = 0; b < 8; ++b) acc[b] = (f32x4){0.f, 0.f, 0.f, 0.f};
            for (int k0 = 0; k0 < 128; k0 += 8) {
                f32x4 wv[8];
#pragma unroll
                for (int kk = 0; kk < 8; ++kk) wv[kk] = __builtin_nontemporal_load((const f32x4*)(wp + (size_t)(k0 + kk) * NCOND));
#pragma unroll
                for (int q = 0; q < 2; ++q)
#pragma unroll
                    for (int b = 0; b < 8; ++b) { const f32x4 s4 = *(const LAS f32x4*)(sc + b * 1024 + 128 * wave + k0 + 4 * q);
#pragma unroll
                        for (int e = 0; e < 4; ++e) acc[b] += wv[4 * q + e] * s4[e]; }
            }
#pragma unroll
            for (int b = 0; b < 8; ++b) *(LAS f32x4*)(R + (wave * 8 + b) * 256 + 4 * lane) = acc[b];
            __syncthreads();
            { const int b = wave; f32x4 s = *(const f32x4*)(a.in[3] + (size_t)l * NCOND + n0 + 4 * lane);
#pragma unroll
              for (int w = 0; w < 8; ++w) s += *(const LAS f32x4*)(R + (w * 8 + b) * 256 + 4 * lane);
              *(f32x4*)(cond + ((size_t)l * 8 + b) * NCOND + n0 + 4 * lane) = s; }
            __syncthreads();
        }
    }
    int first, stride, count;
    if (G >= 256) { if (blockIdx.x < 144) { first = blockIdx.x * 7; stride = 1; count = 7; } else { count = (NL * TILES_PER_LAYER - 1008 + (G - 144) - 1) / (G - 144); first = 1008 + (blockIdx.x - 144) * count; stride = 1; } }
    else { first = blockIdx.x; stride = G; count = (NL * TILES_PER_LAYER + G - 1) / G; }
    for (int rp = 0; rp < PREP_TILE_REP; ++rp)
    {
        int lim = NL * TILES_PER_LAYER; if (G >= 256 && blockIdx.x < 144) lim = 1008;
        int nt = 0; for (int j = 0; j < count; ++j) if (first + j * stride < lim) nt = j + 1;
        float v[16][4];
        TileDesc cur = tile_decode(a, nt > 0 ? first : 0);
        if (nt > 0) tile_load(cur, v, wave, lane);
        for (int j = 0; j < nt; ++j) {
            tile_to_lds(v, lds, wave, lane);
            TileDesc nxt = cur;
            if (j + 1 < nt) { nxt = tile_decode(a, first + (j + 1) * stride); tile_load(nxt, v, wave, lane); }
            __syncthreads();
            tile_store(cur, lds, wave, lane);
            __syncthreads();
            cur = nxt;
        }
    }
    const int gw = blockIdx.x * 8 + wave, NGW = G * 8;
    LAS float* F = (LAS float*)(lds + wave * 2048);
    for (int item = gw; item < NL * 512; item += NGW) {
        const int l = item >> 9, r = item & 511, kb = r >> 5, n8 = r & 31, g = n8 >> 3, d0 = 8 * (n8 & 7), k = 64 * kb + lane;
        unsigned char* wl = a.ws + WS_W + (size_t)l * LW;
        const float* pw = a.in[11] + (size_t)(l * 4 + g) * 4096 + (size_t)lane * 64 + d0;
        const f32x4 p0 = *(const f32x4*)pw, p1 = *(const f32x4*)(pw + 4);
        const float* wr = a.in[8] + ((size_t)l * 1024 + k) * PIN + 512 + 64 * g;
        f32x4 wrow[16];
#pragma unroll
        for (int j = 0; j < 16; ++j) wrow[j] = *(const f32x4*)(wr + 4 * j);
        const float* ps = a.in[12] + (size_t)l * 256 + 64 * g + d0;
        const f32x4 s0 = *(const f32x4*)ps, s1 = *(const f32x4*)(ps + 4);
        *(LAS f32x4*)(F + lane * 8) = p0; *(LAS f32x4*)(F + lane * 8 + 4) = p1;
        LDS_WAIT();
        f32x4 a0 = (f32x4){0.f, 0.f, 0.f, 0.f}, a1 = a0;
#pragma unroll
        for (int j = 0; j < 16; ++j)
#pragma unroll
            for (int e = 0; e < 4; ++e) { const int c = 4 * j + e; const f32x4 f0 = *(const LAS f32x4*)(F + c * 8), f1 = *(const LAS f32x4*)(F + c * 8 + 4);
                a0 += f0 * wrow[j][e]; a1 += f1 * wrow[j][e]; }
        a0 = a0 * s0; a1 = a1 * s1;
        bf16* WT = (bf16*)(wl + OW_MIX) + (size_t)(512 + 64 * g + d0) * 1024 + k;
#pragma unroll
        for (int i = 0; i < 4; ++i) { WT[(size_t)i * 1024] = (bf16)(cvt_pk_bf16(a0[i], 0.f) & 0xffffu); WT[(size_t)(4 + i) * 1024] = (bf16)(cvt_pk_bf16(a1[i], 0.f) & 0xffffu); }
        LDS_WAIT();
    }
}

__device__ __forceinline__ void norm_phase(const float* x, const float* g, const float* sh, const float* scl, bf16* h, bf16* xb, int gw, int NGW, int lane) {
    for (int row = gw; row < M; row += NGW) {
        const f32x4* xr = (const f32x4*)(x + (size_t)row * D) + lane;
        f32x4 v[4]; float s = 0.f;
#pragma unroll
        for (int j = 0; j < 4; ++j) { v[j] = xr[64 * j]; s += (v[j][0] * v[j][0] + v[j][1] * v[j][1]) + (v[j][2] * v[j][2] + v[j][3] * v[j][3]); }
        const float rstd = 1.0f / sqrtf(wave_sum(s) * (1.0f / D) + EPS);
        const size_t cb = (size_t)(row >> 11) * NCOND;
        u32x2* o = (u32x2*)(h + (size_t)row * D) + lane;
        u32x2* ob = (u32x2*)(xb + (size_t)row * D) + lane;
#pragma unroll
        for (int j = 0; j < 4; ++j) { u32x2 w; w.x = cvt_pk_bf16(v[j][0], v[j][1]); w.y = cvt_pk_bf16(v[j][2], v[j][3]); ob[64 * j] = w; }
#pragma unroll
        for (int j = 0; j < 4; ++j) { const int col = 4 * lane + 256 * j;
            const f32x4 gg = *(const f32x4*)(g + col), ss = *(const f32x4*)(scl + cb + col), hh = *(const f32x4*)(sh + cb + col);
            const f32x4 y = (v[j] * rstd * gg) * (ss + 1.0f) + hh;
            u32x2 w; w.x = cvt_pk_bf16(y[0], y[1]); w.y = cvt_pk_bf16(y[2], y[3]); o[64 * j] = w; }
    }
}
__device__ __forceinline__ void final_norm_phase(float* x, const float* g, int gw, int NGW, int lane) {
    for (int row = gw; row < M; row += NGW) {
        f32x4* xr = (f32x4*)(x + (size_t)row * D) + lane;
        f32x4 v[4]; float s = 0.f;
#pragma unroll
        for (int j = 0; j < 4; ++j) { v[j] = xr[64 * j]; s += (v[j][0] * v[j][0] + v[j][1] * v[j][1]) + (v[j][2] * v[j][2] + v[j][3] * v[j][3]); }
        const float rstd = 1.0f / sqrtf(wave_sum(s) * (1.0f / D) + EPS);
#pragma unroll
        for (int j = 0; j < 4; ++j) { const f32x4 gg = *(const f32x4*)(g + 4 * lane + 256 * j); xr[64 * j] = v[j] * rstd * gg; }
    }
}

__device__ __forceinline__ f32x4 ld4bf(const bf16* p) { const u32x2 w = *(const u32x2*)p; return (f32x4){bf_lo(w.x), bf_hi(w.x), bf_lo(w.y), bf_hi(w.y)}; }
__device__ __forceinline__ void st4bf(bf16* p, f32x4 v) { u32x2 w; w.x = cvt_pk_bf16(v[0], v[1]); w.y = cvt_pk_bf16(v[2], v[3]); *(u32x2*)p = w; }
__device__ __forceinline__ bf16x8 pack8(f32x4 lo, f32x4 hi) { u32x4 w; w.x = cvt_pk_bf16(lo[0], lo[1]); w.y = cvt_pk_bf16(lo[2], lo[3]); w.z = cvt_pk_bf16(hi[0], hi[1]); w.w = cvt_pk_bf16(hi[2], hi[3]); return __builtin_bit_cast(bf16x8, w); }

__device__ __forceinline__ void sgu_item(ArgsRef a, int l, int it, LAS unsigned char* lds, int tid, int wave, int lane) {
    const bf16* z = (const bf16*)(a.ws + WS_Z); bf16* ycat = (bf16*)(a.ws + WS_YCAT);
    LAS bf16* vT = (LAS bf16*)lds;
    const int tok0 = it * 128;
    { const int s = tid >> 2, q = tid & 3;
      u32x4 raw[4][2];
#pragma unroll
      for (int h = 0; h < 4; ++h) { const u32x4* zp = (const u32x4*)(z + (size_t)(tok0 + s) * PIN + 256 + 64 * h + 16 * q); raw[h][0] = zp[0]; raw[h][1] = zp[1]; }
#pragma unroll
      for (int h = 0; h < 4; ++h) {
          float v[16]; float sum = 0.f;
#pragma unroll
          for (int j = 0; j < 2; ++j) { const u32x4 rw = raw[h][j]; const unsigned ww[4] = {rw.x, rw.y, rw.z, rw.w};
#pragma unroll
              for (int e = 0; e < 4; ++e) { v[8 * j + 2 * e] = gelu_tanh(bf_lo(ww[e])); v[8 * j + 2 * e + 1] = gelu_tanh(bf_hi(ww[e])); sum += v[8 * j + 2 * e] + v[8 * j + 2 * e + 1]; } }
          sum += __shfl_xor(sum, 1); sum += __shfl_xor(sum, 2);
          const float mu = sum * (1.0f / 64.0f); float q2 = 0.f;
#pragma unroll
          for (int e = 0; e < 16; ++e) { v[e] -= mu; q2 += v[e] * v[e]; }
          q2 += __shfl_xor(q2, 1); q2 += __shfl_xor(q2, 2);
          const float rs = 1.0f / sqrtf(q2 * (1.0f / 64.0f) + EPS);
#pragma unroll
          for (int e = 0; e < 16; ++e) vT[(64 * h + 16 * q + e) * 136 + s] = (bf16)(cvt_pk_bf16(v[e] * rs, 0.f) & 0xffffu);
      } }
    __syncthreads();
    const int fr = lane & 15, fq = lane >> 4, t = 16 * wave + fr, nks = (wave >> 1) + 1;
    f32x4 acc[16];
#pragma unroll
    for (int i = 0; i < 16; ++i) acc[i] = (f32x4){0.f, 0.f, 0.f, 0.f};
    {
        const float* wbase = a.in[9] + ((size_t)(l * 4) * 128 + t) * 128 + 8 * fq;
        f32x4 wq[2][4][2];
#pragma unroll
        for (int ks = 0; ks < 4; ++ks) { wq[0][ks][0] = (f32x4){0.f, 0.f, 0.f, 0.f}; wq[0][ks][1] = wq[0][ks][0];
            if (ks < nks) { wq[0][ks][0] = *(const f32x4*)(wbase + 32 * ks); wq[0][ks][1] = *(const f32x4*)(wbase + 32 * ks + 4); } }
#pragma unroll
        for (int h = 0; h < 4; ++h) {
            if (h < 3) {
#pragma unroll
                for (int ks = 0; ks < 4; ++ks) { wq[(h + 1) & 1][ks][0] = (f32x4){0.f, 0.f, 0.f, 0.f}; wq[(h + 1) & 1][ks][1] = wq[(h + 1) & 1][ks][0];
                    if (ks < nks) { wq[(h + 1) & 1][ks][0] = *(const f32x4*)(wbase + (size_t)(h + 1) * 16384 + 32 * ks); wq[(h + 1) & 1][ks][1] = *(const f32x4*)(wbase + (size_t)(h + 1) * 16384 + 32 * ks + 4); } }
            }
#pragma unroll
            for (int ks = 0; ks < 4; ++ks) if (ks < nks) {
                f32x4 w0 = wq[h & 1][ks][0], w1 = wq[h & 1][ks][1];
                const int s0 = 32 * ks + 8 * fq;
#pragma unroll
                for (int e = 0; e < 4; ++e) { if (s0 + e > t) w0[e] = 0.f; if (s0 + 4 + e > t) w1[e] = 0.f; }
                const bf16x8 wf = pack8(w0, w1);
#pragma unroll
                for (int dt = 0; dt < 4; ++dt) { const bf16x8 vf = *(const LAS bf16x8*)(vT + (64 * h + 16 * dt + fr) * 136 + 32 * ks + 8 * fq);
                    acc[h * 4 + dt] = __builtin_amdgcn_mfma_f32_16x16x32_bf16(vf, wf, acc[h * 4 + dt], 0, 0, 0); }
            }
        }
    }
    const size_t tok = (size_t)tok0 + t; float ss = 0.f;
#pragma unroll
    for (int h = 0; h < 4; ++h) { const float bias = a.in[10][(size_t)(l * 4 + h) * 128 + t];
#pragma unroll
        for (int dt = 0; dt < 4; ++dt) { const f32x4 u4 = ld4bf(z + tok * PIN + 64 * h + 16 * dt + 4 * fq); f32x4 o;
#pragma unroll
            for (int e = 0; e < 4; ++e) { o[e] = gelu_tanh(u4[e]) * (acc[h * 4 + dt][e] + bias); ss += o[e] * o[e]; }
            acc[h * 4 + dt] = o; } }
    ss += __shfl_xor(ss, 16); ss += __shfl_xor(ss, 32);
    const float rstd = 1.0f / sqrtf(ss * (1.0f / 256.0f) + EPS);
    const float* gn = a.in[24] + (size_t)l * 1024;
#pragma unroll
    for (int h = 0; h < 4; ++h)
#pragma unroll
        for (int dt = 0; dt < 4; ++dt) { const int ch = 64 * h + 16 * dt + 4 * fq; const f32x4 gg = *(const f32x4*)(gn + ch);
            st4bf(ycat + tok * 1024 + ch, acc[h * 4 + dt] * rstd * gg); }
    __syncthreads();
}

__device__ __forceinline__ void sincos_red(float ang, float& sn, float& cs) {
    const float n = rintf(ang * 0.15915494309189535f);
    float r = fmaf(-n, 6.2831854820251465f, ang); r = fmaf(-n, -1.7484556e-7f, r);
    const float h = 0.5f * r, h2 = h * h;
    const float s = h * (1.0f + h2 * (-1.6666667e-1f + h2 * (8.3333333e-3f + h2 * (-1.9841270e-4f + h2 * (2.7557319e-6f + h2 * (-2.5052108e-8f))))));
    const float c = 1.0f + h2 * (-0.5f + h2 * (4.1666667e-2f + h2 * (-1.3888889e-3f + h2 * (2.4801587e-5f + h2 * (-2.7557319e-7f + h2 * 2.0876757e-9f)))));
    sn = 2.0f * s * c; cs = 1.0f - 2.0f * s * s;
}

template <int PASS>
__device__ __forceinline__ void s5_span(const bf16* zu, bf16* ygp, LAS float* BU, LAS bf16* Xs, const bf16x8 (&bfrag)[8], const bf16x8 (&cf)[4], f32x4 dd, float are, float aim, float& xr, float& xi, int lane) {
    const int p = lane, fr = lane & 15, fq = lane >> 4;
    bf16x8 uf_n = (bf16x8){0, 0, 0, 0, 0, 0, 0, 0}; u32x2 u4_n = (u32x2){0u, 0u};
    if (fq < 2) uf_n = *(const bf16x8*)(zu + 8 * fq);
    if (PASS == 2) u4_n = *(const u32x2*)(zu + 4 * fq);
    for (int blk = 0; blk < 16; ++blk) {
        const bf16x8 uf = uf_n; const u32x2 u4w = u4_n;
        if (blk < 15) { const bf16* zn = zu + (size_t)(16 * (blk + 1)) * PIN;
            if (fq < 2) uf_n = *(const bf16x8*)(zn + 8 * fq);
            if (PASS == 2) u4_n = *(const u32x2*)(zn + 4 * fq); }
#pragma unroll
        for (int n = 0; n < 8; ++n) { const f32x4 acc = __builtin_amdgcn_mfma_f32_16x16x32_bf16(bfrag[n], uf, (f32x4){0.f, 0.f, 0.f, 0.f}, 0, 0, 0);
            *(LAS f32x4*)(BU + fr * 132 + 16 * n + 4 * fq) = acc; }
        LDS_WAIT();
#pragma unroll
        for (int t = 0; t < 16; ++t) { const float bur = BU[t * 132 + p], bui = BU[t * 132 + 64 + p];
            const float tr = are * xr - aim * xi + bur, ti = are * xi + aim * xr + bui; xr = tr; xi = ti;
            if (PASS == 2) { const unsigned w = cvt_pk_bf16(xr, xi); Xs[t * 136 + p] = (bf16)(w & 0xffffu); Xs[t * 136 + 64 + p] = (bf16)(w >> 16); } }
        if (PASS == 2) {
            LDS_WAIT();
            f32x4 acc = (f32x4){0.f, 0.f, 0.f, 0.f};
#pragma unroll
            for (int ks = 0; ks < 4; ++ks) { const bf16x8 xf = *(const LAS bf16x8*)(Xs + fr * 136 + 32 * ks + 8 * fq);
                acc = __builtin_amdgcn_mfma_f32_16x16x32_bf16(cf[ks], xf, acc, 0, 0, 0); }
            const f32x4 u4 = (f32x4){bf_lo(u4w.x), bf_hi(u4w.x), bf_lo(u4w.y), bf_hi(u4w.y)}; f32x4 y;
#pragma unroll
            for (int e = 0; e < 4; ++e) y[e] = gelu_tanh(acc[e] + dd[e] * u4[e]);
            st4bf(ygp + (size_t)(16 * blk) * 256, y);
        }
        asm volatile("s_waitcnt lgkmcnt(0)" ::: );
    }
}
__device__ __forceinline__ void s5_wg_item(ArgsRef a, int l, int bi, LAS unsigned char* lds, int wave, int lane) {
    const int g = bi & 15, b = bi >> 4, p = lane, fr = lane & 15, fq = lane >> 4;
    const bf16* z = (const bf16*)(a.ws + WS_Z);
    const int lg = l * 16 + g;
    const float dt = expf(a.in[21][lg]);
    const float lre = a.in[14][(size_t)lg * 64 + p], lim = a.in[15][(size_t)lg * 64 + p];
    const float mag = expf(lre * dt); float sn, cs; sincos_red(lim * dt, sn, cs);
    const float are = mag * cs, aim = mag * sn, nr = are - 1.0f, ni = aim, den = lre * lre + lim * lim;
    const float kre = (nr * lre + ni * lim) / den, kim = (ni * lre - nr * lim) / den;
    bf16x8 bfrag[8];
#pragma unroll
    for (int nn = 0; nn < 4; ++nn) { const int pp = 16 * nn + fr; const float kr = __shfl(kre, pp), ki = __shfl(kim, pp);
        const float* brp = a.in[16] + ((size_t)lg * 64 + pp) * 16 + 8 * (fq & 1); const float* bip = a.in[17] + ((size_t)lg * 64 + pp) * 16 + 8 * (fq & 1);
        const f32x4 br0 = *(const f32x4*)brp, br1 = *(const f32x4*)(brp + 4), bi0 = *(const f32x4*)bip, bi1 = *(const f32x4*)(bip + 4);
        bf16x8 fre = pack8(br0 * kr - bi0 * ki, br1 * kr - bi1 * ki), fim = pack8(bi0 * kr + br0 * ki, bi1 * kr + br1 * ki);
        if (fq >= 2) { fre = (bf16x8){0, 0, 0, 0, 0, 0, 0, 0}; fim = fre; }
        bfrag[nn] = fre; bfrag[nn + 4] = fim; }
    const size_t tok0 = (size_t)b * 2048 + 256 * wave;
    const bf16* zu = z + (tok0 + fr) * PIN + 1536 + 16 * g;
    bf16* ygp = (bf16*)(a.ws + WS_YG) + (tok0 + fr) * 256 + 16 * g + 4 * fq;
    LAS float* BU = (LAS float*)(lds + wave * 12800);
    LAS bf16* Xs = (LAS bf16*)(lds + wave * 12800 + 8448);
    LAS float* EX = (LAS float*)(lds + 102400);
    bf16x8 cf[4]; f32x4 dd = (f32x4){0.f, 0.f, 0.f, 0.f};
#pragma unroll
    for (int ks = 0; ks < 4; ++ks) cf[ks] = (bf16x8){0, 0, 0, 0, 0, 0, 0, 0};
    float xr = 0.f, xi = 0.f;
    s5_span<1>(zu, ygp, BU, Xs, bfrag, cf, dd, are, aim, xr, xi, lane);
    EX[wave * 128 + p] = xr; EX[wave * 128 + 64 + p] = xi;
    __syncthreads();
    {   float Ar = are, Ai = aim;
#pragma unroll
        for (int q = 0; q < 8; ++q) { const float tr = Ar * Ar - Ai * Ai, ti = 2.0f * Ar * Ai; Ar = tr; Ai = ti; }
        xr = 0.f; xi = 0.f;
#pragma unroll
        for (int w = 0; w < 7; ++w) if (w < wave) { const float er = EX[w * 128 + p], ei = EX[w * 128 + 64 + p];
            const float tr = Ar * xr - Ai * xi + er, ti = Ar * xi + Ai * xr + ei; xr = tr; xi = ti; }
    }
#pragma unroll
    for (int ks = 0; ks < 4; ++ks) { const float* cp = (ks < 2 ? a.in[18] : a.in[19]) + ((size_t)lg * 16 + fr) * 64 + 32 * (ks & 1) + 8 * fq;
        f32x4 c0 = *(const f32x4*)cp, c1 = *(const f32x4*)(cp + 4); if (ks >= 2) { c0 = -c0; c1 = -c1; } cf[ks] = pack8(c0, c1); }
    dd = *(const f32x4*)(a.in[20] + (size_t)l * 256 + 16 * g + 4 * fq);
    s5_span<2>(zu, ygp, BU, Xs, bfrag, cf, dd, are, aim, xr, xi, lane);
    __syncthreads();
}

__device__ __forceinline__ void poolconv_item(ArgsRef a, int l, int idx, int lane) {
    const bf16* z = (const bf16*)(a.ws + WS_Z); bf16* ycat = (bf16*)(a.ws + WS_YCAT);
    const int tokb = idx * 8, pos0 = tokb & 2047, ch = 4 * lane, gq = lane >> 4, wq = 2 << gq;
    const float m1 = gq >= 1 ? 1.0f : 0.0f, m2 = gq >= 2 ? 1.0f : 0.0f, m3 = gq >= 3 ? 1.0f : 0.0f;
    const float* gn = a.in[24] + (size_t)l * 1024;
    {   f32x4 row[23];
        const bf16* zp = z + (size_t)tokb * PIN + 512 + ch;
#pragma unroll
        for (int r = 0; r < 23; ++r) { row[r] = (f32x4){0.f, 0.f, 0.f, 0.f}; if (pos0 - 15 + r >= 0) row[r] = ld4bf(zp + (ptrdiff_t)(r - 15) * PIN); }
        const f32x4 gg = *(const f32x4*)(gn + 256 + ch);
#pragma unroll
        for (int tt = 0; tt < 8; ++tt) {
            f32x4 sum = row[15 + tt] + row[14 + tt];
            sum += (row[13 + tt] + row[12 + tt]) * m1;
            sum += ((row[11 + tt] + row[10 + tt]) + (row[9 + tt] + row[8 + tt])) * m2;
            sum += (((row[7 + tt] + row[6 + tt]) + (row[5 + tt] + row[4 + tt])) + ((row[3 + tt] + row[2 + tt]) + (row[1 + tt] + row[tt]))) * m3;
            const int pos = pos0 + tt, cnt = (pos + 1 < wq) ? pos + 1 : wq;
            const f32x4 o = sum * (1.0f / (float)cnt) - row[15 + tt];
            const float ss = wave_sum((o[0] * o[0] + o[1] * o[1]) + (o[2] * o[2] + o[3] * o[3]));
            const float rstd = 1.0f / sqrtf(ss * (1.0f / 256.0f) + EPS);
            st4bf(ycat + (size_t)(tokb + tt) * 1024 + 256 + ch, o * rstd * gg); }
    }
    {   f32x4 prod[10], bg[8];
        const bf16* zp = z + (size_t)tokb * PIN + 768 + ch;
#pragma unroll
        for (int r = 0; r < 10; ++r) { prod[r] = (f32x4){0.f, 0.f, 0.f, 0.f}; if (pos0 - 2 + r >= 0) prod[r] = ld4bf(zp + (ptrdiff_t)(r - 2) * PIN + 256) * ld4bf(zp + (ptrdiff_t)(r - 2) * PIN + 512); }
#pragma unroll
        for (int tt = 0; tt < 8; ++tt) bg[tt] = ld4bf(zp + (size_t)tt * PIN);
        const f32x4 w0 = *(const f32x4*)(a.in[13] + ((size_t)l * 3 + 0) * 256 + ch), w1 = *(const f32x4*)(a.in[13] + ((size_t)l * 3 + 1) * 256 + ch), w2 = *(const f32x4*)(a.in[13] + ((size_t)l * 3 + 2) * 256 + ch);
        const f32x4 gg = *(const f32x4*)(gn + 512 + ch);
#pragma unroll
        for (int tt = 0; tt < 8; ++tt) {
            const f32x4 o = bg[tt] * (w0 * prod[tt] + w1 * prod[tt + 1] + w2 * prod[tt + 2]);
            const float ss = wave_sum((o[0] * o[0] + o[1] * o[1]) + (o[2] * o[2] + o[3] * o[3]));
            const float rstd = 1.0f / sqrtf(ss * (1.0f / 256.0f) + EPS);
            st4bf(ycat + (size_t)(tokb + tt) * 1024 + 512 + ch, o * rstd * gg); }
    }
}

__device__ __forceinline__ void glu_item(ArgsRef a, int l, int it, LAS unsigned char* lds, int tid, int wave, int lane) {
    const bf16* yg = (const bf16*)(a.ws + WS_YG) + (size_t)it * 64 * 256; bf16* ycat = (bf16*)(a.ws + WS_YCAT) + (size_t)it * 64 * 1024 + 768;
    const bf16* Bt = (const bf16*)(a.ws + WS_W + (size_t)l * LW + OW_GLU);
    LAS unsigned char* T = lds;
    LAS float* P = (LAS float*)(lds + 34816);
    const int fr = lane & 15, fq = lane >> 4, n0 = 32 * wave;
    u32x4 st[4];
#pragma unroll
    for (int j = 0; j < 4; ++j) { const int idx = tid + 512 * j; st[j] = *(const u32x4*)(yg + (size_t)(idx >> 5) * 256 + 8 * (idx & 31)); }
    bf16x8 bfr[2][8];
#pragma unroll
    for (int nt = 0; nt < 2; ++nt)
#pragma unroll
        for (int ks = 0; ks < 8; ++ks) bfr[nt][ks] = *(const bf16x8*)(Bt + (size_t)(n0 + 16 * nt + fr) * 256 + 32 * ks + 8 * fq);
#pragma unroll
    for (int j = 0; j < 4; ++j) { const int idx = tid + 512 * j; *(LAS u32x4*)(T + (idx >> 5) * 528 + 16 * (idx & 31)) = st[j]; }
    __syncthreads();
    f32x4 acc[4][2];
#pragma unroll
    for (int tt = 0; tt < 4; ++tt) { acc[tt][0] = (f32x4){0.f, 0.f, 0.f, 0.f}; acc[tt][1] = acc[tt][0]; }
#pragma unroll
    for (int ks = 0; ks < 8; ++ks)
#pragma unroll
        for (int tt = 0; tt < 4; ++tt) { const bf16x8 af = *(const LAS bf16x8*)(T + (16 * tt + fr) * 528 + (32 * ks + 8 * fq) * 2);
            acc[tt][0] = __builtin_amdgcn_mfma_f32_16x16x32_bf16(bfr[0][ks], af, acc[tt][0], 0, 0, 0);
            acc[tt][1] = __builtin_amdgcn_mfma_f32_16x16x32_bf16(bfr[1][ks], af, acc[tt][1], 0, 0, 0); }
    const f32x4 gb0 = *(const f32x4*)(a.in[23] + (size_t)l * 256 + n0 + 4 * fq), gb1 = *(const f32x4*)(a.in[23] + (size_t)l * 256 + n0 + 16 + 4 * fq);
#pragma unroll
    for (int tt = 0; tt < 4; ++tt) { float ss = 0.f;
#pragma unroll
        for (int nt = 0; nt < 2; ++nt) { const u32x2 yw = *(const LAS u32x2*)(T + (16 * tt + fr) * 528 + (n0 + 16 * nt + 4 * fq) * 2);
            const f32x4 y = (f32x4){bf_lo(yw.x), bf_hi(yw.x), bf_lo(yw.y), bf_hi(yw.y)}; const f32x4 g4 = nt ? gb1 : gb0; f32x4 o;
#pragma unroll
            for (int e = 0; e < 4; ++e) { o[e] = y[e] * pg8::sigmoid_f(acc[tt][nt][e] + g4[e]); ss += o[e] * o[e]; }
            acc[tt][nt] = o; }
        ss += __shfl_xor(ss, 16); ss += __shfl_xor(ss, 32);
        if (fq == 0) P[(16 * tt + fr) * 8 + wave] = ss; }
    __syncthreads();
    const float* gn = a.in[24] + (size_t)l * 1024 + 768;
    const f32x4 gg0 = *(const f32x4*)(gn + n0 + 4 * fq), gg1 = *(const f32x4*)(gn + n0 + 16 + 4 * fq);
#pragma unroll
    for (int tt = 0; tt < 4; ++tt) { const int t = 16 * tt + fr; const f32x4 p0 = *(const LAS f32x4*)(P + t * 8), p1 = *(const LAS f32x4*)(P + t * 8 + 4);
        const float rstd = __builtin_amdgcn_rsqf((((p0[0] + p0[1]) + (p0[2] + p0[3])) + ((p1[0] + p1[1]) + (p1[2] + p1[3]))) * (1.0f / 256.0f) + EPS);
        st4bf(ycat + (size_t)t * 1024 + n0 + 4 * fq, acc[tt][0] * rstd * gg0); st4bf(ycat + (size_t)t * 1024 + n0 + 16 + 4 * fq, acc[tt][1] * rstd * gg1); }
    __syncthreads();
}

#define XB_TMO      128
#define XB_XCNT(j)  (256  + 64 * (j))
#define XB_XSUB(j)  (1280 + 64 * (j))
#define XB_XGEN(j)  (2304 + 64 * (j))
#define XB_TOP      3328
#define XB_TOPGEN   3392
#define XCD_BAR_WORDS 3456
#define XB_SPIN_CAP (1u << 18)

__device__ __forceinline__ unsigned xb_ld(unsigned* p)              { return __hip_atomic_load(p, __ATOMIC_RELAXED, __HIP_MEMORY_SCOPE_AGENT); }
__device__ __forceinline__ unsigned xb_add(unsigned* p, unsigned v) { return __hip_atomic_fetch_add(p, v, __ATOMIC_RELAXED, __HIP_MEMORY_SCOPE_AGENT); }
__device__ __forceinline__ unsigned xb_xcc_id() { return (unsigned)__builtin_amdgcn_s_getreg((3 << 11) | 20) & 0xFu; }
#define XB_SPIN(cond, bar) do { unsigned _sp = 0; while (cond) { __builtin_amdgcn_s_sleep(1); \
    if ((++_sp & 255u) == 0u) { if (xb_ld(&(bar)[XB_TMO])) break; if (_sp > XB_SPIN_CAP) { atomicAdd(&(bar)[XB_TMO], 1u); break; } } } } while (0)

struct XcdBarrier {
    unsigned* bar; unsigned x;
    volatile LAS unsigned* st;
};

__device__ __forceinline__ XcdBarrier xcd_barrier_post(unsigned* bar, volatile LAS unsigned* st) {
    XcdBarrier b; b.bar = bar; b.x = xb_xcc_id(); b.st = st;
    if (threadIdx.x == 0) (void)xb_add(&bar[XB_XCNT(b.x)], 1u);
    return b;
}
__device__ __forceinline__ void xcd_barrier_complete(unsigned* bar, unsigned x, unsigned& nloc, unsigned& nx) {
    const unsigned G = gridDim.x * gridDim.y * gridDim.z;
    unsigned sum, cnt, mine, sp = 0u;
    for (;;) {
        sum = 0u; cnt = 0u; mine = 0u;
#pragma unroll 1
        for (unsigned j = 0; j < 16; ++j) { const unsigned c = xb_ld(&bar[XB_XCNT(j)]); sum += c; cnt += (c > 0u) ? 1u : 0u; mine = (j == x) ? c : mine; }
        if (sum == G) break;
        __builtin_amdgcn_s_sleep(1);
        if ((++sp & 255u) == 0u) { if (xb_ld(&bar[XB_TMO])) break; if (sp > XB_SPIN_CAP) { atomicAdd(&bar[XB_TMO], 1u); break; } }
    }
    nloc = mine > 0u ? mine : 1u; nx = cnt > 0u ? cnt : 1u;
}

__device__ __forceinline__ void xcd_barrier(const XcdBarrier& b) {
    asm volatile("s_waitcnt vmcnt(0)" ::: "memory");
    __syncthreads();
    if (threadIdx.x == 0) {
        unsigned* bar = b.bar;
        __builtin_amdgcn_s_waitcnt(0);
        unsigned nloc = b.st[0], nx = b.st[1];
        if (nloc == 0u) { xcd_barrier_complete(bar, b.x, nloc, nx); b.st[0] = nloc; b.st[1] = nx; }
        const unsigned old = xb_add(&bar[XB_XSUB(b.x)], 1u);
        const unsigned gen = old / nloc;
        if (old + 1u == (gen + 1u) * nloc) {
            __builtin_amdgcn_fence(__ATOMIC_RELEASE, "agent");
            asm volatile("s_waitcnt vmcnt(0)" ::: "memory");
            const unsigned og = xb_add(&bar[XB_TOP], 1u);
            const unsigned tg = og / nx;
            if (og + 1u == (tg + 1u) * nx) xb_add(&bar[XB_TOPGEN], 1u);
            else XB_SPIN(xb_ld(&bar[XB_TOPGEN]) == tg, bar);
            __builtin_amdgcn_fence(__ATOMIC_ACQUIRE, "agent");
            xb_add(&bar[XB_XGEN(b.x)], 1u);
            asm volatile("s_waitcnt vmcnt(0)" ::: "memory");
        } else {
            XB_SPIN(xb_ld(&bar[XB_XGEN(b.x)]) == gen, bar);
            __builtin_amdgcn_fence(__ATOMIC_ACQUIRE, "agent");
            asm volatile("s_waitcnt vmcnt(0)" ::: "memory");
        }
    }
    __syncthreads();
}

#ifndef SYNC_REP
#define SYNC_REP 1
#endif
#ifndef REP_MASK
#define REP_MASK 0
#endif
#ifndef PHM
#define PHM 0xfff
#endif
#ifndef PER_PHASE_LAUNCH
#define PER_PHASE_LAUNCH 0
#endif
__global__ void __launch_bounds__(512) mega(Args a_) {
    extern __shared__ __attribute__((aligned(16))) unsigned char lds_raw[];
    LAS unsigned char* lds = (LAS unsigned char*)lds_raw;
    const int G = gridDim.x, NGW = G * 8;
    const int ph_lo = a_.ph_lo, ph_hi = a_.ph_hi;
    const bool multi = (ph_hi - ph_lo) > 1;
    unsigned char* const ws0 = a_.ws;
    volatile LAS unsigned* MISC = (volatile LAS unsigned*)(lds + 131072 + 320);
    if (threadIdx.x < 32) MISC[threadIdx.x] = 0u;
    __syncthreads();
    XcdBarrier bar; bar.bar = (unsigned*)(ws0 + WS_BAR); bar.x = 0; bar.st = nullptr;
    if (multi) bar = xcd_barrier_post((unsigned*)(ws0 + WS_BAR), MISC + 8);
    if (ph_lo < 0) cg::this_grid().sync();
    unsigned long long tacc = 0ull;
    for (int ph = ph_lo; ph < ph_hi; ++ph) {
        const unsigned long long tph0 = TPROBE ? __builtin_amdgcn_s_memrealtime() : 0ull;
        int tid = threadIdx.x; asm volatile("" : "+v"(tid));
        const int lane = tid & 63, wave = __builtin_amdgcn_readfirstlane(tid >> 6), gw = blockIdx.x * 8 + wave;
        const Args __attribute__((address_space(4)))* ap = (const Args __attribute__((address_space(4)))*)__builtin_amdgcn_kernarg_segment_ptr(); asm volatile("" : "+s"(ap));
        ArgsRef a = *ap;
        unsigned char* ws = a.ws;
        float* cond = (float*)(ws + WS_COND); float* SS = (float*)(ws + WS_SS); const float* SHW = (const float*)(ws + WS_SHW);
        bf16* H = (bf16*)(ws + WS_H); bf16* ACT = (bf16*)(ws + WS_ACT); bf16* Z = (bf16*)(ws + WS_Z); bf16* YG = (bf16*)(ws + WS_YG); bf16* YCAT = (bf16*)(ws + WS_YCAT);
        if (ph == 0) { for (int rp = 0; rp < PREP_REP; ++rp) { if (rp) { XcdBarrier b3 = bar; asm volatile("" : "+s"(b3.bar)); xcd_barrier(b3); } prep_phase(a, lds, tid, wave, lane, G); } }
        else if (ph == 1) norm_phase(a.in[0], a.in[4], cond, cond + 1024, H, (bf16*)(ws + WS_XB), gw, NGW, lane);
        else {
            const int l = (ph - 2) / NSLOT, slot = (ph - 2) % NSLOT, s = (int)((SLOT_MAP >> (4 * slot)) & 15ull); const bool rep = ((SLOT_REP >> slot) & 1u) != 0u;
            unsigned char* wl = ws + WS_W + (size_t)l * LW;
            const float* cl = cond + (size_t)l * 8 * NCOND;
            if ((PHM & 8) && (s == 0 || s == 7)) {
                pg8::Gemm gm{H, (const bf16*)(wl + (s == 0 ? OW_IN1 : OW_IN2)), M, 2 * DFF, D}; pg8::StaticOrder S; S.init(M, 2 * DFF, G, (int)blockIdx.x);
                pg8::EpiSwiglu E{ACT, DFF};
                pg8::gemm_phase<pg8::EpiSwiglu, pg8::StaticOrder>(lds, gm, S, E, nullptr, tid);
            } else if ((PHM & 16) && (s == 1 || s == 6 || s == 8)) {
                const bf16* A = (s == 6) ? YCAT : ACT; const int K = (s == 6) ? D : DFF;
                const bf16* Bt = (const bf16*)(wl + (s == 1 ? OW_OUT1 : (s == 6 ? OW_MO : OW_OUT2)));
                pg8::Gemm gm{A, Bt, M, D, K}; pg8::StaticOrder S; S.init(M, D, G, (int)blockIdx.x);
                bf16* XB = (bf16*)(ws + WS_XB);
                const float* gnext = (s == 1) ? a.in[7] + (size_t)l * D : (s == 6 ? a.in[26] + (size_t)l * D : (l == NL - 1 ? a.in[29] : a.in[4] + (size_t)(l + 1) * D));
                const float* shnext = (s == 1) ? cl + 3 * 1024 : (s == 6 ? cl + 6 * 1024 : cl + (size_t)8 * NCOND);
                const float* scnext = shnext + 1024;
                bf16* xa = (s == 8 && l == NL - 1) ? (bf16*)nullptr : H;
                const float gs = __builtin_bit_cast(float, __builtin_amdgcn_readfirstlane(s == 6 ? 0x3f800000 : 0x3f000000));
                const unsigned need = 32u * (unsigned)(l * 3 + (s == 1 ? 0 : (s == 6 ? 1 : 2)) + 1);
                pg8::EpiResid E{XB, XB, a.out, cl + (s == 1 ? 2 : (s == 6 ? 5 : 8)) * 1024, gnext, scnext, shnext, xa, (unsigned*)(ws + WS_SS), (unsigned*)(ws + WS_BAR + 16384), gs, need};
                pg8::gemm_phase<pg8::EpiResid, pg8::StaticOrder>(lds, gm, S, E, nullptr, tid);
            } else if ((PHM & 32) && s == 2) {
                pg8::Gemm gm{H, (const bf16*)(wl + OW_MIX), M, PIN, D}; pg8::StaticOrder S; S.init(M, PIN, G, (int)blockIdx.x);
                pg8::EpiZ E{Z, PIN};
                pg8::gemm_phase<pg8::EpiZ, pg8::StaticOrder>(lds, gm, S, E, nullptr, tid);
            } else if ((PHM & 64) && s == 3) {
                int w_first = gw, w_stride = NGW;
                if (G >= 256) { w_first = (blockIdx.x < 128) ? blockIdx.x * 8 + wave : 2048; w_stride = 1024; }
                for (int it = blockIdx.x; it < 256; it += G) { if (it < 128) { for (int rq = 0; rq < SGU_REP; ++rq) sgu_item(a, l, it, lds, tid, wave, lane); } else { for (int rq = 0; rq < S5_REP; ++rq) s5_wg_item(a, l, it - 128, lds, wave, lane); } }
                for (int rq = 0; rq < PC_REP; ++rq) for (int idx = w_first; idx < 2048; idx += w_stride) poolconv_item(a, l, idx, lane);
            } else if ((PHM & 256) && s == 5) {
                for (int it = blockIdx.x; it < M / 64; it += G) glu_item(a, l, it, lds, tid, wave, lane);
            }
        }
        if (ph + 1 < ph_hi) { XcdBarrier b2 = bar; asm volatile("" : "+s"(b2.bar)); xcd_barrier(b2); }
        if (TPROBE) { int ty; if (ph == 0) ty = 0; else if (ph == 1) ty = 1; else { const int s_ = (int)((SLOT_MAP >> (4 * ((ph - 2) % NSLOT))) & 15ull); ty = (s_ == 0 || s_ == 7) ? 2 : ((s_ == 1 || s_ == 6 || s_ == 8) ? 3 : (s_ == 2 ? 4 : (s_ == 3 ? 5 : 6))); }
            if ((TPROBE >> ty) & 1) tacc += __builtin_amdgcn_s_memrealtime() - tph0; }
    }
    if (TPROBE) { const unsigned long long te = __builtin_amdgcn_s_memrealtime(); while (__builtin_amdgcn_s_memrealtime() - te < tacc) __builtin_amdgcn_s_sleep(8); }
}

extern "C" void kernel_launch(void* const* d_in, const int* in_sizes, int n_in, void* d_out, int out_size, void* d_ws, size_t ws_size, hipStream_t stream) {
    static int grid = 0;
    if (grid == 0) {
        int dev = 0, cus = 0;
        if (n_in != 30 || ws_size < WS_END || hipGetDevice(&dev) != hipSuccess || hipDeviceGetAttribute(&cus, hipDeviceAttributeMultiprocessorCount, dev) != hipSuccess) { grid = -1; return; }
        if (hipFuncSetAttribute((const void*)mega, hipFuncAttributeMaxDynamicSharedMemorySize, LDS_BYTES) != hipSuccess) { grid = -1; return; }
        int per_cu = 0;
        if (hipOccupancyMaxActiveBlocksPerMultiprocessor(&per_cu, (const void*)mega, 512, LDS_BYTES) != hipSuccess || per_cu < 1) per_cu = 1;
        (void)hipGetLastError();
        grid = cus;
    }
    if (grid < 0) return;
    Args a{};
    for (int i = 0; i < 30; ++i) a.in[i] = (const float*)d_in[i];
    a.out = (float*)d_out; a.ws = (unsigned char*)d_ws;
#if PER_PHASE_LAUNCH
    for (int ph = 0; ph < NPH; ++ph) { a.ph_lo = ph; a.ph_hi = ph + 1; hipLaunchKernelGGL(mega, dim3(grid), dim3(512), LDS_BYTES, stream, a); }
#else
    (void)hipMemsetAsync((char*)d_ws + WS_BAR, 0, BAR_BYTES, stream);
    a.ph_lo = 0; a.ph_hi = NPH;
    void* args[] = {&a};
    (void)hipLaunchCooperativeKernel((const void*)mega, dim3(grid), dim3(512), args, LDS_BYTES, stream);
#endif
}
```

```cpp
#include <hip/hip_runtime.h>
#include <hip/hip_cooperative_groups.h>
namespace cg = cooperative_groups;
namespace pg8 {
#define PG8_LAS __attribute__((address_space(3)))
typedef unsigned short bf16_t;
typedef short bf16x8 __attribute__((ext_vector_type(8)));
typedef float f32x4 __attribute__((ext_vector_type(4)));
typedef unsigned u32x4 __attribute__((ext_vector_type(4)));
constexpr int BM = 256, BK = 64, HALF = 128, HTB = HALF * BK * 2  , STAGE_BYTES = 8 * HTB, NXCD = 8, WGM = 8;

__host__ __device__ __forceinline__ int lds_byte(int r, int c) { const int st = (r >> 4) * 2 + (c >> 5), rr = r & 15, cc = c & 31, ob = rr * 64 + cc * 2; return st * 1024 + (ob ^ (((ob >> 9) & 1) << 5)); }
__host__ __device__ __forceinline__ void stage_rc(int b, int& R, int& C) { const int st = b / 1024, sb = b % 1024, swz = sb ^ (((sb >> 9) & 1) << 5); R = (st >> 1) * 16 + swz / 64; C = (st & 1) * 32 + (swz % 64) / 2; }
__host__ __device__ __forceinline__ int perm32(int rho) { const int n = rho >> 4, i = rho & 15; return 8 * (i >> 2) + 4 * n + (i & 3); }

struct Unit { int pm, pn; };
struct Gemm { const bf16_t* A; const bf16_t* Bt; int M, N, K; };

struct StaticOrder {
    int nM, nN, nwg, G, c;
    __host__ __device__ void init(int M, int N, int G_, int c_) { nM = M / BM; nN = N / BM; nwg = nM * nN; G = G_; c = c_; }
    __host__ __device__ bool next(int i, Unit& u) const {
        const long L = (long)i * G + c; if (L >= nwg) return false;
        int wgid = (int)L; { const int q = nwg / NXCD, r = nwg % NXCD, xcd = wgid % NXCD, off = wgid / NXCD; wgid = (xcd < r ? xcd * (q + 1) : r * (q + 1) + (xcd - r) * q) + off; }
        const int nig = WGM * nN, gid = wgid / nig, fm = gid * WGM, gsz = (nM - fm) < WGM ? (nM - fm) : WGM;
        u.pm = fm + ((wgid % nig) % gsz); u.pn = (wgid % nig) / gsz; return true;
    }
    __device__ __forceinline__ void a_ready(const Unit&) const {}
    __device__ __forceinline__ void done(const Unit&) const {}
};
__device__ __forceinline__ unsigned cvt_pk_bf16(float lo, float hi) { unsigned r; asm volatile("v_cvt_pk_bf16_f32 %0, %1, %2" : "=v"(r) : "v"(lo), "v"(hi)); return r; }
typedef float f32x2 __attribute__((ext_vector_type(2)));
typedef unsigned u32x2 __attribute__((ext_vector_type(2)));
__device__ __forceinline__ float silu_f(float a) { return a * __builtin_amdgcn_rcpf(1.0f + __expf(-a)); }
__device__ __forceinline__ float sigmoid_f(float a) { return __builtin_amdgcn_rcpf(1.0f + __expf(-a)); }
__device__ __forceinline__ float gelu_tanh(float y) { const float z = 1.5957691216f * (y + 0.044715f * y * y * y); return y * __builtin_amdgcn_rcpf(1.0f + __expf(-z)); }
__device__ __forceinline__ float bf_lo(unsigned w) { return __uint_as_float(w << 16); }
__device__ __forceinline__ float bf_hi(unsigned w) { return __uint_as_float(w & 0xffff0000u); }

struct EpiZ {
    static constexpr bool PERM = true, AFTER_DRAIN = false;
    bf16_t* O; int ldc;
    __device__ __forceinline__ void operator()(const f32x4 (&acc)[2][2][4][2], const Unit& u, int wr, int wc, int fr, int fq) const {
        const int row0 = u.pm * BM + wr * 64 + fr, col0 = u.pn * BM + wc * 32 + 8 * fq;
#pragma unroll
        for (int ai = 0; ai < 2; ++ai)
#pragma unroll
            for (int m = 0; m < 4; ++m) { bf16_t* rowp = O + (size_t)(row0 + ai * HALF + m * 16) * ldc + col0;
#pragma unroll
                for (int bj = 0; bj < 2; ++bj) { const f32x4 v0 = acc[ai][bj][m][0], v1 = acc[ai][bj][m][1];
                    u32x4 w; w.x = cvt_pk_bf16(v0[0], v0[1]); w.y = cvt_pk_bf16(v0[2], v0[3]); w.z = cvt_pk_bf16(v1[0], v1[1]); w.w = cvt_pk_bf16(v1[2], v1[3]);
                    *(u32x4*)(rowp + bj * HALF) = w; } }
    }
};
struct EpiSwiglu {
    static constexpr bool PERM = true, AFTER_DRAIN = false;
    bf16_t* O; int ldc;
    __device__ __forceinline__ void operator()(const f32x4 (&acc)[2][2][4][2], const Unit& u, int wr, int wc, int fr, int fq) const {
        const int row0 = u.pm * BM + wr * 64 + fr, col0 = u.pn * HALF + wc * 32 + 8 * fq;
#pragma unroll
        for (int ai = 0; ai < 2; ++ai)
#pragma unroll
            for (int m = 0; m < 4; ++m) { bf16_t* rowp = O + (size_t)(row0 + ai * HALF + m * 16) * ldc + col0;
                const f32x4 a0 = acc[ai][0][m][0], a1 = acc[ai][0][m][1], b0 = acc[ai][1][m][0], b1 = acc[ai][1][m][1];
                const f32x4 t0 = a0 * -1.4426950408889634f, t1 = a1 * -1.4426950408889634f;
                f32x4 e0, e1;
#pragma unroll
                for (int j = 0; j < 4; ++j) { e0[j] = __builtin_amdgcn_exp2f(t0[j]); e1[j] = __builtin_amdgcn_exp2f(t1[j]); }
                const f32x4 d0 = e0 + 1.0f, d1 = e1 + 1.0f; f32x4 r0, r1;
#pragma unroll
                for (int j = 0; j < 4; ++j) { r0[j] = __builtin_amdgcn_rcpf(d0[j]); r1[j] = __builtin_amdgcn_rcpf(d1[j]); }
                const f32x4 v0 = (a0 * b0) * r0, v1 = (a1 * b1) * r1;
                u32x4 w; w.x = cvt_pk_bf16(v0[0], v0[1]); w.y = cvt_pk_bf16(v0[2], v0[3]); w.z = cvt_pk_bf16(v1[0], v1[1]); w.w = cvt_pk_bf16(v1[2], v1[3]);
                __builtin_nontemporal_store(w, (u32x4*)rowp); }
    }
};
struct EpiResid {
    static constexpr bool PERM = true, AFTER_DRAIN = true;
    const bf16_t* xin; bf16_t* xout; float* fout; const float* gate; const float* gnext; const float* scnext; const float* shnext; bf16_t* xa; unsigned* xbuf; unsigned* cnt; float gs; unsigned need;
    __device__ __forceinline__ void fused(f32x4 (&acc)[2][2][4][2], const Unit& u, int wr, int wc, int fr, int fq, PG8_LAS unsigned char* lds, int wid, int lane) const {
        PG8_LAS float* P = (PG8_LAS float*)lds;
        PG8_LAS float* S = (PG8_LAS float*)(lds + 4096);
        const int row0 = u.pm * BM + wr * 64 + fr, col0 = u.pn * BM + wc * 32 + 8 * fq;
        const size_t cb = (size_t)(u.pm >> 3) * 9216 + col0;
        float sq[8];
#pragma unroll
        for (int i = 0; i < 8; ++i) sq[i] = 0.f;
#pragma unroll
        for (int bj = 0; bj < 2; ++bj) { const int co = bj * HALF;
            const f32x4 gv0 = *(const f32x4*)(gate + cb + co) * gs, gv1 = *(const f32x4*)(gate + cb + co + 4) * gs;
#pragma unroll
            for (int ai = 0; ai < 2; ++ai)
#pragma unroll
                for (int m = 0; m < 4; ++m) { const size_t off = (size_t)(row0 + ai * HALF + m * 16) * 1024 + col0 + co;
                    const u32x4 xw = *(const u32x4*)(xin + off);
                    const f32x4 xi0 = (f32x4){bf_lo(xw.x), bf_hi(xw.x), bf_lo(xw.y), bf_hi(xw.y)}, xi1 = (f32x4){bf_lo(xw.z), bf_hi(xw.z), bf_lo(xw.w), bf_hi(xw.w)};
                    const f32x4 xn0 = xi0 + gv0 * acc[ai][bj][m][0], xn1 = xi1 + gv1 * acc[ai][bj][m][1];
                    if (xa) { u32x4 ow; ow.x = cvt_pk_bf16(xn0[0], xn0[1]); ow.y = cvt_pk_bf16(xn0[2], xn0[3]); ow.z = cvt_pk_bf16(xn1[0], xn1[1]); ow.w = cvt_pk_bf16(xn1[2], xn1[3]);
                        *(u32x4*)(xout + off) = ow; }
                    acc[ai][bj][m][0] = xn0; acc[ai][bj][m][1] = xn1;
                    sq[ai * 4 + m] += ((xn0[0] * xn0[0] + xn0[1] * xn0[1]) + (xn0[2] * xn0[2] + xn0[3] * xn0[3])) + ((xn1[0] * xn1[0] + xn1[1] * xn1[1]) + (xn1[2] * xn1[2] + xn1[3] * xn1[3])); }
            asm volatile("" ::: "memory"); }
#pragma unroll
        for (int i = 0; i < 8; ++i) { float q = sq[i]; q += __shfl_xor(q, 16); q += __shfl_xor(q, 32);
            if (fq == 0) P[((i >> 2) * HALF + wr * 64 + (i & 3) * 16 + fr) * 4 + wc] = q; }
        asm volatile("s_waitcnt lgkmcnt(0)" ::: "memory"); __builtin_amdgcn_s_barrier(); asm volatile("" ::: "memory");
        const int row = wid * 32 + (lane & 31);
        if (lane < 32) { const f32x4 p = *(const PG8_LAS f32x4*)(P + row * 4); const float s = (p[0] + p[1]) + (p[2] + p[3]);
            __hip_atomic_store(xbuf + ((size_t)(u.pm * BM + row) * 4 + u.pn), __float_as_uint(s), __ATOMIC_RELAXED, __HIP_MEMORY_SCOPE_AGENT); }
        asm volatile("s_waitcnt vmcnt(0)" ::: "memory");
        if (lane == 0) __hip_atomic_fetch_add(cnt + 64 * u.pm, 1u, __ATOMIC_RELAXED, __HIP_MEMORY_SCOPE_AGENT);
        if (wid == 0) {
            unsigned spins = 0;
            while ((unsigned)__builtin_amdgcn_readfirstlane(__hip_atomic_load(cnt + 64 * u.pm, __ATOMIC_RELAXED, __HIP_MEMORY_SCOPE_AGENT)) < need) { __builtin_amdgcn_s_sleep(2); if (++spins > (1u << 22)) break; }
            __builtin_amdgcn_fence(__ATOMIC_ACQUIRE, "agent");
        }
        asm volatile("s_waitcnt vmcnt(0) lgkmcnt(0)" ::: "memory"); __builtin_amdgcn_s_barrier(); asm volatile("" ::: "memory");
        if (lane < 32) { const unsigned* slot = xbuf + (size_t)(u.pm * BM + row) * 4; float t = 0.f;
#pragma unroll
            for (int k = 0; k < 4; ++k) t += __uint_as_float(__hip_atomic_load(slot + k, __ATOMIC_RELAXED, __HIP_MEMORY_SCOPE_AGENT));
            S[row] = __builtin_amdgcn_rsqf(t * (1.0f / 1024.0f) + 1e-6f); }
        asm volatile("s_waitcnt vmcnt(0) lgkmcnt(0)" ::: "memory"); __builtin_amdgcn_s_barrier(); asm volatile("" ::: "memory");
        if (xa == nullptr) {
#pragma unroll
            for (int bj = 0; bj < 2; ++bj) { const int co = bj * HALF; const f32x4 g0 = *(const f32x4*)(gnext + col0 + co), g1 = *(const f32x4*)(gnext + col0 + co + 4);
#pragma unroll
                for (int ai = 0; ai < 2; ++ai)
#pragma unroll
                    for (int m = 0; m < 4; ++m) { const int r = ai * HALF + wr * 64 + m * 16 + fr; const float rs = S[r]; float* op = fout + (size_t)(u.pm * BM + r) * 1024 + col0 + co;
                        *(f32x4*)op = acc[ai][bj][m][0] * rs * g0; *(f32x4*)(op + 4) = acc[ai][bj][m][1] * rs * g1; } }
            asm volatile("s_waitcnt lgkmcnt(0)" ::: "memory"); __builtin_amdgcn_s_barrier(); asm volatile("" ::: "memory");
            return;
        }
#pragma unroll
        for (int bj = 0; bj < 2; ++bj) { const int co = bj * HALF;
            const f32x4 gm0 = *(const f32x4*)(gnext + col0 + co) * (*(const f32x4*)(scnext + cb + co) + 1.0f), gm1 = *(const f32x4*)(gnext + col0 + co + 4) * (*(const f32x4*)(scnext + cb + co + 4) + 1.0f);
            const f32x4 sh0 = *(const f32x4*)(shnext + cb + co), sh1 = *(const f32x4*)(shnext + cb + co + 4);
#pragma unroll
            for (int ai = 0; ai < 2; ++ai)
#pragma unroll
                for (int m = 0; m < 4; ++m) { const int r = ai * HALF + wr * 64 + m * 16 + fr; const float rs = S[r];
                    const f32x4 y0 = acc[ai][bj][m][0] * rs * gm0 + sh0, y1 = acc[ai][bj][m][1] * rs * gm1 + sh1;
                    u32x4 w; w.x = cvt_pk_bf16(y0[0], y0[1]); w.y = cvt_pk_bf16(y0[2], y0[3]); w.z = cvt_pk_bf16(y1[0], y1[1]); w.w = cvt_pk_bf16(y1[2], y1[3]);
                    *(u32x4*)(xa + (size_t)(u.pm * BM + r) * 1024 + col0 + co) = w; } }
        asm volatile("s_waitcnt lgkmcnt(0)" ::: "memory"); __builtin_amdgcn_s_barrier(); asm volatile("" ::: "memory");
    }
};
struct EpiGlu {
    static constexpr bool PERM = false, AFTER_DRAIN = true;
    const bf16_t* yg; const float* glu_b; const float* gn; bf16_t* ycat;
    __device__ __forceinline__ void fused(f32x4 (&acc)[2][2][4][2], const Unit& u, int wr, int wc, int fr, int fq, PG8_LAS unsigned char* lds, int wid, int lane) const {
        PG8_LAS float* P = (PG8_LAS float*)lds;
        const int col0 = wc * 32 + 4 * fq;
        f32x4 gb[2][2];
#pragma unroll
        for (int bj = 0; bj < 2; ++bj)
#pragma unroll
            for (int n = 0; n < 2; ++n) gb[bj][n] = *(const f32x4*)(glu_b + col0 + bj * HALF + n * 16);
#pragma unroll
        for (int ai = 0; ai < 2; ++ai)
#pragma unroll
            for (int m = 0; m < 4; ++m) { const int r = ai * HALF + wr * 64 + m * 16 + fr; const bf16_t* yp = yg + (size_t)(u.pm * BM + r) * 256 + col0; float s = 0.f;
#pragma unroll
                for (int bj = 0; bj < 2; ++bj)
#pragma unroll
                    for (int n = 0; n < 2; ++n) { const u32x2 yw = *(const u32x2*)(yp + bj * HALF + n * 16);
                        const f32x4 y = (f32x4){bf_lo(yw.x), bf_hi(yw.x), bf_lo(yw.y), bf_hi(yw.y)}; const f32x4 a = acc[ai][bj][m][n] + gb[bj][n]; f32x4 o;
#pragma unroll
                        for (int j = 0; j < 4; ++j) { o[j] = y[j] * sigmoid_f(a[j]); s += o[j] * o[j]; }
                        acc[ai][bj][m][n] = o; }
                s += __shfl_xor(s, 16); s += __shfl_xor(s, 32);
                if (fq == 0) P[r * 4 + wc] = s; }
        asm volatile("s_waitcnt lgkmcnt(0)" ::: "memory"); __builtin_amdgcn_s_barrier(); asm volatile("" ::: "memory");
        f32x4 gg[2][2];
#pragma unroll
        for (int bj = 0; bj < 2; ++bj)
#pragma unroll
            for (int n = 0; n < 2; ++n) gg[bj][n] = *(const f32x4*)(gn + col0 + bj * HALF + n * 16);
#pragma unroll
        for (int ai = 0; ai < 2; ++ai)
#pragma unroll
            for (int m = 0; m < 4; ++m) { const int r = ai * HALF + wr * 64 + m * 16 + fr; const f32x4 pp = *(const PG8_LAS f32x4*)(P + r * 4);
                const float rstd = 1.0f / sqrtf(((pp[0] + pp[1]) + (pp[2] + pp[3])) * (1.0f / 256.0f) + 1e-6f);
                bf16_t* op = ycat + (size_t)(u.pm * BM + r) * 1024 + 768 + col0;
#pragma unroll
                for (int bj = 0; bj < 2; ++bj)
#pragma unroll
                    for (int n = 0; n < 2; ++n) { const f32x4 o = acc[ai][bj][m][n] * rstd * gg[bj][n]; u32x2 w; w.x = cvt_pk_bf16(o[0], o[1]); w.y = cvt_pk_bf16(o[2], o[3]);
                        *(u32x2*)(op + bj * HALF + n * 16) = w; } }
        asm volatile("s_waitcnt lgkmcnt(0)" ::: "memory"); __builtin_amdgcn_s_barrier(); asm volatile("" ::: "memory");
    }
};

template <class Epi, class Sched, bool STAMP = false>
__device__ __forceinline__ void gemm_phase(PG8_LAS unsigned char* lds, const Gemm g, const Sched& S, const Epi& E, unsigned long long* stamps, const int tid) {
    const int wid = __builtin_amdgcn_readfirstlane(tid >> 6), lane = tid & 63, wr = wid >> 2, wc = wid & 3, fr = lane & 15, fq = lane >> 4;
    const int K = g.K, nt = K / BK;
    int ts_lo = 0, ts_hi = 0, nts = 0; const unsigned long long rt_entry = STAMP ? (unsigned long long)wall_clock64() : 0ull;
#define PG8_STAMP() do { if (STAMP && wid == 0 && nts < 64) { const unsigned long long _c = (unsigned long long)clock64(); \
        ts_lo = (lane == nts) ? (int)(unsigned)_c : ts_lo; ts_hi = (lane == nts) ? (int)(unsigned)(_c >> 32) : ts_hi; ++nts; } } while (0)
    PG8_STAMP();
    unsigned voffA[2], voffB[2];
#pragma unroll
    for (int i = 0; i < 2; ++i) { int R, C; stage_rc(tid * 16 + i * 8192, R, C); const int Rb = Epi::PERM ? ((R & ~31) + perm32(R & 31)) : R;
        voffA[i] = (unsigned)(R * K + C) * 2u; voffB[i] = (unsigned)(Rb * K + C) * 2u; }
    const size_t kstep = (size_t)(BK * 2);
    const size_t hstep = (size_t)HALF * K * 2;
    const size_t tstep = 2 * hstep;
    const unsigned ldsw = (unsigned)wid * 1024u;
    const int aoff = lds_byte(wr * 64 + fr, fq * 8), boff = lds_byte(wc * 32 + fr, fq * 8);
#define PG8_SA(b, h) (((b) * 2 + (h)) * HTB)
#define PG8_SB(b, h) ((4 + (b) * 2 + (h)) * HTB)
#define PG8_STAGE(bufoff, gbase, voff) do { _Pragma("unroll") for (int _i = 0; _i < 2; ++_i) \
        __builtin_amdgcn_global_load_lds((const unsigned*)((const char*)(gbase) + (voff)[_i]), (PG8_LAS unsigned*)(lds + (bufoff) + ldsw + _i * 8192), 16, 0, 0); } while (0)
#define PG8_LDA(dst, b, h) do { _Pragma("unroll") for (int m = 0; m < 4; ++m) _Pragma("unroll") for (int k = 0; k < 2; ++k) dst[m][k] = *(const PG8_LAS bf16x8*)(lds + PG8_SA(b, h) + aoff + m * 2048 + k * 1024); } while (0)
#define PG8_LDB(dst, b, h) do { _Pragma("unroll") for (int n = 0; n < 2; ++n) _Pragma("unroll") for (int k = 0; k < 2; ++k) dst[n][k] = *(const PG8_LAS bf16x8*)(lds + PG8_SB(b, h) + boff + n * 2048 + k * 1024); } while (0)
#define PG8_MMA(ai, bj, At, Bt) do { __builtin_amdgcn_s_setprio(1); _Pragma("unroll") for (int m = 0; m < 4; ++m) _Pragma("unroll") for (int n = 0; n < 2; ++n) _Pragma("unroll") for (int k = 0; k < 2; ++k) \
        acc[ai][bj][m][n] = __builtin_amdgcn_mfma_f32_16x16x32_bf16(Bt[n][k], At[m][k], acc[ai][bj][m][n], 0, 0, 0); __builtin_amdgcn_s_setprio(0); } while (0)
#define PG8_WAIT_V(n) asm volatile("s_waitcnt vmcnt(" #n ")" ::: "memory")
#define PG8_WAIT_L(n) asm volatile("s_waitcnt lgkmcnt(" #n ")" ::: "memory")
#define PG8_BAR __builtin_amdgcn_s_barrier()
#define PG8_SCHED __builtin_amdgcn_sched_barrier(0)
    Unit cur, nxt; int ui = 0;
    if (!S.next(0, cur)) return;
    f32x4 acc[2][2][4][2];
#pragma unroll
    for (int a = 0; a < 2; ++a)
#pragma unroll
        for (int b = 0; b < 2; ++b)
#pragma unroll
            for (int m = 0; m < 4; ++m)
#pragma unroll
                for (int n = 0; n < 2; ++n) acc[a][b][m][n] = (f32x4){0.f, 0.f, 0.f, 0.f};
    bf16x8 At[4][2], B0[2][2], B1[2][2];
    const char* cA = (const char*)g.A + (size_t)cur.pm * tstep; const char* cB = (const char*)g.Bt + (size_t)cur.pn * tstep;
    S.a_ready(cur);
    PG8_STAGE(PG8_SB(0, 0), cB, voffB); PG8_STAGE(PG8_SA(0, 0), cA, voffA); PG8_STAGE(PG8_SB(0, 1), cB + hstep, voffB); PG8_STAGE(PG8_SA(0, 1), cA + hstep, voffA);
    if (wr == 1) PG8_BAR;
    PG8_WAIT_V(4); PG8_BAR;
    PG8_STAGE(PG8_SB(1, 0), cB + kstep, voffB); PG8_STAGE(PG8_SA(1, 0), cA + kstep, voffA); PG8_STAGE(PG8_SB(1, 1), cB + hstep + kstep, voffB);
    PG8_WAIT_V(6); PG8_BAR;
    PG8_STAMP();
    for (;;) {
        const bool has_next = S.next(ui + 1, nxt);
        const char* nA = has_next ? (const char*)g.A + (size_t)nxt.pm * tstep : cA; const char* nB = has_next ? (const char*)g.Bt + (size_t)nxt.pn * tstep : cB;
        for (int t = 0; t < nt; t += 2) {
            const bool last = (t == nt - 2);
            const char* a1 = cA + (size_t)(t + 1) * kstep;
            const char* a2 = last ? nA : cA + (size_t)(t + 2) * kstep; const char* b2 = last ? nB : cB + (size_t)(t + 2) * kstep;
            const char* a3 = a2 + kstep; const char* b3 = b2 + kstep;
            if (last && has_next) S.a_ready(nxt);
            PG8_LDB(B0, 0, 0); PG8_SCHED; PG8_LDA(At, 0, 0); PG8_STAGE(PG8_SA(1, 1), a1 + hstep, voffA);
            PG8_WAIT_L(8); PG8_BAR; PG8_WAIT_L(0); PG8_MMA(0, 0, At, B0); PG8_BAR; PG8_SCHED;
            PG8_LDB(B1, 0, 1); PG8_STAGE(PG8_SB(0, 0), b2, voffB);
            PG8_BAR; PG8_WAIT_L(0); PG8_MMA(0, 1, At, B1); PG8_BAR;
            PG8_LDA(At, 0, 1); PG8_STAGE(PG8_SA(0, 0), a2, voffA);
            PG8_BAR; PG8_WAIT_L(0); PG8_MMA(1, 0, At, B0); PG8_BAR; PG8_SCHED;
            PG8_STAGE(PG8_SB(0, 1), b2 + hstep, voffB);
            PG8_WAIT_V(6); PG8_BAR; PG8_MMA(1, 1, At, B1); PG8_BAR;
            PG8_LDB(B0, 1, 0); PG8_SCHED; PG8_LDA(At, 1, 0); PG8_STAGE(PG8_SA(0, 1), a2 + hstep, voffA);
            PG8_WAIT_L(8); PG8_BAR; PG8_WAIT_L(0); PG8_MMA(0, 0, At, B0); PG8_BAR; PG8_SCHED;
            PG8_LDB(B1, 1, 1); PG8_STAGE(PG8_SB(1, 0), b3, voffB);
            PG8_BAR; PG8_WAIT_L(0); PG8_MMA(0, 1, At, B1); PG8_BAR;
            PG8_LDA(At, 1, 1); PG8_STAGE(PG8_SA(1, 0), a3, voffA);
            PG8_BAR; PG8_WAIT_L(0); PG8_MMA(1, 0, At, B0); PG8_BAR; PG8_SCHED;
            PG8_STAGE(PG8_SB(1, 1), b3 + hstep, voffB);
            PG8_WAIT_V(6); PG8_BAR; PG8_MMA(1, 1, At, B1); PG8_BAR;
        }
        PG8_STAMP();
        if constexpr (!Epi::AFTER_DRAIN) { E(acc, cur, wr, wc, fr, fq); S.done(cur); }
        PG8_STAMP();
        if (!has_next) break;
#pragma unroll
        for (int a = 0; a < 2; ++a)
#pragma unroll
            for (int b = 0; b < 2; ++b)
#pragma unroll
                for (int m = 0; m < 4; ++m)
#pragma unroll
                    for (int n = 0; n < 2; ++n) acc[a][b][m][n] = (f32x4){0.f, 0.f, 0.f, 0.f};
        cur = nxt; cA = nA; cB = nB; ++ui;
    }
    PG8_WAIT_V(0);
    if (wr == 0) PG8_BAR;
    PG8_BAR;
    if constexpr (Epi::AFTER_DRAIN) { E.fused(acc, cur, wr, wc, fr, fq, lds, wid, lane); S.done(cur); }
    PG8_STAMP();
    if (STAMP && wid == 0) { stamps[lane] = lane < nts ? (((unsigned long long)(unsigned)ts_hi << 32) | (unsigned)ts_lo) : 0ull;
        if (lane == 62) stamps[62] = rt_entry; if (lane == 63) stamps[63] = (unsigned long long)wall_clock64(); }
#undef PG8_STAMP
#undef PG8_SA
#undef PG8_SB
#undef PG8_STAGE
#undef PG8_LDA
#undef PG8_LDB
#undef PG8_MMA
#undef PG8_WAIT_V
#undef PG8_WAIT_L
#undef PG8_BAR
#undef PG8_SCHED
}
}

#define LAS __attribute__((address_space(3)))
typedef unsigned short bf16;
using pg8::f32x4; using pg8::bf16x8; using pg8::u32x4; using pg8::u32x2; using pg8::cvt_pk_bf16; using pg8::bf_lo; using pg8::bf_hi; using pg8::gelu_tanh;

constexpr int M = 16384, D = 1024, DFF = 2816, PIN = 1792, NL = 4, NCOND = 9216;
constexpr float EPS = 1e-6f;
constexpr size_t MiB = (size_t)1 << 20;
constexpr size_t WS_BAR = 7 * MiB, BAR_BYTES = 32768;
constexpr size_t WS_COND = 0, WS_E = 2 * MiB, WS_W = 8 * MiB, LW = 39 * MiB;
constexpr size_t OW_IN1 = 0, OW_OUT1 = 11 * MiB, OW_MIX = OW_OUT1 + 11 * MiB / 2, OW_MO = OW_MIX + 7 * MiB / 2, OW_IN2 = OW_MO + 2 * MiB, OW_OUT2 = OW_IN2 + 11 * MiB, OW_GLU = OW_OUT2 + 11 * MiB / 2;
static_assert(OW_GLU + 131072 <= LW, "weights per layer");
constexpr size_t WS_H = 164 * MiB, WS_ACT = 196 * MiB, WS_Z = 284 * MiB, WS_YG = 340 * MiB, WS_YCAT = 348 * MiB, WS_SHW = 380 * MiB, WS_SS = 383 * MiB, WS_XB = 384 * MiB, WS_END = 416 * MiB;
constexpr int LDS_BYTES = 147456;
#ifndef SGU_REP
#define SGU_REP 1
#endif
#ifndef S5_REP
#define S5_REP 1
#endif
#ifndef PC_REP
#define PC_REP 1
#endif
#ifndef PREP_REP
#define PREP_REP 1
#endif
#ifndef PREP_TILE_REP
#define PREP_TILE_REP 1
#endif
#ifndef TPROBE
#define TPROBE 0
#endif
#ifndef SLOT_MAP
#define SLOT_MAP 0x87653210ull
#define SLOT_REP 0u
#define NSLOT 8
#endif
constexpr int NPH = 2 + NL * NSLOT;
constexpr int TILES_PER_LAYER = 176 + 88 + 48 + 32 + 176 + 88 + 2;

struct Args { const float* in[30]; float* out; unsigned char* ws; int ph_lo, ph_hi; };
typedef const Args __attribute__((address_space(4)))& ArgsRef;

__device__ __forceinline__ float wave_sum(float v) {
#pragma unroll
    for (int o = 1; o < 64; o <<= 1) v += __shfl_xor(v, o);
    return v;
}
#define LDS_WAIT() asm volatile("s_waitcnt lgkmcnt(0)" ::: "memory")

struct TileDesc { const float* W; bf16* WT; int K, N, k0, n0, swiglu; };
__device__ __forceinline__ TileDesc tile_decode(ArgsRef a, int item) {
    const int l = item / TILES_PER_LAYER; int r = item % TILES_PER_LAYER;
    unsigned char* wl = a.ws + WS_W + (size_t)l * LW; TileDesc t;
    if (r < 176) t = TileDesc{a.in[5] + (size_t)l * 1024 * 5632, (bf16*)(wl + OW_IN1), 1024, 5632, 128 * (r / 22), 256 * (r % 22), 1};
    else if ((r -= 176) < 88) t = TileDesc{a.in[6] + (size_t)l * DFF * 1024, (bf16*)(wl + OW_OUT1), DFF, 1024, 128 * (r / 4), 256 * (r % 4), 0};
    else if ((r -= 88) < 48) { const int nb = r % 6; t = TileDesc{a.in[8] + (size_t)l * 1024 * PIN, (bf16*)(wl + OW_MIX), 1024, PIN, 128 * (r / 6), 256 * (nb < 2 ? nb : nb + 1), 0}; }
    else if ((r -= 48) < 32) t = TileDesc{a.in[25] + (size_t)l * 1024 * 1024, (bf16*)(wl + OW_MO), 1024, 1024, 128 * (r / 4), 256 * (r % 4), 0};
    else if ((r -= 32) < 176) t = TileDesc{a.in[27] + (size_t)l * 1024 * 5632, (bf16*)(wl + OW_IN2), 1024, 5632, 128 * (r / 22), 256 * (r % 22), 1};
    else if ((r -= 176) < 88) t = TileDesc{a.in[28] + (size_t)l * DFF * 1024, (bf16*)(wl + OW_OUT2), DFF, 1024, 128 * (r / 4), 256 * (r % 4), 0};
    else { r -= 88; t = TileDesc{a.in[22] + (size_t)l * 65536, (bf16*)(wl + OW_GLU), 256, 256, 128 * r, 0, 0}; }
    return t;
}
__device__ __forceinline__ void tile_load(const TileDesc& t, float (&v)[16][4], int wave, int lane) {
    const float* wp = t.W + (size_t)(t.k0 + 16 * wave) * t.N + t.n0 + lane;
#pragma unroll
    for (int r = 0; r < 16; ++r)
#pragma unroll
        for (int e = 0; e < 4; ++e) v[r][e] = __builtin_nontemporal_load(wp + (size_t)r * t.N + 64 * e);
}
__device__ __forceinline__ void tile_to_lds(const float (&v)[16][4], LAS unsigned char* lds, int wave, int lane) {
#pragma unroll
    for (int e = 0; e < 4; ++e)
#pragma unroll
        for (int hq = 0; hq < 2; ++hq) { u32x4 o; o.x = cvt_pk_bf16(v[8 * hq][e], v[8 * hq + 1][e]); o.y = cvt_pk_bf16(v[8 * hq + 2][e], v[8 * hq + 3][e]); o.z = cvt_pk_bf16(v[8 * hq + 4][e], v[8 * hq + 5][e]); o.w = cvt_pk_bf16(v[8 * hq + 6][e], v[8 * hq + 7][e]);
            *(LAS u32x4*)(lds + (lane + 64 * e) * 272 + (16 * wave + 8 * hq) * 2) = o; }
}
__device__ __forceinline__ void tile_store(const TileDesc& t, LAS unsigned char* lds, int wave, int lane) {
#pragma unroll
    for (int j = 0; j < 8; ++j) { const int nl = 32 * wave + 4 * j + (lane >> 4), n = t.n0 + nl;
        const u32x4 o = *(const LAS u32x4*)(lds + nl * 272 + 16 * (lane & 15));
        const int dsw = n < DFF ? (n >> 7) * 256 + (n & 127) : ((n - DFF) >> 7) * 256 + 128 + ((n - DFF) & 127);
        const int dst = t.swiglu ? dsw : n;
        *(u32x4*)(t.WT + (size_t)dst * t.K + t.k0 + 8 * (lane & 15)) = o; }
}

__device__ __forceinline__ void prep_phase(ArgsRef a, LAS unsigned char* lds, int tid, int wave, int lane, int G) {
    LAS float* sc = (LAS float*)lds;
    LAS float* R = (LAS float*)(lds + 32768);
    float* cond = (float*)(a.ws + WS_COND);
    const bool cond_blk = (G >= 256) ? (blockIdx.x < 144) : true;
    if (cond_blk) {
        const float* c_in = a.in[1];
        for (int i = tid; i < 8 * 1024; i += 512) { const float v = c_in[i]; sc[i] = v / (1.0f + expf(-v)); }
        __syncthreads();
        for (int it = blockIdx.x; it < NL * 36; it += (G >= 256 ? 144 : G)) {
            const int l = it / 36, n0 = 256 * (it % 36);
            const float* wp = a.in[2] + ((size_t)l * 1024 + 128 * wave) * NCOND + n0 + 4 * lane;
            f32x4 acc[8];
#pragma unroll
            for (int b = 0; b < 8; ++b) acc[b] = (f32x4){0.f, 0.f, 0.f, 0.f};
            for (int k0 = 0; k0 < 128; k0 += 8) {
                f32x4 wv[8];
#pragma unroll
                for (int kk = 0; kk < 8; ++kk) wv[kk] = __builtin_nontemporal_load((const f32x4*)(wp + (size_t)(k0 + kk) * NCOND));
#pragma unroll
                for (int q = 0; q < 2; ++q)
#pragma unroll
                    for (int b = 0; b < 8; ++b) { const f32x4 s4 = *(const LAS f32x4*)(sc + b * 1024 + 128 * wave + k0 + 4 * q);
#pragma unroll
                        for (int e = 0; e < 4; ++e) acc[b] += wv[4 * q + e] * s4[e]; }
            }
#pragma unroll
            for (int b = 0; b < 8; ++b) *(LAS f32x4*)(R + (wave * 8 + b) * 256 + 4 * lane) = acc[b];
            __syncthreads();
            { const int b = wave; f32x4 s = *(const f32x4*)(a.in[3] + (size_t)l * NCOND + n0 + 4 * lane);
#pragma unroll
              for (int w = 0; w < 8; ++w) s += *(const LAS f32x4*)(R + (w * 8 + b) * 256 + 4 * lane);
              *(f32x4*)(cond + ((size_t)l * 8 + b) * NCOND + n0 + 4 * lane) = s; }
            __syncthreads();
        }
    }
    int first, stride, count;
    if (G >= 256) { if (blockIdx.x < 144) { first = blockIdx.x * 7; stride = 1; count = 7; } else { count = (NL * TILES_PER_LAYER - 1008 + (G - 144) - 1) / (G - 144); first = 1008 + (blockIdx.x - 144) * count; stride = 1; } }
    else { first = blockIdx.x; stride = G; count = (NL * TILES_PER_LAYER + G - 1) / G; }
    for (int rp = 0; rp < PREP_TILE_REP; ++rp)
    {
        int lim = NL * TILES_PER_LAYER; if (G >= 256 && blockIdx.x < 144) lim = 1008;
        int nt = 0; for (int j = 0; j < count; ++j) if (first + j * stride < lim) nt = j + 1;
        float v[16][4];
        TileDesc cur = tile_decode(a, nt > 0 ? first : 0);
        if (nt > 0) tile_load(cur, v, wave, lane);
        for (int j = 0; j < nt; ++j) {
            tile_to_lds(v, lds, wave, lane);
            TileDesc nxt = cur;
            if (j + 1 < nt) { nxt = tile_decode(a, first + (j + 1) * stride); tile_load(nxt, v, wave, lane); }
            __syncthreads();
            tile_store(cur, lds, wave, lane);
            __syncthreads();
            cur = nxt;
        }
    }
    const int gw = blockIdx.x * 8 + wave, NGW = G * 8;
    LAS float* F = (LAS float*)(lds + wave * 2048);
    for (int item = gw; item < NL * 512; item += NGW) {
        const int l = item >> 9, r = item & 511, kb = r >> 5, n8 = r & 31, g = n8 >> 3, d0 = 8 * (n8 & 7), k = 64 * kb + lane;
        unsigned char* wl = a.ws + WS_W + (size_t)l * LW;
        const float* pw = a.in[11] + (size_t)(l * 4 + g) * 4096 + (size_t)lane * 64 + d0;
        const f32x4 p0 = *(const f32x4*)pw, p1 = *(const f32x4*)(pw + 4);
        const float* wr = a.in[8] + ((size_t)l * 1024 + k) * PIN + 512 + 64 * g;
        f32x4 wrow[16];
#pragma unroll
        for (int j = 0; j < 16; ++j) wrow[j] = *(const f32x4*)(wr + 4 * j);
        const float* ps = a.in[12] + (size_t)l * 256 + 64 * g + d0;
        const f32x4 s0 = *(const f32x4*)ps, s1 = *(const f32x4*)(ps + 4);
        *(LAS f32x4*)(F + lane * 8) = p0; *(LAS f32x4*)(F + lane * 8 + 4) = p1;
        LDS_WAIT();
        f32x4 a0 = (f32x4){0.f, 0.f, 0.f, 0.f}, a1 = a0;
#pragma unroll
        for (int j = 0; j < 16; ++j)
#pragma unroll
            for (int e = 0; e < 4; ++e) { const int c = 4 * j + e; const f32x4 f0 = *(const LAS f32x4*)(F + c * 8), f1 = *(const LAS f32x4*)(F + c * 8 + 4);
                a0 += f0 * wrow[j][e]; a1 += f1 * wrow[j][e]; }
        a0 = a0 * s0; a1 = a1 * s1;
        bf16* WT = (bf16*)(wl + OW_MIX) + (size_t)(512 + 64 * g + d0) * 1024 + k;
#pragma unroll
        for (int i = 0; i < 4; ++i) { WT[(size_t)i * 1024] = (bf16)(cvt_pk_bf16(a0[i], 0.f) & 0xffffu); WT[(size_t)(4 + i) * 1024] = (bf16)(cvt_pk_bf16(a1[i], 0.f) & 0xffffu); }
        LDS_WAIT();
    }
}

__device__ __forceinline__ void norm_phase(const float* x, const float* g, const float* sh, const float* scl, bf16* h, bf16* xb, int gw, int NGW, int lane) {
    for (int row = gw; row < M; row += NGW) {
        const f32x4* xr = (const f32x4*)(x + (size_t)row * D) + lane;
        f32x4 v[4]; float s = 0.f;
#pragma unroll
        for (int j = 0; j < 4; ++j) { v[j] = xr[64 * j]; s += (v[j][0] * v[j][0] + v[j][1] * v[j][1]) + (v[j][2] * v[j][2] + v[j][3] * v[j][3]); }
        const float rstd = 1.0f / sqrtf(wave_sum(s) * (1.0f / D) + EPS);
        const size_t cb = (size_t)(row >> 11) * NCOND;
        u32x2* o = (u32x2*)(h + (size_t)row * D) + lane;
        u32x2* ob = (u32x2*)(xb + (size_t)row * D) + lane;
#pragma unroll
        for (int j = 0; j < 4; ++j) { u32x2 w; w.x = cvt_pk_bf16(v[j][0], v[j][1]); w.y = cvt_pk_bf16(v[j][2], v[j][3]); ob[64 * j] = w; }
#pragma unroll
        for (int j = 0; j < 4; ++j) { const int col = 4 * lane + 256 * j;
            const f32x4 gg = *(const f32x4*)(g + col), ss = *(const f32x4*)(scl + cb + col), hh = *(const f32x4*)(sh + cb + col);
            const f32x4 y = (v[j] * rstd * gg) * (ss + 1.0f) + hh;
            u32x2 w; w.x = cvt_pk_bf16(y[0], y[1]); w.y = cvt_pk_bf16(y[2], y[3]); o[64 * j] = w; }
    }
}
__device__ __forceinline__ void final_norm_phase(float* x, const float* g, int gw, int NGW, int lane) {
    for (int row = gw; row < M; row += NGW) {
        f32x4* xr = (f32x4*)(x + (size_t)row * D) + lane;
        f32x4 v[4]; float s = 0.f;
#pragma unroll
        for (int j = 0; j < 4; ++j) { v[j] = xr[64 * j]; s += (v[j][0] * v[j][0] + v[j][1] * v[j][1]) + (v[j][2] * v[j][2] + v[j][3] * v[j][3]); }
        const float rstd = 1.0f / sqrtf(wave_sum(s) * (1.0f / D) + EPS);
#pragma unroll
        for (int j = 0; j < 4; ++j) { const f32x4 gg = *(const f32x4*)(g + 4 * lane + 256 * j); xr[64 * j] = v[j] * rstd * gg; }
    }
}

__device__ __forceinline__ f32x4 ld4bf(const bf16* p) { const u32x2 w = *(const u32x2*)p; return (f32x4){bf_lo(w.x), bf_hi(w.x), bf_lo(w.y), bf_hi(w.y)}; }
__device__ __forceinline__ void st4bf(bf16* p, f32x4 v) { u32x2 w; w.x = cvt_pk_bf16(v[0], v[1]); w.y = cvt_pk_bf16(v[2], v[3]); *(u32x2*)p = w; }
__device__ __forceinline__ bf16x8 pack8(f32x4 lo, f32x4 hi) { u32x4 w; w.x = cvt_pk_bf16(lo[0], lo[1]); w.y = cvt_pk_bf16(lo[2], lo[3]); w.z = cvt_pk_bf16(hi[0], hi[1]); w.w = cvt_pk_bf16(hi[2], hi[3]); return __builtin_bit_cast(bf16x8, w); }

__device__ __forceinline__ void sgu_item(ArgsRef a, int l, int it, LAS unsigned char* lds, int tid, int wave, int lane) {
    const bf16* z = (const bf16*)(a.ws + WS_Z); bf16* ycat = (bf16*)(a.ws + WS_YCAT);
    LAS bf16* vT = (LAS bf16*)lds;
    const int tok0 = it * 128;
    { const int s = tid >> 2, q = tid & 3;
      u32x4 raw[4][2];
#pragma unroll
      for (int h = 0; h < 4; ++h) { const u32x4* zp = (const u32x4*)(z + (size_t)(tok0 + s) * PIN + 256 + 64 * h + 16 * q); raw[h][0] = zp[0]; raw[h][1] = zp[1]; }
#pragma unroll
      for (int h = 0; h < 4; ++h) {
          float v[16]; float sum = 0.f;
#pragma unroll
          for (int j = 0; j < 2; ++j) { const u32x4 rw = raw[h][j]; const unsigned ww[4] = {rw.x, rw.y, rw.z, rw.w};
#pragma unroll
              for (int e = 0; e < 4; ++e) { v[8 * j + 2 * e] = gelu_tanh(bf_lo(ww[e])); v[8 * j + 2 * e + 1] = gelu_tanh(bf_hi(ww[e])); sum += v[8 * j + 2 * e] + v[8 * j + 2 * e + 1]; } }
          sum += __shfl_xor(sum, 1); sum += __shfl_xor(sum, 2);
          const float mu = sum * (1.0f / 64.0f); float q2 = 0.f;
#pragma unroll
          for (int e = 0; e < 16; ++e) { v[e] -= mu; q2 += v[e] * v[e]; }
          q2 += __shfl_xor(q2, 1); q2 += __shfl_xor(q2, 2);
          const float rs = 1.0f / sqrtf(q2 * (1.0f / 64.0f) + EPS);
#pragma unroll
          for (int e = 0; e < 16; ++e) vT[(64 * h + 16 * q + e) * 136 + s] = (bf16)(cvt_pk_bf16(v[e] * rs, 0.f) & 0xffffu);
      } }
    __syncthreads();
    const int fr = lane & 15, fq = lane >> 4, t = 16 * wave + fr, nks = (wave >> 1) + 1;
    f32x4 acc[16];
#pragma unroll
    for (int i = 0; i < 16; ++i) acc[i] = (f32x4){0.f, 0.f, 0.f, 0.f};
    {
        const float* wbase = a.in[9] + ((size_t)(l * 4) * 128 + t) * 128 + 8 * fq;
        f32x4 wq[2][4][2];
#pragma unroll
        for (int ks = 0; ks < 4; ++ks) { wq[0][ks][0] = (f32x4){0.f, 0.f, 0.f, 0.f}; wq[0][ks][1] = wq[0][ks][0];
            if (ks < nks) { wq[0][ks][0] = *(const f32x4*)(wbase + 32 * ks); wq[0][ks][1] = *(const f32x4*)(wbase + 32 * ks + 4); } }
#pragma unroll
        for (int h = 0; h < 4; ++h) {
            if (h < 3) {
#pragma unroll
                for (int ks = 0; ks < 4; ++ks) { wq[(h + 1) & 1][ks][0] = (f32x4){0.f, 0.f, 0.f, 0.f}; wq[(h + 1) & 1][ks][1] = wq[(h + 1) & 1][ks][0];
                    if (ks < nks) { wq[(h + 1) & 1][ks][0] = *(const f32x4*)(wbase + (size_t)(h + 1) * 16384 + 32 * ks); wq[(h + 1) & 1][ks][1] = *(const f32x4*)(wbase + (size_t)(h + 1) * 16384 + 32 * ks + 4); } }
            }
#pragma unroll
            for (int ks = 0; ks < 4; ++ks) if (ks < nks) {
                f32x4 w0 = wq[h & 1][ks][0], w1 = wq[h & 1][ks][1];
                const int s0 = 32 * ks + 8 * fq;
#pragma unroll
                for (int e = 0; e < 4; ++e) { if (s0 + e > t) w0[e] = 0.f; if (s0 + 4 + e > t) w1[e] = 0.f; }
                const bf16x8 wf = pack8(w0, w1);
#pragma unroll
                for (int dt = 0; dt < 4; ++dt) { const bf16x8 vf = *(const LAS bf16x8*)(vT + (64 * h + 16 * dt + fr) * 136 + 32 * ks + 8 * fq);
                    acc[h * 4 + dt] = __builtin_amdgcn_mfma_f32_16x16x32_bf16(vf, wf, acc[h * 4 + dt], 0, 0, 0); }
            }
        }
    }
    const size_t tok = (size_t)tok0 + t; float ss = 0.f;
#pragma unroll
    for (int h = 0; h < 4; ++h) { const float bias = a.in[10][(size_t)(l * 4 + h) * 128 + t];
#pragma unroll
        for (int dt = 0; dt < 4; ++dt) { const f32x4 u4 = ld4bf(z + tok * PIN + 64 * h + 16 * dt + 4 * fq); f32x4 o;
#pragma unroll
            for (int e = 0; e < 4; ++e) { o[e] = gelu_tanh(u4[e]) * (acc[h * 4 + dt][e] + bias); ss += o[e] * o[e]; }
            acc[h * 4 + dt] = o; } }
    ss += __shfl_xor(ss, 16); ss += __shfl_xor(ss, 32);
    const float rstd = 1.0f / sqrtf(ss * (1.0f / 256.0f) + EPS);
    const float* gn = a.in[24] + (size_t)l * 1024;
#pragma unroll
    for (int h = 0; h < 4; ++h)
#pragma unroll
        for (int dt = 0; dt < 4; ++dt) { const int ch = 64 * h + 16 * dt + 4 * fq; const f32x4 gg = *(const f32x4*)(gn + ch);
            st4bf(ycat + tok * 1024 + ch, acc[h * 4 + dt] * rstd * gg); }
    __syncthreads();
}

__device__ __forceinline__ void sincos_red(float ang, float& sn, float& cs) {
    const float n = rintf(ang * 0.15915494309189535f);
    float r = fmaf(-n, 6.2831854820251465f, ang); r = fmaf(-n, -1.7484556e-7f, r);
    const float h = 0.5f * r, h2 = h * h;
    const float s = h * (1.0f + h2 * (-1.6666667e-1f + h2 * (8.3333333e-3f + h2 * (-1.9841270e-4f + h2 * (2.7557319e-6f + h2 * (-2.5052108e-8f))))));
    const float c = 1.0f + h2 * (-0.5f + h2 * (4.1666667e-2f + h2 * (-1.3888889e-3f + h2 * (2.4801587e-5f + h2 * (-2.7557319e-7f + h2 * 2.0876757e-9f)))));
    sn = 2.0f * s * c; cs = 1.0f - 2.0f * s * s;
}

template <int PASS>
__device__ __forceinline__ void s5_span(const bf16* zu, bf16* ygp, LAS float* BU, LAS bf16* Xs, const bf16x8 (&bfrag)[8], const bf16x8 (&cf)[4], f32x4 dd, float are, float aim, float& xr, float& xi, int lane) {
    const int p = lane, fr = lane & 15, fq = lane >> 4;
    bf16x8 uf_n = (bf16x8){0, 0, 0, 0, 0, 0, 0, 0}; u32x2 u4_n = (u32x2){0u, 0u};
    if (fq < 2) uf_n = *(const bf16x8*)(zu + 8 * fq);
    if (PASS == 2) u4_n = *(const u32x2*)(zu + 4 * fq);
    for (int blk = 0; blk < 16; ++blk) {
        const bf16x8 uf = uf_n; const u32x2 u4w = u4_n;
        if (blk < 15) { const bf16* zn = zu + (size_t)(16 * (blk + 1)) * PIN;
            if (fq < 2) uf_n = *(const bf16x8*)(zn + 8 * fq);
            if (PASS == 2) u4_n = *(const u32x2*)(zn + 4 * fq); }
#pragma unroll
        for (int n = 0; n < 8; ++n) { const f32x4 acc = __builtin_amdgcn_mfma_f32_16x16x32_bf16(bfrag[n], uf, (f32x4){0.f, 0.f, 0.f, 0.f}, 0, 0, 0);
            *(LAS f32x4*)(BU + fr * 132 + 16 * n + 4 * fq) = acc; }
        LDS_WAIT();
#pragma unroll
        for (int t = 0; t < 16; ++t) { const float bur = BU[t * 132 + p], bui = BU[t * 132 + 64 + p];
            const float tr = are * xr - aim * xi + bur, ti = are * xi + aim * xr + bui; xr = tr; xi = ti;
            if (PASS == 2) { const unsigned w = cvt_pk_bf16(xr, xi); Xs[t * 136 + p] = (bf16)(w & 0xffffu); Xs[t * 136 + 64 + p] = (bf16)(w >> 16); } }
        if (PASS == 2) {
            LDS_WAIT();
            f32x4 acc = (f32x4){0.f, 0.f, 0.f, 0.f};
#pragma unroll
            for (int ks = 0; ks < 4; ++ks) { const bf16x8 xf = *(const LAS bf16x8*)(Xs + fr * 136 + 32 * ks + 8 * fq);
                acc = __builtin_amdgcn_mfma_f32_16x16x32_bf16(cf[ks], xf, acc, 0, 0, 0); }
            const f32x4 u4 = (f32x4){bf_lo(u4w.x), bf_hi(u4w.x), bf_lo(u4w.y), bf_hi(u4w.y)}; f32x4 y;
#pragma unroll
            for (int e = 0; e < 4; ++e) y[e] = gelu_tanh(acc[e] + dd[e] * u4[e]);
            st4bf(ygp + (size_t)(16 * blk) * 256, y);
        }
        asm volatile("s_waitcnt lgkmcnt(0)" ::: );
    }
}
__device__ __forceinline__ void s5_wg_item(ArgsRef a, int l, int bi, LAS unsigned char* lds, int wave, int lane) {
    const int g = bi & 15, b = bi >> 4, p = lane, fr = lane & 15, fq = lane >> 4;
    const bf16* z = (const bf16*)(a.ws + WS_Z);
    const int lg = l * 16 + g;
    const float dt = expf(a.in[21][lg]);
    const float lre = a.in[14][(size_t)lg * 64 + p], lim = a.in[15][(size_t)lg * 64 + p];
    const float mag = expf(lre * dt); float sn, cs; sincos_red(lim * dt, sn, cs);
    const float are = mag * cs, aim = mag * sn, nr = are - 1.0f, ni = aim, den = lre * lre + lim * lim;
    const float kre = (nr * lre + ni * lim) / den, kim = (ni * lre - nr * lim) / den;
    bf16x8 bfrag[8];
#pragma unroll
    for (int nn = 0; nn < 4; ++nn) { const int pp = 16 * nn + fr; const float kr = __shfl(kre, pp), ki = __shfl(kim, pp);
        const float* brp = a.in[16] + ((size_t)lg * 64 + pp) * 16 + 8 * (fq & 1); const float* bip = a.in[17] + ((size_t)lg * 64 + pp) * 16 + 8 * (fq & 1);
        const f32x4 br0 = *(const f32x4*)brp, br1 = *(const f32x4*)(brp + 4), bi0 = *(const f32x4*)bip, bi1 = *(const f32x4*)(bip + 4);
        bf16x8 fre = pack8(br0 * kr - bi0 * ki, br1 * kr - bi1 * ki), fim = pack8(bi0 * kr + br0 * ki, bi1 * kr + br1 * ki);
        if (fq >= 2) { fre = (bf16x8){0, 0, 0, 0, 0, 0, 0, 0}; fim = fre; }
        bfrag[nn] = fre; bfrag[nn + 4] = fim; }
    const size_t tok0 = (size_t)b * 2048 + 256 * wave;
    const bf16* zu = z + (tok0 + fr) * PIN + 1536 + 16 * g;
    bf16* ygp = (bf16*)(a.ws + WS_YG) + (tok0 + fr) * 256 + 16 * g + 4 * fq;
    LAS float* BU = (LAS float*)(lds + wave * 12800);
    LAS bf16* Xs = (LAS bf16*)(lds + wave * 12800 + 8448);
    LAS float* EX = (LAS float*)(lds + 102400);
    bf16x8 cf[4]; f32x4 dd = (f32x4){0.f, 0.f, 0.f, 0.f};
#pragma unroll
    for (int ks = 0; ks < 4; ++ks) cf[ks] = (bf16x8){0, 0, 0, 0, 0, 0, 0, 0};
    float xr = 0.f, xi = 0.f;
    s5_span<1>(zu, ygp, BU, Xs, bfrag, cf, dd, are, aim, xr, xi, lane);
    EX[wave * 128 + p] = xr; EX[wave * 128 + 64 + p] = xi;
    __syncthreads();
    {   float Ar = are, Ai = aim;
#pragma unroll
        for (int q = 0; q < 8; ++q) { const float tr = Ar * Ar - Ai * Ai, ti = 2.0f * Ar * Ai; Ar = tr; Ai = ti; }
        xr = 0.f; xi = 0.f;
#pragma unroll
        for (int w = 0; w < 7; ++w) if (w < wave) { const float er = EX[w * 128 + p], ei = EX[w * 128 + 64 + p];
            const float tr = Ar * xr - Ai * xi + er, ti = Ar * xi + Ai * xr + ei; xr = tr; xi = ti; }
    }
#pragma unroll
    for (int ks = 0; ks < 4; ++ks) { const float* cp = (ks < 2 ? a.in[18] : a.in[19]) + ((size_t)lg * 16 + fr) * 64 + 32 * (ks & 1) + 8 * fq;
        f32x4 c0 = *(const f32x4*)cp, c1 = *(const f32x4*)(cp + 4); if (ks >= 2) { c0 = -c0; c1 = -c1; } cf[ks] = pack8(c0, c1); }
    dd = *(const f32x4*)(a.in[20] + (size_t)l * 256 + 16 * g + 4 * fq);
    s5_span<2>(zu, ygp, BU, Xs, bfrag, cf, dd, are, aim, xr, xi, lane);
    __syncthreads();
}

__device__ __forceinline__ void poolconv_item(ArgsRef a, int l, int idx, int lane) {
    const bf16* z = (const bf16*)(a.ws + WS_Z); bf16* ycat = (bf16*)(a.ws + WS_YCAT);
    const int tokb = idx * 8, pos0 = tokb & 2047, ch = 4 * lane, gq = lane >> 4, wq = 2 << gq;
    const float m1 = gq >= 1 ? 1.0f : 0.0f, m2 = gq >= 2 ? 1.0f : 0.0f, m3 = gq >= 3 ? 1.0f : 0.0f;
    const float* gn = a.in[24] + (size_t)l * 1024;
    {   f32x4 row[23];
        const bf16* zp = z + (size_t)tokb * PIN + 512 + ch;
#pragma unroll
        for (int r = 0; r < 23; ++r) { row[r] = (f32x4){0.f, 0.f, 0.f, 0.f}; if (pos0 - 15 + r >= 0) row[r] = ld4bf(zp + (ptrdiff_t)(r - 15) * PIN); }
        const f32x4 gg = *(const f32x4*)(gn + 256 + ch);
#pragma unroll
        for (int tt = 0; tt < 8; ++tt) {
            f32x4 sum = row[15 + tt] + row[14 + tt];
            sum += (row[13 + tt] + row[12 + tt]) * m1;
            sum += ((row[11 + tt] + row[10 + tt]) + (row[9 + tt] + row[8 + tt])) * m2;
            sum += (((row[7 + tt] + row[6 + tt]) + (row[5 + tt] + row[4 + tt])) + ((row[3 + tt] + row[2 + tt]) + (row[1 + tt] + row[tt]))) * m3;
            const int pos = pos0 + tt, cnt = (pos + 1 < wq) ? pos + 1 : wq;
            const f32x4 o = sum * (1.0f / (float)cnt) - row[15 + tt];
            const float ss = wave_sum((o[0] * o[0] + o[1] * o[1]) + (o[2] * o[2] + o[3] * o[3]));
            const float rstd = 1.0f / sqrtf(ss * (1.0f / 256.0f) + EPS);
            st4bf(ycat + (size_t)(tokb + tt) * 1024 + 256 + ch, o * rstd * gg); }
    }
    {   f32x4 prod[10], bg[8];
        const bf16* zp = z + (size_t)tokb * PIN + 768 + ch;
#pragma unroll
        for (int r = 0; r < 10; ++r) { prod[r] = (f32x4){0.f, 0.f, 0.f, 0.f}; if (pos0 - 2 + r >= 0) prod[r] = ld4bf(zp + (ptrdiff_t)(r - 2) * PIN + 256) * ld4bf(zp + (ptrdiff_t)(r - 2) * PIN + 512); }
#pragma unroll
        for (int tt = 0; tt < 8; ++tt) bg[tt] = ld4bf(zp + (size_t)tt * PIN);
        const f32x4 w0 = *(const f32x4*)(a.in[13] + ((size_t)l * 3 + 0) * 256 + ch), w1 = *(const f32x4*)(a.in[13] + ((size_t)l * 3 + 1) * 256 + ch), w2 = *(const f32x4*)(a.in[13] + ((size_t)l * 3 + 2) * 256 + ch);
        const f32x4 gg = *(const f32x4*)(gn + 512 + ch);
#pragma unroll
        for (int tt = 0; tt < 8; ++tt) {
            const f32x4 o = bg[tt] * (w0 * prod[tt] + w1 * prod[tt + 1] + w2 * prod[tt + 2]);
            const float ss = wave_sum((o[0] * o[0] + o[1] * o[1]) + (o[2] * o[2] + o[3] * o[3]));
            const float rstd = 1.0f / sqrtf(ss * (1.0f / 256.0f) + EPS);
            st4bf(ycat + (size_t)(tokb + tt) * 1024 + 512 + ch, o * rstd * gg); }
    }
}

__device__ __forceinline__ void glu_item(ArgsRef a, int l, int it, LAS unsigned char* lds, int tid, int wave, int lane) {
    const bf16* yg = (const bf16*)(a.ws + WS_YG) + (size_t)it * 64 * 256; bf16* ycat = (bf16*)(a.ws + WS_YCAT) + (size_t)it * 64 * 1024 + 768;
    const bf16* Bt = (const bf16*)(a.ws + WS_W + (size_t)l * LW + OW_GLU);
    LAS unsigned char* T = lds;
    LAS float* P = (LAS float*)(lds + 34816);
    const int fr = lane & 15, fq = lane >> 4, n0 = 32 * wave;
    u32x4 st[4];
#pragma unroll
    for (int j = 0; j < 4; ++j) { const int idx = tid + 512 * j; st[j] = *(const u32x4*)(yg + (size_t)(idx >> 5) * 256 + 8 * (idx & 31)); }
    bf16x8 bfr[2][8];
#pragma unroll
    for (int nt = 0; nt < 2; ++nt)
#pragma unroll
        for (int ks = 0; ks < 8; ++ks) bfr[nt][ks] = *(const bf16x8*)(Bt + (size_t)(n0 + 16 * nt + fr) * 256 + 32 * ks + 8 * fq);
#pragma unroll
    for (int j = 0; j < 4; ++j) { const int idx = tid + 512 * j; *(LAS u32x4*)(T + (idx >> 5) * 528 + 16 * (idx & 31)) = st[j]; }
    __syncthreads();
    f32x4 acc[4][2];
#pragma unroll
    for (int tt = 0; tt < 4; ++tt) { acc[tt][0] = (f32x4){0.f, 0.f, 0.f, 0.f}; acc[tt][1] = acc[tt][0]; }
#pragma unroll
    for (int ks = 0; ks < 8; ++ks)
#pragma unroll
        for (int tt = 0; tt < 4; ++tt) { const bf16x8 af = *(const LAS bf16x8*)(T + (16 * tt + fr) * 528 + (32 * ks + 8 * fq) * 2);
            acc[tt][0] = __builtin_amdgcn_mfma_f32_16x16x32_bf16(bfr[0][ks], af, acc[tt][0], 0, 0, 0);
            acc[tt][1] = __builtin_amdgcn_mfma_f32_16x16x32_bf16(bfr[1][ks], af, acc[tt][1], 0, 0, 0); }
    const f32x4 gb0 = *(const f32x4*)(a.in[23] + (size_t)l * 256 + n0 + 4 * fq), gb1 = *(const f32x4*)(a.in[23] + (size_t)l * 256 + n0 + 16 + 4 * fq);
#pragma unroll
    for (int tt = 0; tt < 4; ++tt) { float ss = 0.f;
#pragma unroll
        for (int nt = 0; nt < 2; ++nt) { const u32x2 yw = *(const LAS u32x2*)(T + (16 * tt + fr) * 528 + (n0 + 16 * nt + 4 * fq) * 2);
            const f32x4 y = (f32x4){bf_lo(yw.x), bf_hi(yw.x), bf_lo(yw.y), bf_hi(yw.y)}; const f32x4 g4 = nt ? gb1 : gb0; f32x4 o;
#pragma unroll
            for (int e = 0; e < 4; ++e) { o[e] = y[e] * pg8::sigmoid_f(acc[tt][nt][e] + g4[e]); ss += o[e] * o[e]; }
            acc[tt][nt] = o; }
        ss += __shfl_xor(ss, 16); ss += __shfl_xor(ss, 32);
        if (fq == 0) P[(16 * tt + fr) * 8 + wave] = ss; }
    __syncthreads();
    const float* gn = a.in[24] + (size_t)l * 1024 + 768;
    const f32x4 gg0 = *(const f32x4*)(gn + n0 + 4 * fq), gg1 = *(const f32x4*)(gn + n0 + 16 + 4 * fq);
#pragma unroll
    for (int tt = 0; tt < 4; ++tt) { const int t = 16 * tt + fr; const f32x4 p0 = *(const LAS f32x4*)(P + t * 8), p1 = *(const LAS f32x4*)(P + t * 8 + 4);
        const float rstd = __builtin_amdgcn_rsqf((((p0[0] + p0[1]) + (p0[2] + p0[3])) + ((p1[0] + p1[1]) + (p1[2] + p1[3]))) * (1.0f / 256.0f) + EPS);
        st4bf(ycat + (size_t)t * 1024 + n0 + 4 * fq, acc[tt][0] * rstd * gg0); st4bf(ycat + (size_t)t * 1024 + n0 + 16 + 4 * fq, acc[tt][1] * rstd * gg1); }
    __syncthreads();
}

#define XB_TMO      128
#define XB_XCNT(j)  (256  + 64 * (j))
#define XB_XSUB(j)  (1280 + 64 * (j))
#define XB_XGEN(j)  (2304 + 64 * (j))
#define XB_TOP      3328
#define XB_TOPGEN   3392
#define XCD_BAR_WORDS 3456
#define XB_SPIN_CAP (1u << 18)

__device__ __forceinline__ unsigned xb_ld(unsigned* p)              { return __hip_atomic_load(p, __ATOMIC_RELAXED, __HIP_MEMORY_SCOPE_AGENT); }
__device__ __forceinline__ unsigned xb_add(unsigned* p, unsigned v) { return __hip_atomic_fetch_add(p, v, __ATOMIC_RELAXED, __HIP_MEMORY_SCOPE_AGENT); }
__device__ __forceinline__ unsigned xb_xcc_id() { return (unsigned)__builtin_amdgcn_s_getreg((3 << 11) | 20) & 0xFu; }
#define XB_SPIN(cond, bar) do { unsigned _sp = 0; while (cond) { __builtin_amdgcn_s_sleep(1); \
    if ((++_sp & 255u) == 0u) { if (xb_ld(&(bar)[XB_TMO])) break; if (_sp > XB_SPIN_CAP) { atomicAdd(&(bar)[XB_TMO], 1u); break; } } } } while (0)

struct XcdBarrier {
    unsigned* bar; unsigned x;
    volatile LAS unsigned* st;
};

__device__ __forceinline__ XcdBarrier xcd_barrier_post(unsigned* bar, volatile LAS unsigned* st) {
    XcdBarrier b; b.bar = bar; b.x = xb_xcc_id(); b.st = st;
    if (threadIdx.x == 0) (void)xb_add(&bar[XB_XCNT(b.x)], 1u);
    return b;
}
__device__ __forceinline__ void xcd_barrier_complete(unsigned* bar, unsigned x, unsigned& nloc, unsigned& nx) {
    const unsigned G = gridDim.x * gridDim.y * gridDim.z;
    unsigned sum, cnt, mine, sp = 0u;
    for (;;) {
        sum = 0u; cnt = 0u; mine = 0u;
#pragma unroll 1
        for (unsigned j = 0; j < 16; ++j) { const unsigned c = xb_ld(&bar[XB_XCNT(j)]); sum += c; cnt += (c > 0u) ? 1u : 0u; mine = (j == x) ? c : mine; }
        if (sum == G) break;
        __builtin_amdgcn_s_sleep(1);
        if ((++sp & 255u) == 0u) { if (xb_ld(&bar[XB_TMO])) break; if (sp > XB_SPIN_CAP) { atomicAdd(&bar[XB_TMO], 1u); break; } }
    }
    nloc = mine > 0u ? mine : 1u; nx = cnt > 0u ? cnt : 1u;
}

__device__ __forceinline__ void xcd_barrier(const XcdBarrier& b) {
    asm volatile("s_waitcnt vmcnt(0)" ::: "memory");
    __syncthreads();
    if (threadIdx.x == 0) {
        unsigned* bar = b.bar;
        __builtin_amdgcn_s_waitcnt(0);
        unsigned nloc = b.st[0], nx = b.st[1];
        if (nloc == 0u) { xcd_barrier_complete(bar, b.x, nloc, nx); b.st[0] = nloc; b.st[1] = nx; }
        const unsigned old = xb_add(&bar[XB_XSUB(b.x)], 1u);
        const unsigned gen = old / nloc;
        if (old + 1u == (gen + 1u) * nloc) {
            __builtin_amdgcn_fence(__ATOMIC_RELEASE, "agent");
            asm volatile("s_waitcnt vmcnt(0)" ::: "memory");
            const unsigned og = xb_add(&bar[XB_TOP], 1u);
            const unsigned tg = og / nx;
            if (og + 1u == (tg + 1u) * nx) xb_add(&bar[XB_TOPGEN], 1u);
            else XB_SPIN(xb_ld(&bar[XB_TOPGEN]) == tg, bar);
            __builtin_amdgcn_fence(__ATOMIC_ACQUIRE, "agent");
            xb_add(&bar[XB_XGEN(b.x)], 1u);
            asm volatile("s_waitcnt vmcnt(0)" ::: "memory");
        } else {
            XB_SPIN(xb_ld(&bar[XB_XGEN(b.x)]) == gen, bar);
            __builtin_amdgcn_fence(__ATOMIC_ACQUIRE, "agent");
            asm volatile("s_waitcnt vmcnt(0)" ::: "memory");
        }
    }
    __syncthreads();
}

#ifndef SYNC_REP
#define SYNC_REP 1
#endif
#ifndef REP_MASK
#define REP_MASK 0
#endif
#ifndef PHM
#define PHM 0xfff
#endif
#ifndef PER_PHASE_LAUNCH
#define PER_PHASE_LAUNCH 0
#endif
__global__ void __launch_bounds__(512) mega(Args a_) {
    extern __shared__ __attribute__((aligned(16))) unsigned char lds_raw[];
    LAS unsigned char* lds = (LAS unsigned char*)lds_raw;
    const int G = gridDim.x, NGW = G * 8;
    const int ph_lo = a_.ph_lo, ph_hi = a_.ph_hi;
    const bool multi = (ph_hi - ph_lo) > 1;
    unsigned char* const ws0 = a_.ws;
    volatile LAS unsigned* MISC = (volatile LAS unsigned*)(lds + 131072 + 320);
    if (threadIdx.x < 32) MISC[threadIdx.x] = 0u;
    __syncthreads();
    XcdBarrier bar; bar.bar = (unsigned*)(ws0 + WS_BAR); bar.x = 0; bar.st = nullptr;
    if (multi) bar = xcd_barrier_post((unsigned*)(ws0 + WS_BAR), MISC + 8);
    if (ph_lo < 0) cg::this_grid().sync();
    unsigned long long tacc = 0ull;
    for (int ph = ph_lo; ph < ph_hi; ++ph) {
        const unsigned long long tph0 = TPROBE ? __builtin_amdgcn_s_memrealtime() : 0ull;
        int tid = threadIdx.x; asm volatile("" : "+v"(tid));
        const int lane = tid & 63, wave = __builtin_amdgcn_readfirstlane(tid >> 6), gw = blockIdx.x * 8 + wave;
        const Args __attribute__((address_space(4)))* ap = (const Args __attribute__((address_space(4)))*)__builtin_amdgcn_kernarg_segment_ptr(); asm volatile("" : "+s"(ap));
        ArgsRef a = *ap;
        unsigned char* ws = a.ws;
        float* cond = (float*)(ws + WS_COND); float* SS = (float*)(ws + WS_SS); const float* SHW = (const float*)(ws + WS_SHW);
        bf16* H = (bf16*)(ws + WS_H); bf16* ACT = (bf16*)(ws + WS_ACT); bf16* Z = (bf16*)(ws + WS_Z); bf16* YG = (bf16*)(ws + WS_YG); bf16* YCAT = (bf16*)(ws + WS_YCAT);
        if (ph == 0) { for (int rp = 0; rp < PREP_REP; ++rp) { if (rp) { XcdBarrier b3 = bar; asm volatile("" : "+s"(b3.bar)); xcd_barrier(b3); } prep_phase(a, lds, tid, wave, lane, G); } }
        else if (ph == 1) norm_phase(a.in[0], a.in[4], cond, cond + 1024, H, (bf16*)(ws + WS_XB), gw, NGW, lane);
        else {
            const int l = (ph - 2) / NSLOT, slot = (ph - 2) % NSLOT, s = (int)((SLOT_MAP >> (4 * slot)) & 15ull); const bool rep = ((SLOT_REP >> slot) & 1u) != 0u;
            unsigned char* wl = ws + WS_W + (size_t)l * LW;
            const float* cl = cond + (size_t)l * 8 * NCOND;
            if ((PHM & 8) && (s == 0 || s == 7)) {
                pg8::Gemm gm{H, (const bf16*)(wl + (s == 0 ? OW_IN1 : OW_IN2)), M, 2 * DFF, D}; pg8::StaticOrder S; S.init(M, 2 * DFF, G, (int)blockIdx.x);
                pg8::EpiSwiglu E{ACT, DFF};
                pg8::gemm_phase<pg8::EpiSwiglu, pg8::StaticOrder>(lds, gm, S, E, nullptr, tid);
            } else if ((PHM & 16) && (s == 1 || s == 6 || s == 8)) {
                const bf16* A = (s == 6) ? YCAT : ACT; const int K = (s == 6) ? D : DFF;
                const bf16* Bt = (const bf16*)(wl + (s == 1 ? OW_OUT1 : (s == 6 ? OW_MO : OW_OUT2)));
                pg8::Gemm gm{A, Bt, M, D, K}; pg8::StaticOrder S; S.init(M, D, G, (int)blockIdx.x);
                bf16* XB = (bf16*)(ws + WS_XB);
                const float* gnext = (s == 1) ? a.in[7] + (size_t)l * D : (s == 6 ? a.in[26] + (size_t)l * D : (l == NL - 1 ? a.in[29] : a.in[4] + (size_t)(l + 1) * D));
                const float* shnext = (s == 1) ? cl + 3 * 1024 : (s == 6 ? cl + 6 * 1024 : cl + (size_t)8 * NCOND);
                const float* scnext = shnext + 1024;
                bf16* xa = (s == 8 && l == NL - 1) ? (bf16*)nullptr : H;
                const float gs = __builtin_bit_cast(float, __builtin_amdgcn_readfirstlane(s == 6 ? 0x3f800000 : 0x3f000000));
                const unsigned need = 32u * (unsigned)(l * 3 + (s == 1 ? 0 : (s == 6 ? 1 : 2)) + 1);
                pg8::EpiResid E{XB, XB, a.out, cl + (s == 1 ? 2 : (s == 6 ? 5 : 8)) * 1024, gnext, scnext, shnext, xa, (unsigned*)(ws + WS_SS), (unsigned*)(ws + WS_BAR + 16384), gs, need};
                pg8::gemm_phase<pg8::EpiResid, pg8::StaticOrder>(lds, gm, S, E, nullptr, tid);
            } else if ((PHM & 32) && s == 2) {
                pg8::Gemm gm{H, (const bf16*)(wl + OW_MIX), M, PIN, D}; pg8::StaticOrder S; S.init(M, PIN, G, (int)blockIdx.x);
                pg8::EpiZ E{Z, PIN};
                pg8::gemm_phase<pg8::EpiZ, pg8::StaticOrder>(lds, gm, S, E, nullptr, tid);
            } else if ((PHM & 64) && s == 3) {
                int w_first = gw, w_stride = NGW;
                if (G >= 256) { w_first = (blockIdx.x < 128) ? blockIdx.x * 8 + wave : 2048; w_stride = 1024; }
                for (int it = blockIdx.x; it < 256; it += G) { if (it < 128) { for (int rq = 0; rq < SGU_REP; ++rq) sgu_item(a, l, it, lds, tid, wave, lane); } else { for (int rq = 0; rq < S5_REP; ++rq) s5_wg_item(a, l, it - 128, lds, wave, lane); } }
                for (int rq = 0; rq < PC_REP; ++rq) for (int idx = w_first; idx < 2048; idx += w_stride) poolconv_item(a, l, idx, lane);
            } else if ((PHM & 256) && s == 5) {
                for (int it = blockIdx.x; it < M / 64; it += G) glu_item(a, l, it, lds, tid, wave, lane);
            }
        }
        if (ph + 1 < ph_hi) { XcdBarrier b2 = bar; asm volatile("" : "+s"(b2.bar)); xcd_barrier(b2); }
        if (TPROBE) { int ty; if (ph == 0) ty = 0; else if (ph == 1) ty = 1; else { const int s_ = (int)((SLOT_MAP >> (4 * ((ph - 2) % NSLOT))) & 15ull); ty = (s_ == 0 || s_ == 7) ? 2 : ((s_ == 1 || s_ == 6 || s_ == 8) ? 3 : (s_ == 2 ? 4 : (s_ == 3 ? 5 : 6))); }
            if ((TPROBE >> ty) & 1) tacc += __builtin_amdgcn_s_memrealtime() - tph0; }
    }
    if (TPROBE) { const unsigned long long te = __builtin_amdgcn_s_memrealtime(); while (__builtin_amdgcn_s_memrealtime() - te < tacc) __builtin_amdgcn_s_sleep(8); }
}

extern "C" void kernel_launch(void* const* d_in, const int* in_sizes, int n_in, void* d_out, int out_size, void* d_ws, size_t ws_size, hipStream_t stream) {
    static int grid = 0;
    if (grid == 0) {
        int dev = 0, cus = 0;
        if (n_in != 30 || ws_size < WS_END || hipGetDevice(&dev) != hipSuccess || hipDeviceGetAttribute(&cus, hipDeviceAttributeMultiprocessorCount, dev) != hipSuccess) { grid = -1; return; }
        if (hipFuncSetAttribute((const void*)mega, hipFuncAttributeMaxDynamicSharedMemorySize, LDS_BYTES) != hipSuccess) { grid = -1; return; }
        int per_cu = 0;
        if (hipOccupancyMaxActiveBlocksPerMultiprocessor(&per_cu, (const void*)mega, 512, LDS_BYTES) != hipSuccess || per_cu < 1) per_cu = 1;
        (void)hipGetLastError();
        grid = cus;
    }
    if (grid < 0) return;
    Args a{};
    for (int i = 0; i < 30; ++i) a.in[i] = (const float*)d_in[i];
    a.out = (float*)d_out; a.ws = (unsigned char*)d_ws;
#if PER_PHASE_LAUNCH
    for (int ph = 0; ph < NPH; ++ph) { a.ph_lo = ph; a.ph_hi = ph + 1; hipLaunchKernelGGL(mega, dim3(grid), dim3(512), LDS_BYTES, stream, a); }
#else
    (void)hipMemsetAsync((char*)d_ws + WS_BAR, 0, BAR_BYTES, stream);
    a.ph_lo = 0; a.ph_hi = NPH;
    void* args[] = {&a};
    (void)hipLaunchCooperativeKernel((const void*)mega, dim3(grid), dim3(512), args, LDS_BYTES, stream);
#endif
}
```

```cpp
#include <hip/hip_runtime.h>
#include <hip/hip_cooperative_groups.h>
namespace cg = cooperative_groups;
namespace pg8 {
#define PG8_LAS __attribute__((address_space(3)))
typedef unsigned short bf16_t;
typedef short bf16x8 __attribute__((ext_vector_type(8)));
typedef float f32x4 __attribute__((ext_vector_type(4)));
typedef unsigned u32x4 __attribute__((ext_vector_type(4)));
constexpr int BM = 256, BK = 64, HALF = 128, HTB = HALF * BK * 2  , STAGE_BYTES = 8 * HTB, NXCD = 8, WGM = 8;

__host__ __device__ __forceinline__ int lds_byte(int r, int c) { const int st = (r >> 4) * 2 + (c >> 5), rr = r & 15, cc = c & 31, ob = rr * 64 + cc * 2; return st * 1024 + (ob ^ (((ob >> 9) & 1) << 5)); }
__host__ __device__ __forceinline__ void stage_rc(int b, int& R, int& C) { const int st = b / 1024, sb = b % 1024, swz = sb ^ (((sb >> 9) & 1) << 5); R = (st >> 1) * 16 + swz / 64; C = (st & 1) * 32 + (swz % 64) / 2; }
__host__ __device__ __forceinline__ int perm32(int rho) { const int n = rho >> 4, i = rho & 15; return 8 * (i >> 2) + 4 * n + (i & 3); }

struct Unit { int pm, pn; };
struct Gemm { const bf16_t* A; const bf16_t* Bt; int M, N, K; };

struct StaticOrder {
    int nM, nN, nwg, G, c;
    __host__ __device__ void init(int M, int N, int G_, int c_) { nM = M / BM; nN = N / BM; nwg = nM * nN; G = G_; c = c_; }
    __host__ __device__ bool next(int i, Unit& u) const {
        const long L = (long)i * G + c; if (L >= nwg) return false;
        int wgid = (int)L; { const int q = nwg / NXCD, r = nwg % NXCD, xcd = wgid % NXCD, off = wgid / NXCD; wgid = (xcd < r ? xcd * (q + 1) : r * (q + 1) + (xcd - r) * q) + off; }
        const int nig = WGM * nN, gid = wgid / nig, fm = gid * WGM, gsz = (nM - fm) < WGM ? (nM - fm) : WGM;
        u.pm = fm + ((wgid % nig) % gsz); u.pn = (wgid % nig) / gsz; return true;
    }
    __device__ __forceinline__ void a_ready(const Unit&) const {}
    __device__ __forceinline__ void done(const Unit&) const {}
};
__device__ __forceinline__ unsigned cvt_pk_bf16(float lo, float hi) { unsigned r; asm volatile("v_cvt_pk_bf16_f32 %0, %1, %2" : "=v"(r) : "v"(lo), "v"(hi)); return r; }
typedef float f32x2 __attribute__((ext_vector_type(2)));
typedef unsigned u32x2 __attribute__((ext_vector_type(2)));
__device__ __forceinline__ float silu_f(float a) { return a * __builtin_amdgcn_rcpf(1.0f + __expf(-a)); }
__device__ __forceinline__ float sigmoid_f(float a) { return __builtin_amdgcn_rcpf(1.0f + __expf(-a)); }
__device__ __forceinline__ float gelu_tanh(float y) { const float z = 1.5957691216f * (y + 0.044715f * y * y * y); return y * __builtin_amdgcn_rcpf(1.0f + __expf(-z)); }
__device__ __forceinline__ float bf_lo(unsigned w) { return __uint_as_float(w << 16); }
__device__ __forceinline__ float bf_hi(unsigned w) { return __uint_as_float(w & 0xffff0000u); }

struct EpiZ {
    static constexpr bool PERM = true, AFTER_DRAIN = false;
    bf16_t* O; int ldc;
    __device__ __forceinline__ void operator()(const f32x4 (&acc)[2][2][4][2], const Unit& u, int wr, int wc, int fr, int fq) const {
        const int row0 = u.pm * BM + wr * 64 + fr, col0 = u.pn * BM + wc * 32 + 8 * fq;
#pragma unroll
        for (int ai = 0; ai < 2; ++ai)
#pragma unroll
            for (int m = 0; m < 4; ++m) { bf16_t* rowp = O + (size_t)(row0 + ai * HALF + m * 16) * ldc + col0;
#pragma unroll
                for (int bj = 0; bj < 2; ++bj) { const f32x4 v0 = acc[ai][bj][m][0], v1 = acc[ai][bj][m][1];
                    u32x4 w; w.x = cvt_pk_bf16(v0[0], v0[1]); w.y = cvt_pk_bf16(v0[2], v0[3]); w.z = cvt_pk_bf16(v1[0], v1[1]); w.w = cvt_pk_bf16(v1[2], v1[3]);
                    *(u32x4*)(rowp + bj * HALF) = w; } }
    }
};
struct EpiSwiglu {
    static constexpr bool PERM = true, AFTER_DRAIN = false;
    bf16_t* O; int ldc;
    __device__ __forceinline__ void operator()(const f32x4 (&acc)[2][2][4][2], const Unit& u, int wr, int wc, int fr, int fq) const {
        const int row0 = u.pm * BM + wr * 64 + fr, col0 = u.pn * HALF + wc * 32 + 8 * fq;
#pragma unroll
        for (int ai = 0; ai < 2; ++ai)
#pragma unroll
            for (int m = 0; m < 4; ++m) { bf16_t* rowp = O + (size_t)(row0 + ai * HALF + m * 16) * ldc + col0;
                const f32x4 a0 = acc[ai][0][m][0], a1 = acc[ai][0][m][1], b0 = acc[ai][1][m][0], b1 = acc[ai][1][m][1];
                const f32x4 t0 = a0 * -1.4426950408889634f, t1 = a1 * -1.4426950408889634f;
                f32x4 e0, e1;
#pragma unroll
                for (int j = 0; j < 4; ++j) { e0[j] = __builtin_amdgcn_exp2f(t0[j]); e1[j] = __builtin_amdgcn_exp2f(t1[j]); }
                const f32x4 d0 = e0 + 1.0f, d1 = e1 + 1.0f; f32x4 r0, r1;
#pragma unroll
                for (int j = 0; j < 4; ++j) { r0[j] = __builtin_amdgcn_rcpf(d0[j]); r1[j] = __builtin_amdgcn_rcpf(d1[j]); }
                const f32x4 v0 = (a0 * b0) * r0, v1 = (a1 * b1) * r1;
                u32x4 w; w.x = cvt_pk_bf16(v0[0], v0[1]); w.y = cvt_pk_bf16(v0[2], v0[3]); w.z = cvt_pk_bf16(v1[0], v1[1]); w.w = cvt_pk_bf16(v1[2], v1[3]);
                __builtin_nontemporal_store(w, (u32x4*)rowp); }
    }
};
struct EpiResid {
    static constexpr bool PERM = true, AFTER_DRAIN = true;
    const bf16_t* xin; bf16_t* xout; float* fout; const float* gate; const float* gnext; const float* scnext; const float* shnext; bf16_t* xa; unsigned* xbuf; unsigned* cnt; float gs; unsigned need;
    __device__ __forceinline__ void fused(f32x4 (&acc)[2][2][4][2], const Unit& u, int wr, int wc, int fr, int fq, PG8_LAS unsigned char* lds, int wid, int lane) const {
        PG8_LAS float* P = (PG8_LAS float*)lds;
        PG8_LAS float* S = (PG8_LAS float*)(lds + 4096);
        const int row0 = u.pm * BM + wr * 64 + fr, col0 = u.pn * BM + wc * 32 + 8 * fq;
        const size_t cb = (size_t)(u.pm >> 3) * 9216 + col0;
        float sq[8];
#pragma unroll
        for (int i = 0; i < 8; ++i) sq[i] = 0.f;
#pragma unroll
        for (int bj = 0; bj < 2; ++bj) { const int co = bj * HALF;
            const f32x4 gv0 = *(const f32x4*)(gate + cb + co) * gs, gv1 = *(const f32x4*)(gate + cb + co + 4) * gs;
#pragma unroll
            for (int ai = 0; ai < 2; ++ai)
#pragma unroll
                for (int m = 0; m < 4; ++m) { const size_t off = (size_t)(row0 + ai * HALF + m * 16) * 1024 + col0 + co;
                    const u32x4 xw = *(const u32x4*)(xin + off);
                    const f32x4 xi0 = (f32x4){bf_lo(xw.x), bf_hi(xw.x), bf_lo(xw.y), bf_hi(xw.y)}, xi1 = (f32x4){bf_lo(xw.z), bf_hi(xw.z), bf_lo(xw.w), bf_hi(xw.w)};
                    const f32x4 xn0 = xi0 + gv0 * acc[ai][bj][m][0], xn1 = xi1 + gv1 * acc[ai][bj][m][1];
                    if (xa) { u32x4 ow; ow.x = cvt_pk_bf16(xn0[0], xn0[1]); ow.y = cvt_pk_bf16(xn0[2], xn0[3]); ow.z = cvt_pk_bf16(xn1[0], xn1[1]); ow.w = cvt_pk_bf16(xn1[2], xn1[3]);
                        *(u32x4*)(xout + off) = ow; }
                    acc[ai][bj][m][0] = xn0; acc[ai][bj][m][1] = xn1;
                    sq[ai * 4 + m] += ((xn0[0] * xn0[0] + xn0[1] * xn0[1]) + (xn0[2] * xn0[2] + xn0[3] * xn0[3])) + ((xn1[0] * xn1[0] + xn1[1] * xn1[1]) + (xn1[2] * xn1[2] + xn1[3] * xn1[3])); }
            asm volatile("" ::: "memory"); }
#pragma unroll
        for (int i = 0; i < 8; ++i) { float q = sq[i]; q += __shfl_xor(q, 16); q += __shfl_xor(q, 32);
            if (fq == 0) P[((i >> 2) * HALF + wr * 64 + (i & 3) * 16 + fr) * 4 + wc] = q; }
        asm volatile("s_waitcnt lgkmcnt(0)" ::: "memory"); __builtin_amdgcn_s_barrier(); asm volatile("" ::: "memory");
        const int row = wid * 32 + (lane & 31);
        if (lane < 32) { const f32x4 p = *(const PG8_LAS f32x4*)(P + row * 4); const float s = (p[0] + p[1]) + (p[2] + p[3]);
            __hip_atomic_store(xbuf + ((size_t)(u.pm * BM + row) * 4 + u.pn), __float_as_uint(s), __ATOMIC_RELAXED, __HIP_MEMORY_SCOPE_AGENT); }
        asm volatile("s_waitcnt vmcnt(0)" ::: "memory");
        if (lane == 0) __hip_atomic_fetch_add(cnt + 64 * u.pm, 1u, __ATOMIC_RELAXED, __HIP_MEMORY_SCOPE_AGENT);
        if (wid == 0) {
            unsigned spins = 0;
            while ((unsigned)__builtin_amdgcn_readfirstlane(__hip_atomic_load(cnt + 64 * u.pm, __ATOMIC_RELAXED, __HIP_MEMORY_SCOPE_AGENT)) < need) { __builtin_amdgcn_s_sleep(2); if (++spins > (1u << 22)) break; }
            __builtin_amdgcn_fence(__ATOMIC_ACQUIRE, "agent");
        }
        asm volatile("s_waitcnt vmcnt(0) lgkmcnt(0)" ::: "memory"); __builtin_amdgcn_s_barrier(); asm volatile("" ::: "memory");
        if (lane < 32) { const unsigned* slot = xbuf + (size_t)(u.pm * BM + row) * 4; float t = 0.f;
#pragma unroll
            for (int k = 0; k < 4; ++k) t += __uint_as_float(__hip_atomic_load(slot + k, __ATOMIC_RELAXED, __HIP_MEMORY_SCOPE_AGENT));
            S[row] = __builtin_amdgcn_rsqf(t * (1.0f / 1024.0f) + 1e-6f); }
        asm volatile("s_waitcnt vmcnt(0) lgkmcnt(0)" ::: "memory"); __builtin_amdgcn_s_barrier(); asm volatile("" ::: "memory");
        if (xa == nullptr) {
#pragma unroll
            for (int bj = 0; bj < 2; ++bj) { const int co = bj * HALF; const f32x4 g0 = *(const f32x4*)(gnext + col0 + co), g1 = *(const f32x4*)(gnext + col0 + co + 4);
#pragma unroll
                for (int ai = 0; ai < 2; ++ai)
#pragma unroll
                    for (int m = 0; m < 4; ++m) { const int r = ai * HALF + wr * 64 + m * 16 + fr; const float rs = S[r]; float* op = fout + (size_t)(u.pm * BM + r) * 1024 + col0 + co;
                        *(f32x4*)op = acc[ai][bj][m][0] * rs * g0; *(f32x4*)(op + 4) = acc[ai][bj][m][1] * rs * g1; } }
            asm volatile("s_waitcnt lgkmcnt(0)" ::: "memory"); __builtin_amdgcn_s_barrier(); asm volatile("" ::: "memory");
            return;
        }
#pragma unroll
        for (int bj = 0; bj < 2; ++bj) { const int co = bj * HALF;
            const f32x4 gm0 = *(const f32x4*)(gnext + col0 + co) * (*(const f32x4*)(scnext + cb + co) + 1.0f), gm1 = *(const f32x4*)(gnext + col0 + co + 4) * (*(const f32x4*)(scnext + cb + co + 4) + 1.0f);
            const f32x4 sh0 = *(const f32x4*)(shnext + cb + co), sh1 = *(const f32x4*)(shnext + cb + co + 4);
#pragma unroll
            for (int ai = 0; ai < 2; ++ai)
#pragma unroll
                for (int m = 0; m < 4; ++m) { const int r = ai * HALF + wr * 64 + m * 16 + fr; const float rs = S[r];
                    const f32x4 y0 = acc[ai][bj][m][0] * rs * gm0 + sh0, y1 = acc[ai][bj][m][1] * rs * gm1 + sh1;
                    u32x4 w; w.x = cvt_pk_bf16(y0[0], y0[1]); w.y = cvt_pk_bf16(y0[2], y0[3]); w.z = cvt_pk_bf16(y1[0], y1[1]); w.w = cvt_pk_bf16(y1[2], y1[3]);
                    *(u32x4*)(xa + (size_t)(u.pm * BM + r) * 1024 + col0 + co) = w; } }
        asm volatile("s_waitcnt lgkmcnt(0)" ::: "memory"); __builtin_amdgcn_s_barrier(); asm volatile("" ::: "memory");
    }
};
struct EpiGlu {
    static constexpr bool PERM = false, AFTER_DRAIN = true;
    const bf16_t* yg; const float* glu_b; const float* gn; bf16_t* ycat;
    __device__ __forceinline__ void fused(f32x4 (&acc)[2][2][4][2], const Unit& u, int wr, int wc, int fr, int fq, PG8_LAS unsigned char* lds, int wid, int lane) const {
        PG8_LAS float* P = (PG8_LAS float*)lds;
        const int col0 = wc * 32 + 4 * fq;
        f32x4 gb[2][2];
#pragma unroll
        for (int bj = 0; bj < 2; ++bj)
#pragma unroll
            for (int n = 0; n < 2; ++n) gb[bj][n] = *(const f32x4*)(glu_b + col0 + bj * HALF + n * 16);
#pragma unroll
        for (int ai = 0; ai < 2; ++ai)
#pragma unroll
            for (int m = 0; m < 4; ++m) { const int r = ai * HALF + wr * 64 + m * 16 + fr; const bf16_t* yp = yg + (size_t)(u.pm * BM + r) * 256 + col0; float s = 0.f;
#pragma unroll
                for (int bj = 0; bj < 2; ++bj)
#pragma unroll
                    for (int n = 0; n < 2; ++n) { const u32x2 yw = *(const u32x2*)(yp + bj * HALF + n * 16);
                        const f32x4 y = (f32x4){bf_lo(yw.x), bf_hi(yw.x), bf_lo(yw.y), bf_hi(yw.y)}; const f32x4 a = acc[ai][bj][m][n] + gb[bj][n]; f32x4 o;
#pragma unroll
                        for (int j = 0; j < 4; ++j) { o[j] = y[j] * sigmoid_f(a[j]); s += o[j] * o[j]; }
                        acc[ai][bj][m][n] = o; }
                s += __shfl_xor(s, 16); s += __shfl_xor(s, 32);
                if (fq == 0) P[r * 4 + wc] = s; }
        asm volatile("s_waitcnt lgkmcnt(0)" ::: "memory"); __builtin_amdgcn_s_barrier(); asm volatile("" ::: "memory");
        f32x4 gg[2][2];
#pragma unroll
        for (int bj = 0; bj < 2; ++bj)
#pragma unroll
            for (int n = 0; n < 2; ++n) gg[bj][n] = *(const f32x4*)(gn + col0 + bj * HALF + n * 16);
#pragma unroll
        for (int ai = 0; ai < 2; ++ai)
#pragma unroll
            for (int m = 0; m < 4; ++m) { const int r = ai * HALF + wr * 64 + m * 16 + fr; const f32x4 pp = *(const PG8_LAS f32x4*)(P + r * 4);
                const float rstd = 1.0f / sqrtf(((pp[0] + pp[1]) + (pp[2] + pp[3])) * (1.0f / 256.0f) + 1e-6f);
                bf16_t* op = ycat + (size_t)(u.pm * BM + r) * 1024 + 768 + col0;
#pragma unroll
                for (int bj = 0; bj < 2; ++bj)
#pragma unroll
                    for (int n = 0; n < 2; ++n) { const f32x4 o = acc[ai][bj][m][n] * rstd * gg[bj][n]; u32x2 w; w.x = cvt_pk_bf16(o[0], o[1]); w.y = cvt_pk_bf16(o[2], o[3]);
                        *(u32x2*)(op + bj * HALF + n * 16) = w; } }
        asm volatile("s_waitcnt lgkmcnt(0)" ::: "memory"); __builtin_amdgcn_s_barrier(); asm volatile("" ::: "memory");
    }
};

template <class Epi, class Sched, bool STAMP = false>
__device__ __forceinline__ void gemm_phase(PG8_LAS unsigned char* lds, const Gemm g, const Sched& S, const Epi& E, unsigned long long* stamps, const int tid) {
    const int wid = __builtin_amdgcn_readfirstlane(tid >> 6), lane = tid & 63, wr = wid >> 2, wc = wid & 3, fr = lane & 15, fq = lane >> 4;
    const int K = g.K, nt = K / BK;
    int ts_lo = 0, ts_hi = 0, nts = 0; const unsigned long long rt_entry = STAMP ? (unsigned long long)wall_clock64() : 0ull;
#define PG8_STAMP() do { if (STAMP && wid == 0 && nts < 64) { const unsigned long long _c = (unsigned long long)clock64(); \
        ts_lo = (lane == nts) ? (int)(unsigned)_c : ts_lo; ts_hi = (lane == nts) ? (int)(unsigned)(_c >> 32) : ts_hi; ++nts; } } while (0)
    PG8_STAMP();
    unsigned voffA[2], voffB[2];
#pragma unroll
    for (int i = 0; i < 2; ++i) { int R, C; stage_rc(tid * 16 + i * 8192, R, C); const int Rb = Epi::PERM ? ((R & ~31) + perm32(R & 31)) : R;
        voffA[i] = (unsigned)(R * K + C) * 2u; voffB[i] = (unsigned)(Rb * K + C) * 2u; }
    const size_t kstep = (size_t)(BK * 2);
    const size_t hstep = (size_t)HALF * K * 2;
    const size_t tstep = 2 * hstep;
    const unsigned ldsw = (unsigned)wid * 1024u;
    const int aoff = lds_byte(wr * 64 + fr, fq * 8), boff = lds_byte(wc * 32 + fr, fq * 8);
#define PG8_SA(b, h) (((b) * 2 + (h)) * HTB)
#define PG8_SB(b, h) ((4 + (b) * 2 + (h)) * HTB)
#define PG8_STAGE(bufoff, gbase, voff) do { _Pragma("unroll") for (int _i = 0; _i < 2; ++_i) \
        __builtin_amdgcn_global_load_lds((const unsigned*)((const char*)(gbase) + (voff)[_i]), (PG8_LAS unsigned*)(lds + (bufoff) + ldsw + _i * 8192), 16, 0, 0); } while (0)
#define PG8_LDA(dst, b, h) do { _Pragma("unroll") for (int m = 0; m < 4; ++m) _Pragma("unroll") for (int k = 0; k < 2; ++k) dst[m][k] = *(const PG8_LAS bf16x8*)(lds + PG8_SA(b, h) + aoff + m * 2048 + k * 1024); } while (0)
#define PG8_LDB(dst, b, h) do { _Pragma("unroll") for (int n = 0; n < 2; ++n) _Pragma("unroll") for (int k = 0; k < 2; ++k) dst[n][k] = *(const PG8_LAS bf16x8*)(lds + PG8_SB(b, h) + boff + n * 2048 + k * 1024); } while (0)
#define PG8_MMA(ai, bj, At, Bt) do { __builtin_amdgcn_s_setprio(1); _Pragma("unroll") for (int m = 0; m < 4; ++m) _Pragma("unroll") for (int n = 0; n < 2; ++n) _Pragma("unroll") for (int k = 0; k < 2; ++k) \
        acc[ai][bj][m][n] = __builtin_amdgcn_mfma_f32_16x16x32_bf16(Bt[n][k], At[m][k], acc[ai][bj][m][n], 0, 0, 0); __builtin_amdgcn_s_setprio(0); } while (0)
#define PG8_WAIT_V(n) asm volatile("s_waitcnt vmcnt(" #n ")" ::: "memory")
#define PG8_WAIT_L(n) asm volatile("s_waitcnt lgkmcnt(" #n ")" ::: "memory")
#define PG8_BAR __builtin_amdgcn_s_barrier()
#define PG8_SCHED __builtin_amdgcn_sched_barrier(0)
    Unit cur, nxt; int ui = 0;
    if (!S.next(0, cur)) return;
    f32x4 acc[2][2][4][2];
#pragma unroll
    for (int a = 0; a < 2; ++a)
#pragma unroll
        for (int b = 0; b < 2; ++b)
#pragma unroll
            for (int m = 0; m < 4; ++m)
#pragma unroll
                for (int n = 0; n < 2; ++n) acc[a][b][m][n] = (f32x4){0.f, 0.f, 0.f, 0.f};
    bf16x8 At[4][2], B0[2][2], B1[2][2];
    const char* cA = (const char*)g.A + (size_t)cur.pm * tstep; const char* cB = (const char*)g.Bt + (size_t)cur.pn * tstep;
    S.a_ready(cur);
    PG8_STAGE(PG8_SB(0, 0), cB, voffB); PG8_STAGE(PG8_SA(0, 0), cA, voffA); PG8_STAGE(PG8_SB(0, 1), cB + hstep, voffB); PG8_STAGE(PG8_SA(0, 1), cA + hstep, voffA);
    if (wr == 1) PG8_BAR;
    PG8_WAIT_V(4); PG8_BAR;
    PG8_STAGE(PG8_SB(1, 0), cB + kstep, voffB); PG8_STAGE(PG8_SA(1, 0), cA + kstep, voffA); PG8_STAGE(PG8_SB(1, 1), cB + hstep + kstep, voffB);
    PG8_WAIT_V(6); PG8_BAR;
    PG8_STAMP();
    for (;;) {
        const bool has_next = S.next(ui + 1, nxt);
        const char* nA = has_next ? (const char*)g.A + (size_t)nxt.pm * tstep : cA; const char* nB = has_next ? (const char*)g.Bt + (size_t)nxt.pn * tstep : cB;
        for (int t = 0; t < nt; t += 2) {
            const bool last = (t == nt - 2);
            const char* a1 = cA + (size_t)(t + 1) * kstep;
            const char* a2 = last ? nA : cA + (size_t)(t + 2) * kstep; const char* b2 = last ? nB : cB + (size_t)(t + 2) * kstep;
            const char* a3 = a2 + kstep; const char* b3 = b2 + kstep;
            if (last && has_next) S.a_ready(nxt);
            PG8_LDB(B0, 0, 0); PG8_SCHED; PG8_LDA(At, 0, 0); PG8_STAGE(PG8_SA(1, 1), a1 + hstep, voffA);
            PG8_WAIT_L(8); PG8_BAR; PG8_WAIT_L(0); PG8_MMA(0, 0, At, B0); PG8_BAR; PG8_SCHED;
            PG8_LDB(B1, 0, 1); PG8_STAGE(PG8_SB(0, 0), b2, voffB);
            PG8_BAR; PG8_WAIT_L(0); PG8_MMA(0, 1, At, B1); PG8_BAR;
            PG8_LDA(At, 0, 1); PG8_STAGE(PG8_SA(0, 0), a2, voffA);
            PG8_BAR; PG8_WAIT_L(0); PG8_MMA(1, 0, At, B0); PG8_BAR; PG8_SCHED;
            PG8_STAGE(PG8_SB(0, 1), b2 + hstep, voffB);
            PG8_WAIT_V(6); PG8_BAR; PG8_MMA(1, 1, At, B1); PG8_BAR;
            PG8_LDB(B0, 1, 0); PG8_SCHED; PG8_LDA(At, 1, 0); PG8_STAGE(PG8_SA(0, 1), a2 + hstep, voffA);
            PG8_WAIT_L(8); PG8_BAR; PG8_WAIT_L(0); PG8_MMA(0, 0, At, B0); PG8_BAR; PG8_SCHED;
            PG8_LDB(B1, 1, 1); PG8_STAGE(PG8_SB(1, 0), b3, voffB);
            PG8_BAR; PG8_WAIT_L(0); PG8_MMA(0, 1, At, B1); PG8_BAR;
            PG8_LDA(At, 1, 1); PG8_STAGE(PG8_SA(1, 0), a3, voffA);
            PG8_BAR; PG8_WAIT_L(0); PG8_MMA(1, 0, At, B0); PG8_BAR; PG8_SCHED;
            PG8_STAGE(PG8_SB(1, 1), b3 + hstep, voffB);
            PG8_WAIT_V(6); PG8_BAR; PG8_MMA(1, 1, At, B1); PG8_BAR;
        }
        PG8_STAMP();
        if constexpr (!Epi::AFTER_DRAIN) { E(acc, cur, wr, wc, fr, fq); S.done(cur); }
        PG8_STAMP();
        if (!has_next) break;
#pragma unroll
        for (int a = 0; a < 2; ++a)
#pragma unroll
            for (int b = 0; b < 2; ++b)
#pragma unroll
                for (int m = 0; m < 4; ++m)
#pragma unroll
                    for (int n = 0; n < 2; ++n) acc[a][b][m][n] = (f32x4){0.f, 0.f, 0.f, 0.f};
        cur = nxt; cA = nA; cB = nB; ++ui;
    }
    PG8_WAIT_V(0);
    if (wr == 0) PG8_BAR;
    PG8_BAR;
    if constexpr (Epi::AFTER_DRAIN) { E.fused(acc, cur, wr, wc, fr, fq, lds, wid, lane); S.done(cur); }
    PG8_STAMP();
    if (STAMP && wid == 0) { stamps[lane] = lane < nts ? (((unsigned long long)(unsigned)ts_hi << 32) | (unsigned)ts_lo) : 0ull;
        if (lane == 62) stamps[62] = rt_entry; if (lane == 63) stamps[63] = (unsigned long long)wall_clock64(); }
#undef PG8_STAMP
#undef PG8_SA
#undef PG8_SB
#undef PG8_STAGE
#undef PG8_LDA
#undef PG8_LDB
#undef PG8_MMA
#undef PG8_WAIT_V
#undef PG8_WAIT_L
#undef PG8_BAR
#undef PG8_SCHED
}
}

#define LAS __attribute__((address_space(3)))
typedef unsigned short bf16;
using pg8::f32x4; using pg8::bf16x8; using pg8::u32x4; using pg8::u32x2; using pg8::cvt_pk_bf16; using pg8::bf_lo; using pg8::bf_hi; using pg8::gelu_tanh;

constexpr int M = 16384, D = 1024, DFF = 2816, PIN = 1792, NL = 4, NCOND = 9216;
constexpr float EPS = 1e-6f;
constexpr size_t MiB = (size_t)1 << 20;
constexpr size_t WS_BAR = 7 * MiB, BAR_BYTES = 32768;
constexpr size_t WS_COND = 0, WS_E = 2 * MiB, WS_W = 8 * MiB, LW = 39 * MiB;
constexpr size_t OW_IN1 = 0, OW_OUT1 = 11 * MiB, OW_MIX = OW_OUT1 + 11 * MiB / 2, OW_MO = OW_MIX + 7 * MiB / 2, OW_IN2 = OW_MO + 2 * MiB, OW_OUT2 = OW_IN2 + 11 * MiB, OW_GLU = OW_OUT2 + 11 * MiB / 2;
static_assert(OW_GLU + 131072 <= LW, "weights per layer");
constexpr size_t WS_H = 164 * MiB, WS_ACT = 196 * MiB, WS_Z = 284 * MiB, WS_YG = 340 * MiB, WS_YCAT = 348 * MiB, WS_SHW = 380 * MiB, WS_SS = 383 * MiB, WS_XB = 384 * MiB, WS_END = 416 * MiB;
constexpr int LDS_BYTES = 147456;
#ifndef SGU_REP
#define SGU_REP 1
#endif
#ifndef S5_REP
#define S5_REP 1
#endif
#ifndef PC_REP
#define PC_REP 1
#endif
#ifndef PREP_REP
#define PREP_REP 1
#endif
#ifndef PREP_TILE_REP
#define PREP_TILE_REP 1
#endif
#ifndef TPROBE
#define TPROBE 0
#endif
#ifndef SLOT_MAP
#define SLOT_MAP 0x87653210ull
#define SLOT_REP 0u
#define NSLOT 8
#endif
constexpr int NPH = 2 + NL * NSLOT;
constexpr int TILES_PER_LAYER = 176 + 88 + 48 + 32 + 176 + 88 + 2;

struct Args { const float* in[30]; float* out; unsigned char* ws; int ph_lo, ph_hi; };
typedef const Args __attribute__((address_space(4)))& ArgsRef;

__device__ __forceinline__ float wave_sum(float v) {
#pragma unroll
    for (int o = 1; o < 64; o <<= 1) v += __shfl_xor(v, o);
    return v;
}
#define LDS_WAIT() asm volatile("s_waitcnt lgkmcnt(0)" ::: "memory")

struct TileDesc { const float* W; bf16* WT; int K, N, k0, n0, swiglu; };
__device__ __forceinline__ TileDesc tile_decode(ArgsRef a, int item) {
    const int l = item / TILES_PER_LAYER; int r = item % TILES_PER_LAYER;
    unsigned char* wl = a.ws + WS_W + (size_t)l * LW; TileDesc t;
    if (r < 176) t = TileDesc{a.in[5] + (size_t)l * 1024 * 5632, (bf16*)(wl + OW_IN1), 1024, 5632, 128 * (r / 22), 256 * (r % 22), 1};
    else if ((r -= 176) < 88) t = TileDesc{a.in[6] + (size_t)l * DFF * 1024, (bf16*)(wl + OW_OUT1), DFF, 1024, 128 * (r / 4), 256 * (r % 4), 0};
    else if ((r -= 88) < 48) { const int nb = r % 6; t = TileDesc{a.in[8] + (size_t)l * 1024 * PIN, (bf16*)(wl + OW_MIX), 1024, PIN, 128 * (r / 6), 256 * (nb < 2 ? nb : nb + 1), 0}; }
    else if ((r -= 48) < 32) t = TileDesc{a.in[25] + (size_t)l * 1024 * 1024, (bf16*)(wl + OW_MO), 1024, 1024, 128 * (r / 4), 256 * (r % 4), 0};
    else if ((r -= 32) < 176) t = TileDesc{a.in[27] + (size_t)l * 1024 * 5632, (bf16*)(wl + OW_IN2), 1024, 5632, 128 * (r / 22), 256 * (r % 22), 1};
    else if ((r -= 176) < 88) t = TileDesc{a.in[28] + (size_t)l * DFF * 1024, (bf16*)(wl + OW_OUT2), DFF, 1024, 128 * (r / 4), 256 * (r % 4), 0};
    else { r -= 88; t = TileDesc{a.in[22] + (size_t)l * 65536, (bf16*)(wl + OW_GLU), 256, 256, 128 * r, 0, 0}; }
    return t;
}
__device__ __forceinline__ void tile_load(const TileDesc& t, float (&v)[16][4], int wave, int lane) {
    const float* wp = t.W + (size_t)(t.k0 + 16 * wave) * t.N + t.n0 + lane;
#pragma unroll
    for (int r = 0; r < 16; ++r)
#pragma unroll
        for (int e = 0; e < 4; ++e) v[r][e] = __builtin_nontemporal_load(wp + (size_t)r * t.N + 64 * e);
}
__device__ __forceinline__ void tile_to_lds(const float (&v)[16][4], LAS unsigned char* lds, int wave, int lane) {
#pragma unroll
    for (int e = 0; e < 4; ++e)
#pragma unroll
        for (int hq = 0; hq < 2; ++hq) { u32x4 o; o.x = cvt_pk_bf16(v[8 * hq][e], v[8 * hq + 1][e]); o.y = cvt_pk_bf16(v[8 * hq + 2][e], v[8 * hq + 3][e]); o.z = cvt_pk_bf16(v[8 * hq + 4][e], v[8 * hq + 5][e]); o.w = cvt_pk_bf16(v[8 * hq + 6][e], v[8 * hq + 7][e]);
            *(LAS u32x4*)(lds + (lane + 64 * e) * 272 + (16 * wave + 8 * hq) * 2) = o; }
}
__device__ __forceinline__ void tile_store(const TileDesc& t, LAS unsigned char* lds, int wave, int lane) {
#pragma unroll
    for (int j = 0; j < 8; ++j) { const int nl = 32 * wave + 4 * j + (lane >> 4), n = t.n0 + nl;
        const u32x4 o = *(const LAS u32x4*)(lds + nl * 272 + 16 * (lane & 15));
        const int dsw = n < DFF ? (n >> 7) * 256 + (n & 127) : ((n - DFF) >> 7) * 256 + 128 + ((n - DFF) & 127);
        const int dst = t.swiglu ? dsw : n;
        *(u32x4*)(t.WT + (size_t)dst * t.K + t.k0 + 8 * (lane & 15)) = o; }
}

__device__ __forceinline__ void prep_phase(ArgsRef a, LAS unsigned char* lds, int tid, int wave, int lane, int G) {
    LAS float* sc = (LAS float*)lds;
    LAS float* R = (LAS float*)(lds + 32768);
    float* cond = (float*)(a.ws + WS_COND);
    const bool cond_blk = (G >= 256) ? (blockIdx.x < 144) : true;
    if (cond_blk) {
        const float* c_in = a.in[1];
        for (int i = tid; i < 8 * 1024; i += 512) { const float v = c_in[i]; sc[i] = v / (1.0f + expf(-v)); }
        __syncthreads();
        for (int it = blockIdx.x; it < NL * 36; it += (G >= 256 ? 144 : G)) {
            const int l = it / 36, n0 = 256 * (it % 36);
            const float* wp = a.in[2] + ((size_t)l * 1024 + 128 * wave) * NCOND + n0 + 4 * lane;
            f32x4 acc[8];
#pragma unroll
            for (int b = 0; b < 8; ++b) acc[b] = (f32x4){0.f, 0.f, 0.f, 0.f};
            f32x4 wv[8], wn[8];
#pragma unroll
            for (int kk = 0; kk < 8; ++kk) wv[kk] = __builtin_nontemporal_load((const f32x4*)(wp + (size_t)kk * NCOND));
            for (int k0 = 0; k0 < 128; k0 += 8) {
                if (k0 + 8 < 128) {
#pragma unroll
                    for (int kk = 0; kk < 8; ++kk) wn[kk] = __builtin_nontemporal_load((const f32x4*)(wp + (size_t)(k0 + 8 + kk) * NCOND));
                }
#pragma unroll
                for (int q = 0; q < 2; ++q)
#pragma unroll
                    for (int b = 0; b < 8; ++b) { const f32x4 s4 = *(const LAS f32x4*)(sc + b * 1024 + 128 * wave + k0 + 4 * q);
#pragma unroll
                        for (int e = 0; e < 4; ++e) acc[b] += wv[4 * q + e] * s4[e]; }
#pragma unroll
                for (int kk = 0; kk < 8; ++kk) wv[kk] = wn[kk];
            }
#pragma unroll
            for (int b = 0; b < 8; ++b) *(LAS f32x4*)(R + (wave * 8 + b) * 256 + 4 * lane) = acc[b];
            __syncthreads();
            { const int b = wave; f32x4 s = *(const f32x4*)(a.in[3] + (size_t)l * NCOND + n0 + 4 * lane);
#pragma unroll
              for (int w = 0; w < 8; ++w) s += *(const LAS f32x4*)(R + (w * 8 + b) * 256 + 4 * lane);
              *(f32x4*)(cond + ((size_t)l * 8 + b) * NCOND + n0 + 4 * lane) = s; }
            __syncthreads();
        }
    }
    int first, stride, count;
    if (G >= 256) { if (blockIdx.x < 144) { first = blockIdx.x * 7; stride = 1; count = 7; } else { count = (NL * TILES_PER_LAYER - 1008 + (G - 144) - 1) / (G - 144); first = 1008 + (blockIdx.x - 144) * count; stride = 1; } }
    else { first = blockIdx.x; stride = G; count = (NL * TILES_PER_LAYER + G - 1) / G; }
    for (int rp = 0; rp < PREP_TILE_REP; ++rp)
    {
        int lim = NL * TILES_PER_LAYER; if (G >= 256 && blockIdx.x < 144) lim = 1008;
        int nt = 0; for (int j = 0; j < count; ++j) if (first + j * stride < lim) nt = j + 1;
        float v[16][4];
        TileDesc cur = tile_decode(a, nt > 0 ? first : 0);
        if (nt > 0) tile_load(cur, v, wave, lane);
        for (int j = 0; j < nt; ++j) {
            tile_to_lds(v, lds, wave, lane);
            TileDesc nxt = cur;
            if (j + 1 < nt) { nxt = tile_decode(a, first + (j + 1) * stride); tile_load(nxt, v, wave, lane); }
            __syncthreads();
            tile_store(cur, lds, wave, lane);
            __syncthreads();
            cur = nxt;
        }
    }
    const int gw = blockIdx.x * 8 + wave, NGW = G * 8;
    LAS float* F = (LAS float*)(lds + wave * 2048);
    for (int item = gw; item < NL * 512; item += NGW) {
        const int l = item >> 9, r = item & 511, kb = r >> 5, n8 = r & 31, g = n8 >> 3, d0 = 8 * (n8 & 7), k = 64 * kb + lane;
        unsigned char* wl = a.ws + WS_W + (size_t)l * LW;
        const float* pw = a.in[11] + (size_t)(l * 4 + g) * 4096 + (size_t)lane * 64 + d0;
        const f32x4 p0 = *(const f32x4*)pw, p1 = *(const f32x4*)(pw + 4);
        const float* wr = a.in[8] + ((size_t)l * 1024 + k) * PIN + 512 + 64 * g;
        f32x4 wrow[16];
#pragma unroll
        for (int j = 0; j < 16; ++j) wrow[j] = *(const f32x4*)(wr + 4 * j);
        const float* ps = a.in[12] + (size_t)l * 256 + 64 * g + d0;
        const f32x4 s0 = *(const f32x4*)ps, s1 = *(const f32x4*)(ps + 4);
        *(LAS f32x4*)(F + lane * 8) = p0; *(LAS f32x4*)(F + lane * 8 + 4) = p1;
        LDS_WAIT();
        f32x4 a0 = (f32x4){0.f, 0.f, 0.f, 0.f}, a1 = a0;
#pragma unroll
        for (int j = 0; j < 16; ++j)
#pragma unroll
            for (int e = 0; e < 4; ++e) { const int c = 4 * j + e; const f32x4 f0 = *(const LAS f32x4*)(F + c * 8), f1 = *(const LAS f32x4*)(F + c * 8 + 4);
                a0 += f0 * wrow[j][e]; a1 += f1 * wrow[j][e]; }
        a0 = a0 * s0; a1 = a1 * s1;
        bf16* WT = (bf16*)(wl + OW_MIX) + (size_t)(512 + 64 * g + d0) * 1024 + k;
#pragma unroll
        for (int i = 0; i < 4; ++i) { WT[(size_t)i * 1024] = (bf16)(cvt_pk_bf16(a0[i], 0.f) & 0xffffu); WT[(size_t)(4 + i) * 1024] = (bf16)(cvt_pk_bf16(a1[i], 0.f) & 0xffffu); }
        LDS_WAIT();
    }
}

__device__ __forceinline__ void norm_phase(const float* x, const float* g, const float* sh, const float* scl, bf16* h, bf16* xb, int gw, int NGW, int lane) {
    for (int row = gw; row < M; row += NGW) {
        const f32x4* xr = (const f32x4*)(x + (size_t)row * D) + lane;
        f32x4 v[4]; float s = 0.f;
#pragma unroll
        for (int j = 0; j < 4; ++j) { v[j] = xr[64 * j]; s += (v[j][0] * v[j][0] + v[j][1] * v[j][1]) + (v[j][2] * v[j][2] + v[j][3] * v[j][3]); }
        const float rstd = 1.0f / sqrtf(wave_sum(s) * (1.0f / D) + EPS);
        const size_t cb = (size_t)(row >> 11) * NCOND;
        u32x2* o = (u32x2*)(h + (size_t)row * D) + lane;
        u32x2* ob = (u32x2*)(xb + (size_t)row * D) + lane;
#pragma unroll
        for (int j = 0; j < 4; ++j) { u32x2 w; w.x = cvt_pk_bf16(v[j][0], v[j][1]); w.y = cvt_pk_bf16(v[j][2], v[j][3]); ob[64 * j] = w; }
#pragma unroll
        for (int j = 0; j < 4; ++j) { const int col = 4 * lane + 256 * j;
            const f32x4 gg = *(const f32x4*)(g + col), ss = *(const f32x4*)(scl + cb + col), hh = *(const f32x4*)(sh + cb + col);
            const f32x4 y = (v[j] * rstd * gg) * (ss + 1.0f) + hh;
            u32x2 w; w.x = cvt_pk_bf16(y[0], y[1]); w.y = cvt_pk_bf16(y[2], y[3]); o[64 * j] = w; }
    }
}
__device__ __forceinline__ void final_norm_phase(float* x, const float* g, int gw, int NGW, int lane) {
    for (int row = gw; row < M; row += NGW) {
        f32x4* xr = (f32x4*)(x + (size_t)row * D) + lane;
        f32x4 v[4]; float s = 0.f;
#pragma unroll
        for (int j = 0; j < 4; ++j) { v[j] = xr[64 * j]; s += (v[j][0] * v[j][0] + v[j][1] * v[j][1]) + (v[j][2] * v[j][2] + v[j][3] * v[j][3]); }
        const float rstd = 1.0f / sqrtf(wave_sum(s) * (1.0f / D) + EPS);
#pragma unroll
        for (int j = 0; j < 4; ++j) { const f32x4 gg = *(const f32x4*)(g + 4 * lane + 256 * j); xr[64 * j] = v[j] * rstd * gg; }
    }
}

__device__ __forceinline__ f32x4 ld4bf(const bf16* p) { const u32x2 w = *(const u32x2*)p; return (f32x4){bf_lo(w.x), bf_hi(w.x), bf_lo(w.y), bf_hi(w.y)}; }
__device__ __forceinline__ void st4bf(bf16* p, f32x4 v) { u32x2 w; w.x = cvt_pk_bf16(v[0], v[1]); w.y = cvt_pk_bf16(v[2], v[3]); *(u32x2*)p = w; }
__device__ __forceinline__ bf16x8 pack8(f32x4 lo, f32x4 hi) { u32x4 w; w.x = cvt_pk_bf16(lo[0], lo[1]); w.y = cvt_pk_bf16(lo[2], lo[3]); w.z = cvt_pk_bf16(hi[0], hi[1]); w.w = cvt_pk_bf16(hi[2], hi[3]); return __builtin_bit_cast(bf16x8, w); }

__device__ __forceinline__ void sgu_item(ArgsRef a, int l, int it, LAS unsigned char* lds, int tid, int wave, int lane) {
    const bf16* z = (const bf16*)(a.ws + WS_Z); bf16* ycat = (bf16*)(a.ws + WS_YCAT);
    LAS bf16* vT = (LAS bf16*)lds;
    const int tok0 = it * 128;
    { const int s = tid >> 2, q = tid & 3;
      u32x4 raw[4][2];
#pragma unroll
      for (int h = 0; h < 4; ++h) { const u32x4* zp = (const u32x4*)(z + (size_t)(tok0 + s) * PIN + 256 + 64 * h + 16 * q); raw[h][0] = zp[0]; raw[h][1] = zp[1]; }
#pragma unroll
      for (int h = 0; h < 4; ++h) {
          float v[16]; float sum = 0.f;
#pragma unroll
          for (int j = 0; j < 2; ++j) { const u32x4 rw = raw[h][j]; const unsigned ww[4] = {rw.x, rw.y, rw.z, rw.w};
#pragma unroll
              for (int e = 0; e < 4; ++e) { v[8 * j + 2 * e] = gelu_tanh(bf_lo(ww[e])); v[8 * j + 2 * e + 1] = gelu_tanh(bf_hi(ww[e])); sum += v[8 * j + 2 * e] + v[8 * j + 2 * e + 1]; } }
          sum += __shfl_xor(sum, 1); sum += __shfl_xor(sum, 2);
          const float mu = sum * (1.0f / 64.0f); float q2 = 0.f;
#pragma unroll
          for (int e = 0; e < 16; ++e) { v[e] -= mu; q2 += v[e] * v[e]; }
          q2 += __shfl_xor(q2, 1); q2 += __shfl_xor(q2, 2);
          const float rs = 1.0f / sqrtf(q2 * (1.0f / 64.0f) + EPS);
#pragma unroll
          for (int e = 0; e < 16; ++e) vT[(64 * h + 16 * q + e) * 136 + s] = (bf16)(cvt_pk_bf16(v[e] * rs, 0.f) & 0xffffu);
      } }
    __syncthreads();
    const int fr = lane & 15, fq = lane >> 4, t = 16 * wave + fr, nks = (wave >> 1) + 1;
    f32x4 acc[16];
#pragma unroll
    for (int i = 0; i < 16; ++i) acc[i] = (f32x4){0.f, 0.f, 0.f, 0.f};
    {
        const float* wbase = a.in[9] + ((size_t)(l * 4) * 128 + t) * 128 + 8 * fq;
        f32x4 wq[2][4][2];
#pragma unroll
        for (int ks = 0; ks < 4; ++ks) { wq[0][ks][0] = (f32x4){0.f, 0.f, 0.f, 0.f}; wq[0][ks][1] = wq[0][ks][0];
            if (ks < nks) { wq[0][ks][0] = *(const f32x4*)(wbase + 32 * ks); wq[0][ks][1] = *(const f32x4*)(wbase + 32 * ks + 4); } }
#pragma unroll
        for (int h = 0; h < 4; ++h) {
            if (h < 3) {
#pragma unroll
                for (int ks = 0; ks < 4; ++ks) { wq[(h + 1) & 1][ks][0] = (f32x4){0.f, 0.f, 0.f, 0.f}; wq[(h + 1) & 1][ks][1] = wq[(h + 1) & 1][ks][0];
                    if (ks < nks) { wq[(h + 1) & 1][ks][0] = *(const f32x4*)(wbase + (size_t)(h + 1) * 16384 + 32 * ks); wq[(h + 1) & 1][ks][1] = *(const f32x4*)(wbase + (size_t)(h + 1) * 16384 + 32 * ks + 4); } }
            }
#pragma unroll
            for (int ks = 0; ks < 4; ++ks) if (ks < nks) {
                f32x4 w0 = wq[h & 1][ks][0], w1 = wq[h & 1][ks][1];
                const int s0 = 32 * ks + 8 * fq;
#pragma unroll
                for (int e = 0; e < 4; ++e) { if (s0 + e > t) w0[e] = 0.f; if (s0 + 4 + e > t) w1[e] = 0.f; }
                const bf16x8 wf = pack8(w0, w1);
#pragma unroll
                for (int dt = 0; dt < 4; ++dt) { const bf16x8 vf = *(const LAS bf16x8*)(vT + (64 * h + 16 * dt + fr) * 136 + 32 * ks + 8 * fq);
                    acc[h * 4 + dt] = __builtin_amdgcn_mfma_f32_16x16x32_bf16(vf, wf, acc[h * 4 + dt], 0, 0, 0); }
            }
        }
    }
    const size_t tok = (size_t)tok0 + t; float ss = 0.f;
#pragma unroll
    for (int h = 0; h < 4; ++h) { const float bias = a.in[10][(size_t)(l * 4 + h) * 128 + t];
#pragma unroll
        for (int dt = 0; dt < 4; ++dt) { const f32x4 u4 = ld4bf(z + tok * PIN + 64 * h + 16 * dt + 4 * fq); f32x4 o;
#pragma unroll
            for (int e = 0; e < 4; ++e) { o[e] = gelu_tanh(u4[e]) * (acc[h * 4 + dt][e] + bias); ss += o[e] * o[e]; }
            acc[h * 4 + dt] = o; } }
    ss += __shfl_xor(ss, 16); ss += __shfl_xor(ss, 32);
    const float rstd = 1.0f / sqrtf(ss * (1.0f / 256.0f) + EPS);
    const float* gn = a.in[24] + (size_t)l * 1024;
#pragma unroll
    for (int h = 0; h < 4; ++h)
#pragma unroll
        for (int dt = 0; dt < 4; ++dt) { const int ch = 64 * h + 16 * dt + 4 * fq; const f32x4 gg = *(const f32x4*)(gn + ch);
            st4bf(ycat + tok * 1024 + ch, acc[h * 4 + dt] * rstd * gg); }
    __syncthreads();
}

__device__ __forceinline__ void sincos_red(float ang, float& sn, float& cs) {
    const float n = rintf(ang * 0.15915494309189535f);
    float r = fmaf(-n, 6.2831854820251465f, ang); r = fmaf(-n, -1.7484556e-7f, r);
    const float h = 0.5f * r, h2 = h * h;
    const float s = h * (1.0f + h2 * (-1.6666667e-1f + h2 * (8.3333333e-3f + h2 * (-1.9841270e-4f + h2 * (2.7557319e-6f + h2 * (-2.5052108e-8f))))));
    const float c = 1.0f + h2 * (-0.5f + h2 * (4.1666667e-2f + h2 * (-1.3888889e-3f + h2 * (2.4801587e-5f + h2 * (-2.7557319e-7f + h2 * 2.0876757e-9f)))));
    sn = 2.0f * s * c; cs = 1.0f - 2.0f * s * s;
}

template <int PASS>
__device__ __forceinline__ void s5_span(const bf16* zu, bf16* ygp, LAS float* BU, LAS bf16* Xs, const bf16x8 (&bfrag)[8], const bf16x8 (&cf)[4], f32x4 dd, float are, float aim, float& xr, float& xi, int lane) {
    const int p = lane, fr = lane & 15, fq = lane >> 4;
    bf16x8 uf_n = (bf16x8){0, 0, 0, 0, 0, 0, 0, 0}; u32x2 u4_n = (u32x2){0u, 0u};
    if (fq < 2) uf_n = *(const bf16x8*)(zu + 8 * fq);
    if (PASS == 2) u4_n = *(const u32x2*)(zu + 4 * fq);
    for (int blk = 0; blk < 16; ++blk) {
        const bf16x8 uf = uf_n; const u32x2 u4w = u4_n;
        if (blk < 15) { const bf16* zn = zu + (size_t)(16 * (blk + 1)) * PIN;
            if (fq < 2) uf_n = *(const bf16x8*)(zn + 8 * fq);
            if (PASS == 2) u4_n = *(const u32x2*)(zn + 4 * fq); }
#pragma unroll
        for (int n = 0; n < 8; ++n) { const f32x4 acc = __builtin_amdgcn_mfma_f32_16x16x32_bf16(bfrag[n], uf, (f32x4){0.f, 0.f, 0.f, 0.f}, 0, 0, 0);
            *(LAS f32x4*)(BU + fr * 132 + 16 * n + 4 * fq) = acc; }
        LDS_WAIT();
#pragma unroll
        for (int t = 0; t < 16; ++t) { const float bur = BU[t * 132 + p], bui = BU[t * 132 + 64 + p];
            const float tr = are * xr - aim * xi + bur, ti = are * xi + aim * xr + bui; xr = tr; xi = ti;
            if (PASS == 2) { const unsigned w = cvt_pk_bf16(xr, xi); Xs[t * 136 + p] = (bf16)(w & 0xffffu); Xs[t * 136 + 64 + p] = (bf16)(w >> 16); } }
        if (PASS == 2) {
            LDS_WAIT();
            f32x4 acc = (f32x4){0.f, 0.f, 0.f, 0.f};
#pragma unroll
            for (int ks = 0; ks < 4; ++ks) { const bf16x8 xf = *(const LAS bf16x8*)(Xs + fr * 136 + 32 * ks + 8 * fq);
                acc = __builtin_amdgcn_mfma_f32_16x16x32_bf16(cf[ks], xf, acc, 0, 0, 0); }
            const f32x4 u4 = (f32x4){bf_lo(u4w.x), bf_hi(u4w.x), bf_lo(u4w.y), bf_hi(u4w.y)}; f32x4 y;
#pragma unroll
            for (int e = 0; e < 4; ++e) y[e] = gelu_tanh(acc[e] + dd[e] * u4[e]);
            st4bf(ygp + (size_t)(16 * blk) * 256, y);
        }
        asm volatile("s_waitcnt lgkmcnt(0)" ::: );
    }
}
__device__ __forceinline__ void s5_wg_item(ArgsRef a, int l, int bi, LAS unsigned char* lds, int wave, int lane) {
    const int g = bi & 15, b = bi >> 4, p = lane, fr = lane & 15, fq = lane >> 4;
    const bf16* z = (const bf16*)(a.ws + WS_Z);
    const int lg = l * 16 + g;
    const float dt = expf(a.in[21][lg]);
    const float lre = a.in[14][(size_t)lg * 64 + p], lim = a.in[15][(size_t)lg * 64 + p];
    const float mag = expf(lre * dt); float sn, cs; sincos_red(lim * dt, sn, cs);
    const float are = mag * cs, aim = mag * sn, nr = are - 1.0f, ni = aim, den = lre * lre + lim * lim;
    const float kre = (nr * lre + ni * lim) / den, kim = (ni * lre - nr * lim) / den;
    bf16x8 bfrag[8];
#pragma unroll
    for (int nn = 0; nn < 4; ++nn) { const int pp = 16 * nn + fr; const float kr = __shfl(kre, pp), ki = __shfl(kim, pp);
        const float* brp = a.in[16] + ((size_t)lg * 64 + pp) * 16 + 8 * (fq & 1); const float* bip = a.in[17] + ((size_t)lg * 64 + pp) * 16 + 8 * (fq & 1);
        const f32x4 br0 = *(const f32x4*)brp, br1 = *(const f32x4*)(brp + 4), bi0 = *(const f32x4*)bip, bi1 = *(const f32x4*)(bip + 4);
        bf16x8 fre = pack8(br0 * kr - bi0 * ki, br1 * kr - bi1 * ki), fim = pack8(bi0 * kr + br0 * ki, bi1 * kr + br1 * ki);
        if (fq >= 2) { fre = (bf16x8){0, 0, 0, 0, 0, 0, 0, 0}; fim = fre; }
        bfrag[nn] = fre; bfrag[nn + 4] = fim; }
    const size_t tok0 = (size_t)b * 2048 + 256 * wave;
    const bf16* zu = z + (tok0 + fr) * PIN + 1536 + 16 * g;
    bf16* ygp = (bf16*)(a.ws + WS_YG) + (tok0 + fr) * 256 + 16 * g + 4 * fq;
    LAS float* BU = (LAS float*)(lds + wave * 12800);
    LAS bf16* Xs = (LAS bf16*)(lds + wave * 12800 + 8448);
    LAS float* EX = (LAS float*)(lds + 102400);
    bf16x8 cf[4]; f32x4 dd = (f32x4){0.f, 0.f, 0.f, 0.f};
#pragma unroll
    for (int ks = 0; ks < 4; ++ks) cf[ks] = (bf16x8){0, 0, 0, 0, 0, 0, 0, 0};
    float xr = 0.f, xi = 0.f;
    s5_span<1>(zu, ygp, BU, Xs, bfrag, cf, dd, are, aim, xr, xi, lane);
    EX[wave * 128 + p] = xr; EX[wave * 128 + 64 + p] = xi;
    __syncthreads();
    {   float Ar = are, Ai = aim;
#pragma unroll
        for (int q = 0; q < 8; ++q) { const float tr = Ar * Ar - Ai * Ai, ti = 2.0f * Ar * Ai; Ar = tr; Ai = ti; }
        xr = 0.f; xi = 0.f;
#pragma unroll
        for (int w = 0; w < 7; ++w) if (w < wave) { const float er = EX[w * 128 + p], ei = EX[w * 128 + 64 + p];
            const float tr = Ar * xr - Ai * xi + er, ti = Ar * xi + Ai * xr + ei; xr = tr; xi = ti; }
    }
#pragma unroll
    for (int ks = 0; ks < 4; ++ks) { const float* cp = (ks < 2 ? a.in[18] : a.in[19]) + ((size_t)lg * 16 + fr) * 64 + 32 * (ks & 1) + 8 * fq;
        f32x4 c0 = *(const f32x4*)cp, c1 = *(const f32x4*)(cp + 4); if (ks >= 2) { c0 = -c0; c1 = -c1; } cf[ks] = pack8(c0, c1); }
    dd = *(const f32x4*)(a.in[20] + (size_t)l * 256 + 16 * g + 4 * fq);
    s5_span<2>(zu, ygp, BU, Xs, bfrag, cf, dd, are, aim, xr, xi, lane);
    __syncthreads();
}

__device__ __forceinline__ void poolconv_item(ArgsRef a, int l, int idx, int lane) {
    const bf16* z = (const bf16*)(a.ws + WS_Z); bf16* ycat = (bf16*)(a.ws + WS_YCAT);
    const int tokb = idx * 8, pos0 = tokb & 2047, ch = 4 * lane, gq = lane >> 4, wq = 2 << gq;
    const float m1 = gq >= 1 ? 1.0f : 0.0f, m2 = gq >= 2 ? 1.0f : 0.0f, m3 = gq >= 3 ? 1.0f : 0.0f;
    const float* gn = a.in[24] + (size_t)l * 1024;
    {   f32x4 row[23];
        const bf16* zp = z + (size_t)tokb * PIN + 512 + ch;
#pragma unroll
        for (int r = 0; r < 23; ++r) { row[r] = (f32x4){0.f, 0.f, 0.f, 0.f}; if (pos0 - 15 + r >= 0) row[r] = ld4bf(zp + (ptrdiff_t)(r - 15) * PIN); }
        const f32x4 gg = *(const f32x4*)(gn + 256 + ch);
#pragma unroll
        for (int tt = 0; tt < 8; ++tt) {
            f32x4 sum = row[15 + tt] + row[14 + tt];
            sum += (row[13 + tt] + row[12 + tt]) * m1;
            sum += ((row[11 + tt] + row[10 + tt]) + (row[9 + tt] + row[8 + tt])) * m2;
            sum += (((row[7 + tt] + row[6 + tt]) + (row[5 + tt] + row[4 + tt])) + ((row[3 + tt] + row[2 + tt]) + (row[1 + tt] + row[tt]))) * m3;
            const int pos = pos0 + tt, cnt = (pos + 1 < wq) ? pos + 1 : wq;
            const f32x4 o = sum * (1.0f / (float)cnt) - row[15 + tt];
            const float ss = wave_sum((o[0] * o[0] + o[1] * o[1]) + (o[2] * o[2] + o[3] * o[3]));
            const float rstd = 1.0f / sqrtf(ss * (1.0f / 256.0f) + EPS);
            st4bf(ycat + (size_t)(tokb + tt) * 1024 + 256 + ch, o * rstd * gg); }
    }
    {   f32x4 prod[10], bg[8];
        const bf16* zp = z + (size_t)tokb * PIN + 768 + ch;
#pragma unroll
        for (int r = 0; r < 10; ++r) { prod[r] = (f32x4){0.f, 0.f, 0.f, 0.f}; if (pos0 - 2 + r >= 0) prod[r] = ld4bf(zp + (ptrdiff_t)(r - 2) * PIN + 256) * ld4bf(zp + (ptrdiff_t)(r - 2) * PIN + 512); }
#pragma unroll
        for (int tt = 0; tt < 8; ++tt) bg[tt] = ld4bf(zp + (size_t)tt * PIN);
        const f32x4 w0 = *(const f32x4*)(a.in[13] + ((size_t)l * 3 + 0) * 256 + ch), w1 = *(const f32x4*)(a.in[13] + ((size_t)l * 3 + 1) * 256 + ch), w2 = *(const f32x4*)(a.in[13] + ((size_t)l * 3 + 2) * 256 + ch);
        const f32x4 gg = *(const f32x4*)(gn + 512 + ch);
#pragma unroll
        for (int tt = 0; tt < 8; ++tt) {
            const f32x4 o = bg[tt] * (w0 * prod[tt] + w1 * prod[tt + 1] + w2 * prod[tt + 2]);
            const float ss = wave_sum((o[0] * o[0] + o[1] * o[1]) + (o[2] * o[2] + o[3] * o[3]));
            const float rstd = 1.0f / sqrtf(ss * (1.0f / 256.0f) + EPS);
            st4bf(ycat + (size_t)(tokb + tt) * 1024 + 512 + ch, o * rstd * gg); }
    }
}

__device__ __forceinline__ void glu_item(ArgsRef a, int l, int it, LAS unsigned char* lds, int tid, int wave, int lane) {
    const bf16* yg = (const bf16*)(a.ws + WS_YG) + (size_t)it * 64 * 256; bf16* ycat = (bf16*)(a.ws + WS_YCAT) + (size_t)it * 64 * 1024 + 768;
    const bf16* Bt = (const bf16*)(a.ws + WS_W + (size_t)l * LW + OW_GLU);
    LAS unsigned char* T = lds;
    LAS float* P = (LAS float*)(lds + 34816);
    const int fr = lane & 15, fq = lane >> 4, n0 = 32 * wave;
    u32x4 st[4];
#pragma unroll
    for (int j = 0; j < 4; ++j) { const int idx = tid + 512 * j; st[j] = *(const u32x4*)(yg + (size_t)(idx >> 5) * 256 + 8 * (idx & 31)); }
    bf16x8 bfr[2][8];
#pragma unroll
    for (int nt = 0; nt < 2; ++nt)
#pragma unroll
        for (int ks = 0; ks < 8; ++ks) bfr[nt][ks] = *(const bf16x8*)(Bt + (size_t)(n0 + 16 * nt + fr) * 256 + 32 * ks + 8 * fq);
#pragma unroll
    for (int j = 0; j < 4; ++j) { const int idx = tid + 512 * j; *(LAS u32x4*)(T + (idx >> 5) * 528 + 16 * (idx & 31)) = st[j]; }
    __syncthreads();
    f32x4 acc[4][2];
#pragma unroll
    for (int tt = 0; tt < 4; ++tt) { acc[tt][0] = (f32x4){0.f, 0.f, 0.f, 0.f}; acc[tt][1] = acc[tt][0]; }
#pragma unroll
    for (int ks = 0; ks < 8; ++ks)
#pragma unroll
        for (int tt = 0; tt < 4; ++tt) { const bf16x8 af = *(const LAS bf16x8*)(T + (16 * tt + fr) * 528 + (32 * ks + 8 * fq) * 2);
            acc[tt][0] = __builtin_amdgcn_mfma_f32_16x16x32_bf16(bfr[0][ks], af, acc[tt][0], 0, 0, 0);
            acc[tt][1] = __builtin_amdgcn_mfma_f32_16x16x32_bf16(bfr[1][ks], af, acc[tt][1], 0, 0, 0); }
    const f32x4 gb0 = *(const f32x4*)(a.in[23] + (size_t)l * 256 + n0 + 4 * fq), gb1 = *(const f32x4*)(a.in[23] + (size_t)l * 256 + n0 + 16 + 4 * fq);
#pragma unroll
    for (int tt = 0; tt < 4; ++tt) { float ss = 0.f;
#pragma unroll
        for (int nt = 0; nt < 2; ++nt) { const u32x2 yw = *(const LAS u32x2*)(T + (16 * tt + fr) * 528 + (n0 + 16 * nt + 4 * fq) * 2);
            const f32x4 y = (f32x4){bf_lo(yw.x), bf_hi(yw.x), bf_lo(yw.y), bf_hi(yw.y)}; const f32x4 g4 = nt ? gb1 : gb0; f32x4 o;
#pragma unroll
            for (int e = 0; e < 4; ++e) { o[e] = y[e] * pg8::sigmoid_f(acc[tt][nt][e] + g4[e]); ss += o[e] * o[e]; }
            acc[tt][nt] = o; }
        ss += __shfl_xor(ss, 16); ss += __shfl_xor(ss, 32);
        if (fq == 0) P[(16 * tt + fr) * 8 + wave] = ss; }
    __syncthreads();
    const float* gn = a.in[24] + (size_t)l * 1024 + 768;
    const f32x4 gg0 = *(const f32x4*)(gn + n0 + 4 * fq), gg1 = *(const f32x4*)(gn + n0 + 16 + 4 * fq);
#pragma unroll
    for (int tt = 0; tt < 4; ++tt) { const int t = 16 * tt + fr; const f32x4 p0 = *(const LAS f32x4*)(P + t * 8), p1 = *(const LAS f32x4*)(P + t * 8 + 4);
        const float rstd = __builtin_amdgcn_rsqf((((p0[0] + p0[1]) + (p0[2] + p0[3])) + ((p1[0] + p1[1]) + (p1[2] + p1[3]))) * (1.0f / 256.0f) + EPS);
        st4bf(ycat + (size_t)t * 1024 + n0 + 4 * fq, acc[tt][0] * rstd * gg0); st4bf(ycat + (size_t)t * 1024 + n0 + 16 + 4 * fq, acc[tt][1] * rstd * gg1); }
    __syncthreads();
}

#define XB_TMO      128
#define XB_XCNT(j)  (256  + 64 * (j))
#define XB_XSUB(j)  (1280 + 64 * (j))
#define XB_XGEN(j)  (2304 + 64 * (j))
#define XB_TOP      3328
#define XB_TOPGEN   3392
#define XCD_BAR_WORDS 3456
#define XB_SPIN_CAP (1u << 18)

__device__ __forceinline__ unsigned xb_ld(unsigned* p)              { return __hip_atomic_load(p, __ATOMIC_RELAXED, __HIP_MEMORY_SCOPE_AGENT); }
__device__ __forceinline__ unsigned xb_add(unsigned* p, unsigned v) { return __hip_atomic_fetch_add(p, v, __ATOMIC_RELAXED, __HIP_MEMORY_SCOPE_AGENT); }
__device__ __forceinline__ unsigned xb_xcc_id() { return (unsigned)__builtin_amdgcn_s_getreg((3 << 11) | 20) & 0xFu; }
#define XB_SPIN(cond, bar) do { unsigned _sp = 0; while (cond) { __builtin_amdgcn_s_sleep(1); \
    if ((++_sp & 255u) == 0u) { if (xb_ld(&(bar)[XB_TMO])) break; if (_sp > XB_SPIN_CAP) { atomicAdd(&(bar)[XB_TMO], 1u); break; } } } } while (0)

struct XcdBarrier {
    unsigned* bar; unsigned x;
    volatile LAS unsigned* st;
};

__device__ __forceinline__ XcdBarrier xcd_barrier_post(unsigned* bar, volatile LAS unsigned* st) {
    XcdBarrier b; b.bar = bar; b.x = xb_xcc_id(); b.st = st;
    if (threadIdx.x == 0) (void)xb_add(&bar[XB_XCNT(b.x)], 1u);
    return b;
}
__device__ __forceinline__ void xcd_barrier_complete(unsigned* bar, unsigned x, unsigned& nloc, unsigned& nx) {
    const unsigned G = gridDim.x * gridDim.y * gridDim.z;
    unsigned sum, cnt, mine, sp = 0u;
    for (;;) {
        sum = 0u; cnt = 0u; mine = 0u;
#pragma unroll 1
        for (unsigned j = 0; j < 16; ++j) { const unsigned c = xb_ld(&bar[XB_XCNT(j)]); sum += c; cnt += (c > 0u) ? 1u : 0u; mine = (j == x) ? c : mine; }
        if (sum == G) break;
        __builtin_amdgcn_s_sleep(1);
        if ((++sp & 255u) == 0u) { if (xb_ld(&bar[XB_TMO])) break; if (sp > XB_SPIN_CAP) { atomicAdd(&bar[XB_TMO], 1u); break; } }
    }
    nloc = mine > 0u ? mine : 1u; nx = cnt > 0u ? cnt : 1u;
}

__device__ __forceinline__ void xcd_barrier(const XcdBarrier& b) {
    asm volatile("s_waitcnt vmcnt(0)" ::: "memory");
    __syncthreads();
    if (threadIdx.x == 0) {
        unsigned* bar = b.bar;
        __builtin_amdgcn_s_waitcnt(0);
        unsigned nloc = b.st[0], nx = b.st[1];
        if (nloc == 0u) { xcd_barrier_complete(bar, b.x, nloc, nx); b.st[0] = nloc; b.st[1] = nx; }
        const unsigned old = xb_add(&bar[XB_XSUB(b.x)], 1u);
        const unsigned gen = old / nloc;
        if (old + 1u == (gen + 1u) * nloc) {
            __builtin_amdgcn_fence(__ATOMIC_RELEASE, "agent");
            asm volatile("s_waitcnt vmcnt(0)" ::: "memory");
            const unsigned og = xb_add(&bar[XB_TOP], 1u);
            const unsigned tg = og / nx;
            if (og + 1u == (tg + 1u) * nx) xb_add(&bar[XB_TOPGEN], 1u);
            else XB_SPIN(xb_ld(&bar[XB_TOPGEN]) == tg, bar);
            __builtin_amdgcn_fence(__ATOMIC_ACQUIRE, "agent");
            xb_add(&bar[XB_XGEN(b.x)], 1u);
            asm volatile("s_waitcnt vmcnt(0)" ::: "memory");
        } else {
            XB_SPIN(xb_ld(&bar[XB_XGEN(b.x)]) == gen, bar);
            __builtin_amdgcn_fence(__ATOMIC_ACQUIRE, "agent");
            asm volatile("s_waitcnt vmcnt(0)" ::: "memory");
        }
    }
    __syncthreads();
}

#ifndef SYNC_REP
#define SYNC_REP 1
#endif
#ifndef REP_MASK
#define REP_MASK 0
#endif
#ifndef PHM
#define PHM 0xfff
#endif
#ifndef PER_PHASE_LAUNCH
#define PER_PHASE_LAUNCH 0
#endif
__global__ void __launch_bounds__(512) mega(Args a_) {
    extern __shared__ __attribute__((aligned(16))) unsigned char lds_raw[];
    LAS unsigned char* lds = (LAS unsigned char*)lds_raw;
    const int G = gridDim.x, NGW = G * 8;
    const int ph_lo = a_.ph_lo, ph_hi = a_.ph_hi;
    const bool multi = (ph_hi - ph_lo) > 1;
    unsigned char* const ws0 = a_.ws;
    volatile LAS unsigned* MISC = (volatile LAS unsigned*)(lds + 131072 + 320);
    if (threadIdx.x < 32) MISC[threadIdx.x] = 0u;
    __syncthreads();
    XcdBarrier bar; bar.bar = (unsigned*)(ws0 + WS_BAR); bar.x = 0; bar.st = nullptr;
    if (multi) bar = xcd_barrier_post((unsigned*)(ws0 + WS_BAR), MISC + 8);
    if (ph_lo < 0) cg::this_grid().sync();
    unsigned long long tacc = 0ull;
    for (int ph = ph_lo; ph < ph_hi; ++ph) {
        const unsigned long long tph0 = TPROBE ? __builtin_amdgcn_s_memrealtime() : 0ull;
        int tid = threadIdx.x; asm volatile("" : "+v"(tid));
        const int lane = tid & 63, wave = __builtin_amdgcn_readfirstlane(tid >> 6), gw = blockIdx.x * 8 + wave;
        const Args __attribute__((address_space(4)))* ap = (const Args __attribute__((address_space(4)))*)__builtin_amdgcn_kernarg_segment_ptr(); asm volatile("" : "+s"(ap));
        ArgsRef a = *ap;
        unsigned char* ws = a.ws;
        float* cond = (float*)(ws + WS_COND); float* SS = (float*)(ws + WS_SS); const float* SHW = (const float*)(ws + WS_SHW);
        bf16* H = (bf16*)(ws + WS_H); bf16* ACT = (bf16*)(ws + WS_ACT); bf16* Z = (bf16*)(ws + WS_Z); bf16* YG = (bf16*)(ws + WS_YG); bf16* YCAT = (bf16*)(ws + WS_YCAT);
        if (ph == 0) { for (int rp = 0; rp < PREP_REP; ++rp) { if (rp) { XcdBarrier b3 = bar; asm volatile("" : "+s"(b3.bar)); xcd_barrier(b3); } prep_phase(a, lds, tid, wave, lane, G); } }
        else if (ph == 1) norm_phase(a.in[0], a.in[4], cond, cond + 1024, H, (bf16*)(ws + WS_XB), gw, NGW, lane);
        else {
            const int l = (ph - 2) / NSLOT, slot = (ph - 2) % NSLOT, s = (int)((SLOT_MAP >> (4 * slot)) & 15ull); const bool rep = ((SLOT_REP >> slot) & 1u) != 0u;
            unsigned char* wl = ws + WS_W + (size_t)l * LW;
            const float* cl = cond + (size_t)l * 8 * NCOND;
            if ((PHM & 8) && (s == 0 || s == 7)) {
                pg8::Gemm gm{H, (const bf16*)(wl + (s == 0 ? OW_IN1 : OW_IN2)), M, 2 * DFF, D}; pg8::StaticOrder S; S.init(M, 2 * DFF, G, (int)blockIdx.x);
                pg8::EpiSwiglu E{ACT, DFF};
                pg8::gemm_phase<pg8::EpiSwiglu, pg8::StaticOrder>(lds, gm, S, E, nullptr, tid);
            } else if ((PHM & 16) && (s == 1 || s == 6 || s == 8)) {
                const bf16* A = (s == 6) ? YCAT : ACT; const int K = (s == 6) ? D : DFF;
                const bf16* Bt = (const bf16*)(wl + (s == 1 ? OW_OUT1 : (s == 6 ? OW_MO : OW_OUT2)));
                pg8::Gemm gm{A, Bt, M, D, K}; pg8::StaticOrder S; S.init(M, D, G, (int)blockIdx.x);
                bf16* XB = (bf16*)(ws + WS_XB);
                const float* gnext = (s == 1) ? a.in[7] + (size_t)l * D : (s == 6 ? a.in[26] + (size_t)l * D : (l == NL - 1 ? a.in[29] : a.in[4] + (size_t)(l + 1) * D));
                const float* shnext = (s == 1) ? cl + 3 * 1024 : (s == 6 ? cl + 6 * 1024 : cl + (size_t)8 * NCOND);
                const float* scnext = shnext + 1024;
                bf16* xa = (s == 8 && l == NL - 1) ? (bf16*)nullptr : H;
                const float gs = __builtin_bit_cast(float, __builtin_amdgcn_readfirstlane(s == 6 ? 0x3f800000 : 0x3f000000));
                const unsigned need = 32u * (unsigned)(l * 3 + (s == 1 ? 0 : (s == 6 ? 1 : 2)) + 1);
                pg8::EpiResid E{XB, XB, a.out, cl + (s == 1 ? 2 : (s == 6 ? 5 : 8)) * 1024, gnext, scnext, shnext, xa, (unsigned*)(ws + WS_SS), (unsigned*)(ws + WS_BAR + 16384), gs, need};
                pg8::gemm_phase<pg8::EpiResid, pg8::StaticOrder>(lds, gm, S, E, nullptr, tid);
            } else if ((PHM & 32) && s == 2) {
                pg8::Gemm gm{H, (const bf16*)(wl + OW_MIX), M, PIN, D}; pg8::StaticOrder S; S.init(M, PIN, G, (int)blockIdx.x);
                pg8::EpiZ E{Z, PIN};
                pg8::gemm_phase<pg8::EpiZ, pg8::StaticOrder>(lds, gm, S, E, nullptr, tid);
            } else if ((PHM & 64) && s == 3) {
                int w_first = gw, w_stride = NGW;
                if (G >= 256) { w_first = (blockIdx.x < 128) ? blockIdx.x * 8 + wave : 2048; w_stride = 1024; }
                for (int it = blockIdx.x; it < 256; it += G) { if (it < 128) { for (int rq = 0; rq < SGU_REP; ++rq) sgu_item(a, l, it, lds, tid, wave, lane); } else { for (int rq = 0; rq < S5_REP; ++rq) s5_wg_item(a, l, it - 128, lds, wave, lane); } }
                for (int rq = 0; rq < PC_REP; ++rq) for (int idx = w_first; idx < 2048; idx += w_stride) poolconv_item(a, l, idx, lane);
            } else if ((PHM & 256) && s == 5) {
                for (int it = blockIdx.x; it < M / 64; it += G) glu_item(a, l, it, lds, tid, wave, lane);
            }
        }
        if (ph + 1 < ph_hi) { XcdBarrier b2 = bar; asm volatile("" : "+s"(b2.bar)); xcd_barrier(b2); }
        if (TPROBE) { int ty; if (ph == 0) ty = 0; else if (ph == 1) ty = 1; else { const int s_ = (int)((SLOT_MAP >> (4 * ((ph - 2) % NSLOT))) & 15ull); ty = (s_ == 0 || s_ == 7) ? 2 : ((s_ == 1 || s_ == 6 || s_ == 8) ? 3 : (s_ == 2 ? 4 : (s_ == 3 ? 5 : 6))); }
            if ((TPROBE >> ty) & 1) tacc += __builtin_amdgcn_s_memrealtime() - tph0; }
    }
    if (TPROBE) { const unsigned long long te = __builtin_amdgcn_s_memrealtime(); while (__builtin_amdgcn_s_memrealtime() - te < tacc) __builtin_amdgcn_s_sleep(8); }
}

extern "C" void kernel_launch(void* const* d_in, const int* in_sizes, int n_in, void* d_out, int out_size, void* d_ws, size_t ws_size, hipStream_t stream) {
    static int grid = 0;
    if (grid == 0) {
        int dev = 0, cus = 0;
        if (n_in != 30 || ws_size < WS_END || hipGetDevice(&dev) != hipSuccess || hipDeviceGetAttribute(&cus, hipDeviceAttributeMultiprocessorCount, dev) != hipSuccess) { grid = -1; return; }
        if (hipFuncSetAttribute((const void*)mega, hipFuncAttributeMaxDynamicSharedMemorySize, LDS_BYTES) != hipSuccess) { grid = -1; return; }
        int per_cu = 0;
        if (hipOccupancyMaxActiveBlocksPerMultiprocessor(&per_cu, (const void*)mega, 512, LDS_BYTES) != hipSuccess || per_cu < 1) per_cu = 1;
        (void)hipGetLastError();
        grid = cus;
    }
    if (grid < 0) return;
    Args a{};
    for (int i = 0; i < 30; ++i) a.in[i] = (const float*)d_in[i];
    a.out = (float*)d_out; a.ws = (unsigned char*)d_ws;
#if PER_PHASE_LAUNCH
    for (int ph = 0; ph < NPH; ++ph) { a.ph_lo = ph; a.ph_hi = ph + 1; hipLaunchKernelGGL(mega, dim3(grid), dim3(512), LDS_BYTES, stream, a); }
#else
    (void)hipMemsetAsync((char*)d_ws + WS_BAR, 0, BAR_BYTES, stream);
    a.ph_lo = 0; a.ph_hi = NPH;
    void* args[] = {&a};
    (void)hipLaunchCooperativeKernel((const void*)mega, dim3(grid), dim3(512), args, LDS_BYTES, stream);
#endif
}
```

```cpp
#include <hip/hip_runtime.h>
#include <hip/hip_cooperative_groups.h>
namespace cg = cooperative_groups;
namespace pg8 {
#define PG8_LAS __attribute__((address_space(3)))
typedef unsigned short bf16_t;
typedef short bf16x8 __attribute__((ext_vector_type(8)));
typedef float f32x4 __attribute__((ext_vector_type(4)));
typedef unsigned u32x4 __attribute__((ext_vector_type(4)));
constexpr int BM = 256, BK = 64, HALF = 128, HTB = HALF * BK * 2  , STAGE_BYTES = 8 * HTB, NXCD = 8, WGM = 8;

__host__ __device__ __forceinline__ int lds_byte(int r, int c) { const int st = (r >> 4) * 2 + (c >> 5), rr = r & 15, cc = c & 31, ob = rr * 64 + cc * 2; return st * 1024 + (ob ^ (((ob >> 9) & 1) << 5)); }
__host__ __device__ __forceinline__ void stage_rc(int b, int& R, int& C) { const int st = b / 1024, sb = b % 1024, swz = sb ^ (((sb >> 9) & 1) << 5); R = (st >> 1) * 16 + swz / 64; C = (st & 1) * 32 + (swz % 64) / 2; }
__host__ __device__ __forceinline__ int perm32(int rho) { const int n = rho >> 4, i = rho & 15; return 8 * (i >> 2) + 4 * n + (i & 3); }

struct Unit { int pm, pn; };
struct Gemm { const bf16_t* A; const bf16_t* Bt; int M, N, K; };

struct StaticOrder {
    int nM, nN, nwg, G, c;
    __host__ __device__ void init(int M, int N, int G_, int c_) { nM = M / BM; nN = N / BM; nwg = nM * nN; G = G_; c = c_; }
    __host__ __device__ bool next(int i, Unit& u) const {
        const long L = (long)i * G + c; if (L >= nwg) return false;
        int wgid = (int)L; { const int q = nwg / NXCD, r = nwg % NXCD, xcd = wgid % NXCD, off = wgid / NXCD; wgid = (xcd < r ? xcd * (q + 1) : r * (q + 1) + (xcd - r) * q) + off; }
        const int nig = WGM * nN, gid = wgid / nig, fm = gid * WGM, gsz = (nM - fm) < WGM ? (nM - fm) : WGM;
        u.pm = fm + ((wgid % nig) % gsz); u.pn = (wgid % nig) / gsz; return true;
    }
    __device__ __forceinline__ void a_ready(const Unit&) const {}
    __device__ __forceinline__ void done(const Unit&) const {}
};
__device__ __forceinline__ unsigned cvt_pk_bf16(float lo, float hi) { unsigned r; asm volatile("v_cvt_pk_bf16_f32 %0, %1, %2" : "=v"(r) : "v"(lo), "v"(hi)); return r; }
typedef float f32x2 __attribute__((ext_vector_type(2)));
typedef unsigned u32x2 __attribute__((ext_vector_type(2)));
__device__ __forceinline__ float silu_f(float a) { return a * __builtin_amdgcn_rcpf(1.0f + __expf(-a)); }
__device__ __forceinline__ float sigmoid_f(float a) { return __builtin_amdgcn_rcpf(1.0f + __expf(-a)); }
__device__ __forceinline__ float gelu_tanh(float y) { const float z = 1.5957691216f * (y + 0.044715f * y * y * y); return y * __builtin_amdgcn_rcpf(1.0f + __expf(-z)); }
__device__ __forceinline__ float bf_lo(unsigned w) { return __uint_as_float(w << 16); }
__device__ __forceinline__ float bf_hi(unsigned w) { return __uint_as_float(w & 0xffff0000u); }

struct EpiZ {
    static constexpr bool PERM = true, AFTER_DRAIN = false;
    bf16_t* O; int ldc;
    __device__ __forceinline__ void operator()(const f32x4 (&acc)[2][2][4][2], const Unit& u, int wr, int wc, int fr, int fq) const {
        const int row0 = u.pm * BM + wr * 64 + fr, col0 = u.pn * BM + wc * 32 + 8 * fq;
#pragma unroll
        for (int ai = 0; ai < 2; ++ai)
#pragma unroll
            for (int m = 0; m < 4; ++m) { bf16_t* rowp = O + (size_t)(row0 + ai * HALF + m * 16) * ldc + col0;
#pragma unroll
                for (int bj = 0; bj < 2; ++bj) { const f32x4 v0 = acc[ai][bj][m][0], v1 = acc[ai][bj][m][1];
                    u32x4 w; w.x = cvt_pk_bf16(v0[0], v0[1]); w.y = cvt_pk_bf16(v0[2], v0[3]); w.z = cvt_pk_bf16(v1[0], v1[1]); w.w = cvt_pk_bf16(v1[2], v1[3]);
                    *(u32x4*)(rowp + bj * HALF) = w; } }
    }
};
struct EpiSwiglu {
    static constexpr bool PERM = true, AFTER_DRAIN = false;
    bf16_t* O; int ldc;
    __device__ __forceinline__ void operator()(const f32x4 (&acc)[2][2][4][2], const Unit& u, int wr, int wc, int fr, int fq) const {
        const int row0 = u.pm * BM + wr * 64 + fr, col0 = u.pn * HALF + wc * 32 + 8 * fq;
#pragma unroll
        for (int ai = 0; ai < 2; ++ai)
#pragma unroll
            for (int m = 0; m < 4; ++m) { bf16_t* rowp = O + (size_t)(row0 + ai * HALF + m * 16) * ldc + col0;
                const f32x4 a0 = acc[ai][0][m][0], a1 = acc[ai][0][m][1], b0 = acc[ai][1][m][0], b1 = acc[ai][1][m][1];
                const f32x4 t0 = a0 * -1.4426950408889634f, t1 = a1 * -1.4426950408889634f;
                f32x4 e0, e1;
#pragma unroll
                for (int j = 0; j < 4; ++j) { e0[j] = __builtin_amdgcn_exp2f(t0[j]); e1[j] = __builtin_amdgcn_exp2f(t1[j]); }
                const f32x4 d0 = e0 + 1.0f, d1 = e1 + 1.0f; f32x4 r0, r1;
#pragma unroll
                for (int j = 0; j < 4; ++j) { r0[j] = __builtin_amdgcn_rcpf(d0[j]); r1[j] = __builtin_amdgcn_rcpf(d1[j]); }
                const f32x4 v0 = (a0 * b0) * r0, v1 = (a1 * b1) * r1;
                u32x4 w; w.x = cvt_pk_bf16(v0[0], v0[1]); w.y = cvt_pk_bf16(v0[2], v0[3]); w.z = cvt_pk_bf16(v1[0], v1[1]); w.w = cvt_pk_bf16(v1[2], v1[3]);
                __builtin_nontemporal_store(w, (u32x4*)rowp); }
    }
};
struct EpiResid {
    static constexpr bool PERM = true, AFTER_DRAIN = true;
    const bf16_t* xin; bf16_t* xout; float* fout; const float* gate; const float* gnext; const float* scnext; const float* shnext; bf16_t* xa; unsigned* xbuf; unsigned* cnt; float gs; unsigned need;
    __device__ __forceinline__ void fused(f32x4 (&acc)[2][2][4][2], const Unit& u, int wr, int wc, int fr, int fq, PG8_LAS unsigned char* lds, int wid, int lane) const {
        PG8_LAS float* P = (PG8_LAS float*)lds;
        PG8_LAS float* S = (PG8_LAS float*)(lds + 4096);
        const int row0 = u.pm * BM + wr * 64 + fr, col0 = u.pn * BM + wc * 32 + 8 * fq;
        const size_t cb = (size_t)(u.pm >> 3) * 9216 + col0;
        float sq[8];
#pragma unroll
        for (int i = 0; i < 8; ++i) sq[i] = 0.f;
#pragma unroll
        for (int bj = 0; bj < 2; ++bj) { const int co = bj * HALF;
            const f32x4 gv0 = *(const f32x4*)(gate + cb + co) * gs, gv1 = *(const f32x4*)(gate + cb + co + 4) * gs;
#pragma unroll
            for (int ai = 0; ai < 2; ++ai)
#pragma unroll
                for (int m = 0; m < 4; ++m) { const size_t off = (size_t)(row0 + ai * HALF + m * 16) * 1024 + col0 + co;
                    const u32x4 xw = *(const u32x4*)(xin + off);
                    const f32x4 xi0 = (f32x4){bf_lo(xw.x), bf_hi(xw.x), bf_lo(xw.y), bf_hi(xw.y)}, xi1 = (f32x4){bf_lo(xw.z), bf_hi(xw.z), bf_lo(xw.w), bf_hi(xw.w)};
                    const f32x4 xn0 = xi0 + gv0 * acc[ai][bj][m][0], xn1 = xi1 + gv1 * acc[ai][bj][m][1];
                    if (xa) { u32x4 ow; ow.x = cvt_pk_bf16(xn0[0], xn0[1]); ow.y = cvt_pk_bf16(xn0[2], xn0[3]); ow.z = cvt_pk_bf16(xn1[0], xn1[1]); ow.w = cvt_pk_bf16(xn1[2], xn1[3]);
                        *(u32x4*)(xout + off) = ow; }
                    acc[ai][bj][m][0] = xn0; acc[ai][bj][m][1] = xn1;
                    sq[ai * 4 + m] += ((xn0[0] * xn0[0] + xn0[1] * xn0[1]) + (xn0[2] * xn0[2] + xn0[3] * xn0[3])) + ((xn1[0] * xn1[0] + xn1[1] * xn1[1]) + (xn1[2] * xn1[2] + xn1[3] * xn1[3])); }
            asm volatile("" ::: "memory"); }
#pragma unroll
        for (int i = 0; i < 8; ++i) { float q = sq[i]; q += __shfl_xor(q, 16); q += __shfl_xor(q, 32);
            if (fq == 0) P[((i >> 2) * HALF + wr * 64 + (i & 3) * 16 + fr) * 4 + wc] = q; }
        asm volatile("s_waitcnt lgkmcnt(0)" ::: "memory"); __builtin_amdgcn_s_barrier(); asm volatile("" ::: "memory");
        const int row = wid * 32 + (lane & 31);
        if (lane < 32) { const f32x4 p = *(const PG8_LAS f32x4*)(P + row * 4); const float s = (p[0] + p[1]) + (p[2] + p[3]);
            __hip_atomic_store(xbuf + ((size_t)(u.pm * BM + row) * 4 + u.pn), __float_as_uint(s), __ATOMIC_RELAXED, __HIP_MEMORY_SCOPE_AGENT); }
        asm volatile("s_waitcnt vmcnt(0)" ::: "memory");
        if (lane == 0) __hip_atomic_fetch_add(cnt + 64 * u.pm, 1u, __ATOMIC_RELAXED, __HIP_MEMORY_SCOPE_AGENT);
        if (wid == 0) {
            unsigned spins = 0;
            while ((unsigned)__builtin_amdgcn_readfirstlane(__hip_atomic_load(cnt + 64 * u.pm, __ATOMIC_RELAXED, __HIP_MEMORY_SCOPE_AGENT)) < need) { __builtin_amdgcn_s_sleep(2); if (++spins > (1u << 22)) break; }
            __builtin_amdgcn_fence(__ATOMIC_ACQUIRE, "agent");
        }
        asm volatile("s_waitcnt vmcnt(0) lgkmcnt(0)" ::: "memory"); __builtin_amdgcn_s_barrier(); asm volatile("" ::: "memory");
        if (lane < 32) { const unsigned* slot = xbuf + (size_t)(u.pm * BM + row) * 4; float t = 0.f;
#pragma unroll
            for (int k = 0; k < 4; ++k) t += __uint_as_float(__hip_atomic_load(slot + k, __ATOMIC_RELAXED, __HIP_MEMORY_SCOPE_AGENT));
            S[row] = __builtin_amdgcn_rsqf(t * (1.0f / 1024.0f) + 1e-6f); }
        asm volatile("s_waitcnt vmcnt(0) lgkmcnt(0)" ::: "memory"); __builtin_amdgcn_s_barrier(); asm volatile("" ::: "memory");
        if (xa == nullptr) {
#pragma unroll
            for (int bj = 0; bj < 2; ++bj) { const int co = bj * HALF; const f32x4 g0 = *(const f32x4*)(gnext + col0 + co), g1 = *(const f32x4*)(gnext + col0 + co + 4);
#pragma unroll
                for (int ai = 0; ai < 2; ++ai)
#pragma unroll
                    for (int m = 0; m < 4; ++m) { const int r = ai * HALF + wr * 64 + m * 16 + fr; const float rs = S[r]; float* op = fout + (size_t)(u.pm * BM + r) * 1024 + col0 + co;
                        *(f32x4*)op = acc[ai][bj][m][0] * rs * g0; *(f32x4*)(op + 4) = acc[ai][bj][m][1] * rs * g1; } }
            asm volatile("s_waitcnt lgkmcnt(0)" ::: "memory"); __builtin_amdgcn_s_barrier(); asm volatile("" ::: "memory");
            return;
        }
#pragma unroll
        for (int bj = 0; bj < 2; ++bj) { const int co = bj * HALF;
            const f32x4 gm0 = *(const f32x4*)(gnext + col0 + co) * (*(const f32x4*)(scnext + cb + co) + 1.0f), gm1 = *(const f32x4*)(gnext + col0 + co + 4) * (*(const f32x4*)(scnext + cb + co + 4) + 1.0f);
            const f32x4 sh0 = *(const f32x4*)(shnext + cb + co), sh1 = *(const f32x4*)(shnext + cb + co + 4);
#pragma unroll
            for (int ai = 0; ai < 2; ++ai)
#pragma unroll
                for (int m = 0; m < 4; ++m) { const int r = ai * HALF + wr * 64 + m * 16 + fr; const float rs = S[r];
                    const f32x4 y0 = acc[ai][bj][m][0] * rs * gm0 + sh0, y1 = acc[ai][bj][m][1] * rs * gm1 + sh1;
                    u32x4 w; w.x = cvt_pk_bf16(y0[0], y0[1]); w.y = cvt_pk_bf16(y0[2], y0[3]); w.z = cvt_pk_bf16(y1[0], y1[1]); w.w = cvt_pk_bf16(y1[2], y1[3]);
                    *(u32x4*)(xa + (size_t)(u.pm * BM + r) * 1024 + col0 + co) = w; } }
        asm volatile("s_waitcnt lgkmcnt(0)" ::: "memory"); __builtin_amdgcn_s_barrier(); asm volatile("" ::: "memory");
    }
};
struct EpiGlu {
    static constexpr bool PERM = false, AFTER_DRAIN = true;
    const bf16_t* yg; const float* glu_b; const float* gn; bf16_t* ycat;
    __device__ __forceinline__ void fused(f32x4 (&acc)[2][2][4][2], const Unit& u, int wr, int wc, int fr, int fq, PG8_LAS unsigned char* lds, int wid, int lane) const {
        PG8_LAS float* P = (PG8_LAS float*)lds;
        const int col0 = wc * 32 + 4 * fq;
        f32x4 gb[2][2];
#pragma unroll
        for (int bj = 0; bj < 2; ++bj)
#pragma unroll
            for (int n = 0; n < 2; ++n) gb[bj][n] = *(const f32x4*)(glu_b + col0 + bj * HALF + n * 16);
#pragma unroll
        for (int ai = 0; ai < 2; ++ai)
#pragma unroll
            for (int m = 0; m < 4; ++m) { const int r = ai * HALF + wr * 64 + m * 16 + fr; const bf16_t* yp = yg + (size_t)(u.pm * BM + r) * 256 + col0; float s = 0.f;
#pragma unroll
                for (int bj = 0; bj < 2; ++bj)
#pragma unroll
                    for (int n = 0; n < 2; ++n) { const u32x2 yw = *(const u32x2*)(yp + bj * HALF + n * 16);
                        const f32x4 y = (f32x4){bf_lo(yw.x), bf_hi(yw.x), bf_lo(yw.y), bf_hi(yw.y)}; const f32x4 a = acc[ai][bj][m][n] + gb[bj][n]; f32x4 o;
#pragma unroll
                        for (int j = 0; j < 4; ++j) { o[j] = y[j] * sigmoid_f(a[j]); s += o[j] * o[j]; }
                        acc[ai][bj][m][n] = o; }
                s += __shfl_xor(s, 16); s += __shfl_xor(s, 32);
                if (fq == 0) P[r * 4 + wc] = s; }
        asm volatile("s_waitcnt lgkmcnt(0)" ::: "memory"); __builtin_amdgcn_s_barrier(); asm volatile("" ::: "memory");
        f32x4 gg[2][2];
#pragma unroll
        for (int bj = 0; bj < 2; ++bj)
#pragma unroll
            for (int n = 0; n < 2; ++n) gg[bj][n] = *(const f32x4*)(gn + col0 + bj * HALF + n * 16);
#pragma unroll
        for (int ai = 0; ai < 2; ++ai)
#pragma unroll
            for (int m = 0; m < 4; ++m) { const int r = ai * HALF + wr * 64 + m * 16 + fr; const f32x4 pp = *(const PG8_LAS f32x4*)(P + r * 4);
                const float rstd = 1.0f / sqrtf(((pp[0] + pp[1]) + (pp[2] + pp[3])) * (1.0f / 256.0f) + 1e-6f);
                bf16_t* op = ycat + (size_t)(u.pm * BM + r) * 1024 + 768 + col0;
#pragma unroll
                for (int bj = 0; bj < 2; ++bj)
#pragma unroll
                    for (int n = 0; n < 2; ++n) { const f32x4 o = acc[ai][bj][m][n] * rstd * gg[bj][n]; u32x2 w; w.x = cvt_pk_bf16(o[0], o[1]); w.y = cvt_pk_bf16(o[2], o[3]);
                        *(u32x2*)(op + bj * HALF + n * 16) = w; } }
        asm volatile("s_waitcnt lgkmcnt(0)" ::: "memory"); __builtin_amdgcn_s_barrier(); asm volatile("" ::: "memory");
    }
};

template <class Epi, class Sched, bool STAMP = false>
__device__ __forceinline__ void gemm_phase(PG8_LAS unsigned char* lds, const Gemm g, const Sched& S, const Epi& E, unsigned long long* stamps, const int tid) {
    const int wid = __builtin_amdgcn_readfirstlane(tid >> 6), lane = tid & 63, wr = wid >> 2, wc = wid & 3, fr = lane & 15, fq = lane >> 4;
    const int K = g.K, nt = K / BK;
    int ts_lo = 0, ts_hi = 0, nts = 0; const unsigned long long rt_entry = STAMP ? (unsigned long long)wall_clock64() : 0ull;
#define PG8_STAMP() do { if (STAMP && wid == 0 && nts < 64) { const unsigned long long _c = (unsigned long long)clock64(); \
        ts_lo = (lane == nts) ? (int)(unsigned)_c : ts_lo; ts_hi = (lane == nts) ? (int)(unsigned)(_c >> 32) : ts_hi; ++nts; } } while (0)
    PG8_STAMP();
    unsigned voffA[2], voffB[2];
#pragma unroll
    for (int i = 0; i < 2; ++i) { int R, C; stage_rc(tid * 16 + i * 8192, R, C); const int Rb = Epi::PERM ? ((R & ~31) + perm32(R & 31)) : R;
        voffA[i] = (unsigned)(R * K + C) * 2u; voffB[i] = (unsigned)(Rb * K + C) * 2u; }
    const size_t kstep = (size_t)(BK * 2);
    const size_t hstep = (size_t)HALF * K * 2;
    const size_t tstep = 2 * hstep;
    const unsigned ldsw = (unsigned)wid * 1024u;
    const int aoff = lds_byte(wr * 64 + fr, fq * 8), boff = lds_byte(wc * 32 + fr, fq * 8);
#define PG8_SA(b, h) (((b) * 2 + (h)) * HTB)
#define PG8_SB(b, h) ((4 + (b) * 2 + (h)) * HTB)
#define PG8_STAGE(bufoff, gbase, voff) do { _Pragma("unroll") for (int _i = 0; _i < 2; ++_i) \
        __builtin_amdgcn_global_load_lds((const unsigned*)((const char*)(gbase) + (voff)[_i]), (PG8_LAS unsigned*)(lds + (bufoff) + ldsw + _i * 8192), 16, 0, 0); } while (0)
#define PG8_LDA(dst, b, h) do { _Pragma("unroll") for (int m = 0; m < 4; ++m) _Pragma("unroll") for (int k = 0; k < 2; ++k) dst[m][k] = *(const PG8_LAS bf16x8*)(lds + PG8_SA(b, h) + aoff + m * 2048 + k * 1024); } while (0)
#define PG8_LDB(dst, b, h) do { _Pragma("unroll") for (int n = 0; n < 2; ++n) _Pragma("unroll") for (int k = 0; k < 2; ++k) dst[n][k] = *(const PG8_LAS bf16x8*)(lds + PG8_SB(b, h) + boff + n * 2048 + k * 1024); } while (0)
#define PG8_MMA(ai, bj, At, Bt) do { __builtin_amdgcn_s_setprio(1); _Pragma("unroll") for (int m = 0; m < 4; ++m) _Pragma("unroll") for (int n = 0; n < 2; ++n) _Pragma("unroll") for (int k = 0; k < 2; ++k) \
        acc[ai][bj][m][n] = __builtin_amdgcn_mfma_f32_16x16x32_bf16(Bt[n][k], At[m][k], acc[ai][bj][m][n], 0, 0, 0); __builtin_amdgcn_s_setprio(0); } while (0)
#define PG8_WAIT_V(n) asm volatile("s_waitcnt vmcnt(" #n ")" ::: "memory")
#define PG8_WAIT_L(n) asm volatile("s_waitcnt lgkmcnt(" #n ")" ::: "memory")
#define PG8_BAR __builtin_amdgcn_s_barrier()
#define PG8_SCHED __builtin_amdgcn_sched_barrier(0)
    Unit cur, nxt; int ui = 0;
    if (!S.next(0, cur)) return;
    f32x4 acc[2][2][4][2];
#pragma unroll
    for (int a = 0; a < 2; ++a)
#pragma unroll
        for (int b = 0; b < 2; ++b)
#pragma unroll
            for (int m = 0; m < 4; ++m)
#pragma unroll
                for (int n = 0; n < 2; ++n) acc[a][b][m][n] = (f32x4){0.f, 0.f, 0.f, 0.f};
    bf16x8 At[4][2], B0[2][2], B1[2][2];
    const char* cA = (const char*)g.A + (size_t)cur.pm * tstep; const char* cB = (const char*)g.Bt + (size_t)cur.pn * tstep;
    S.a_ready(cur);
    PG8_STAGE(PG8_SB(0, 0), cB, voffB); PG8_STAGE(PG8_SA(0, 0), cA, voffA); PG8_STAGE(PG8_SB(0, 1), cB + hstep, voffB); PG8_STAGE(PG8_SA(0, 1), cA + hstep, voffA);
    if (wr == 1) PG8_BAR;
    PG8_WAIT_V(4); PG8_BAR;
    PG8_STAGE(PG8_SB(1, 0), cB + kstep, voffB); PG8_STAGE(PG8_SA(1, 0), cA + kstep, voffA); PG8_STAGE(PG8_SB(1, 1), cB + hstep + kstep, voffB);
    PG8_WAIT_V(6); PG8_BAR;
    PG8_STAMP();
    for (;;) {
        const bool has_next = S.next(ui + 1, nxt);
        const char* nA = has_next ? (const char*)g.A + (size_t)nxt.pm * tstep : cA; const char* nB = has_next ? (const char*)g.Bt + (size_t)nxt.pn * tstep : cB;
        for (int t = 0; t < nt; t += 2) {
            const bool last = (t == nt - 2);
            const char* a1 = cA + (size_t)(t + 1) * kstep;
            const char* a2 = last ? nA : cA + (size_t)(t + 2) * kstep; const char* b2 = last ? nB : cB + (size_t)(t + 2) * kstep;
            const char* a3 = a2 + kstep; const char* b3 = b2 + kstep;
            if (last && has_next) S.a_ready(nxt);
            PG8_LDB(B0, 0, 0); PG8_SCHED; PG8_LDA(At, 0, 0); PG8_STAGE(PG8_SA(1, 1), a1 + hstep, voffA);
            PG8_WAIT_L(8); PG8_BAR; PG8_WAIT_L(0); PG8_MMA(0, 0, At, B0); PG8_BAR; PG8_SCHED;
            PG8_LDB(B1, 0, 1); PG8_STAGE(PG8_SB(0, 0), b2, voffB);
            PG8_BAR; PG8_WAIT_L(0); PG8_MMA(0, 1, At, B1); PG8_BAR;
            PG8_LDA(At, 0, 1); PG8_STAGE(PG8_SA(0, 0), a2, voffA);
            PG8_BAR; PG8_WAIT_L(0); PG8_MMA(1, 0, At, B0); PG8_BAR; PG8_SCHED;
            PG8_STAGE(PG8_SB(0, 1), b2 + hstep, voffB);
            PG8_WAIT_V(6); PG8_BAR; PG8_MMA(1, 1, At, B1); PG8_BAR;
            PG8_LDB(B0, 1, 0); PG8_SCHED; PG8_LDA(At, 1, 0); PG8_STAGE(PG8_SA(0, 1), a2 + hstep, voffA);
            PG8_WAIT_L(8); PG8_BAR; PG8_WAIT_L(0); PG8_MMA(0, 0, At, B0); PG8_BAR; PG8_SCHED;
            PG8_LDB(B1, 1, 1); PG8_STAGE(PG8_SB(1, 0), b3, voffB);
            PG8_BAR; PG8_WAIT_L(0); PG8_MMA(0, 1, At, B1); PG8_BAR;
            PG8_LDA(At, 1, 1); PG8_STAGE(PG8_SA(1, 0), a3, voffA);
            PG8_BAR; PG8_WAIT_L(0); PG8_MMA(1, 0, At, B0); PG8_BAR; PG8_SCHED;
            PG8_STAGE(PG8_SB(1, 1), b3 + hstep, voffB);
            PG8_WAIT_V(6); PG8_BAR; PG8_MMA(1, 1, At, B1); PG8_BAR;
        }
        PG8_STAMP();
        if constexpr (!Epi::AFTER_DRAIN) { E(acc, cur, wr, wc, fr, fq); S.done(cur); }
        PG8_STAMP();
        if (!has_next) break;
#pragma unroll
        for (int a = 0; a < 2; ++a)
#pragma unroll
            for (int b = 0; b < 2; ++b)
#pragma unroll
                for (int m = 0; m < 4; ++m)
#pragma unroll
                    for (int n = 0; n < 2; ++n) acc[a][b][m][n] = (f32x4){0.f, 0.f, 0.f, 0.f};
        cur = nxt; cA = nA; cB = nB; ++ui;
    }
    PG8_WAIT_V(0);
    if (wr == 0) PG8_BAR;
    PG8_BAR;
    if constexpr (Epi::AFTER_DRAIN) { E.fused(acc, cur, wr, wc, fr, fq, lds, wid, lane); S.done(cur); }
    PG8_STAMP();
    if (STAMP && wid == 0) { stamps[lane] = lane < nts ? (((unsigned long long)(unsigned)ts_hi << 32) | (unsigned)ts_lo) : 0ull;
        if (lane == 62) stamps[62] = rt_entry; if (lane == 63) stamps[63] = (unsigned long long)wall_clock64(); }
#undef PG8_STAMP
#undef PG8_SA
#undef PG8_SB
#undef PG8_STAGE
#undef PG8_LDA
#undef PG8_LDB
#undef PG8_MMA
#undef PG8_WAIT_V
#undef PG8_WAIT_L
#undef PG8_BAR
#undef PG8_SCHED
}
}

#define LAS __attribute__((address_space(3)))
typedef unsigned short bf16;
using pg8::f32x4; using pg8::bf16x8; using pg8::u32x4; using pg8::u32x2; using pg8::cvt_pk_bf16; using pg8::bf_lo; using pg8::bf_hi; using pg8::gelu_tanh;

constexpr int M = 16384, D = 1024, DFF = 2816, PIN = 1792, NL = 4, NCOND = 9216;
constexpr float EPS = 1e-6f;
constexpr size_t MiB = (size_t)1 << 20;
constexpr size_t WS_BAR = 7 * MiB, BAR_BYTES = 32768;
constexpr size_t WS_COND = 0, WS_E = 2 * MiB, WS_W = 8 * MiB, LW = 39 * MiB;
constexpr size_t OW_IN1 = 0, OW_OUT1 = 11 * MiB, OW_MIX = OW_OUT1 + 11 * MiB / 2, OW_MO = OW_MIX + 7 * MiB / 2, OW_IN2 = OW_MO + 2 * MiB, OW_OUT2 = OW_IN2 + 11 * MiB, OW_GLU = OW_OUT2 + 11 * MiB / 2;
static_assert(OW_GLU + 131072 <= LW, "weights per layer");
constexpr size_t WS_H = 164 * MiB, WS_ACT = 196 * MiB, WS_Z = 284 * MiB, WS_YG = 340 * MiB, WS_YCAT = 348 * MiB, WS_SHW = 380 * MiB, WS_SS = 383 * MiB, WS_XB = 384 * MiB, WS_END = 416 * MiB;
constexpr int LDS_BYTES = 147456;
#ifndef SGU_REP
#define SGU_REP 1
#endif
#ifndef S5_REP
#define S5_REP 1
#endif
#ifndef PC_REP
#define PC_REP 1
#endif
#ifndef PREP_REP
#define PREP_REP 1
#endif
#ifndef PREP_TILE_REP
#define PREP_TILE_REP 1
#endif
#ifndef TPROBE
#define TPROBE 0
#endif
#ifndef SLOT_MAP
#define SLOT_MAP 0x87653210ull
#define SLOT_REP 0u
#define NSLOT 8
#endif
constexpr int NPH = 2 + NL * NSLOT;
constexpr int TILES_PER_LAYER = 176 + 88 + 48 + 32 + 176 + 88 + 2;

struct Args { const float* in[30]; float* out; unsigned char* ws; int ph_lo, ph_hi; };
typedef const Args __attribute__((address_space(4)))& ArgsRef;

__device__ __forceinline__ float wave_sum(float v) {
#pragma unroll
    for (int o = 1; o < 64; o <<= 1) v += __shfl_xor(v, o);
    return v;
}
#define LDS_WAIT() asm volatile("s_waitcnt lgkmcnt(0)" ::: "memory")

struct TileDesc { const float* W; bf16* WT; int K, N, k0, n0, swiglu; };
__device__ __forceinline__ TileDesc tile_decode(ArgsRef a, int item) {
    const int l = item / TILES_PER_LAYER; int r = item % TILES_PER_LAYER;
    unsigned char* wl = a.ws + WS_W + (size_t)l * LW; TileDesc t;
    if (r < 176) t = TileDesc{a.in[5] + (size_t)l * 1024 * 5632, (bf16*)(wl + OW_IN1), 1024, 5632, 128 * (r / 22), 256 * (r % 22), 1};
    else if ((r -= 176) < 88) t = TileDesc{a.in[6] + (size_t)l * DFF * 1024, (bf16*)(wl + OW_OUT1), DFF, 1024, 128 * (r / 4), 256 * (r % 4), 0};
    else if ((r -= 88) < 48) { const int nb = r % 6; t = TileDesc{a.in[8] + (size_t)l * 1024 * PIN, (bf16*)(wl + OW_MIX), 1024, PIN, 128 * (r / 6), 256 * (nb < 2 ? nb : nb + 1), 0}; }
    else if ((r -= 48) < 32) t = TileDesc{a.in[25] + (size_t)l * 1024 * 1024, (bf16*)(wl + OW_MO), 1024, 1024, 128 * (r / 4), 256 * (r % 4), 0};
    else if ((r -= 32) < 176) t = TileDesc{a.in[27] + (size_t)l * 1024 * 5632, (bf16*)(wl + OW_IN2), 1024, 5632, 128 * (r / 22), 256 * (r % 22), 1};
    else if ((r -= 176) < 88) t = TileDesc{a.in[28] + (size_t)l * DFF * 1024, (bf16*)(wl + OW_OUT2), DFF, 1024, 128 * (r / 4), 256 * (r % 4), 0};
    else { r -= 88; t = TileDesc{a.in[22] + (size_t)l * 65536, (bf16*)(wl + OW_GLU), 256, 256, 128 * r, 0, 0}; }
    return t;
}
__device__ __forceinline__ void tile_load(const TileDesc& t, float (&v)[16][4], int wave, int lane) {
    const float* wp = t.W + (size_t)(t.k0 + 16 * wave) * t.N + t.n0 + lane;
#pragma unroll
    for (int r = 0; r < 16; ++r)
#pragma unroll
        for (int e = 0; e < 4; ++e) v[r][e] = __builtin_nontemporal_load(wp + (size_t)r * t.N + 64 * e);
}
__device__ __forceinline__ void tile_to_lds(const float (&v)[16][4], LAS unsigned char* lds, int wave, int lane) {
#pragma unroll
    for (int e = 0; e < 4; ++e)
#pragma unroll
        for (int hq = 0; hq < 2; ++hq) { u32x4 o; o.x = cvt_pk_bf16(v[8 * hq][e], v[8 * hq + 1][e]); o.y = cvt_pk_bf16(v[8 * hq + 2][e], v[8 * hq + 3][e]); o.z = cvt_pk_bf16(v[8 * hq + 4][e], v[8 * hq + 5][e]); o.w = cvt_pk_bf16(v[8 * hq + 6][e], v[8 * hq + 7][e]);
            *(LAS u32x4*)(lds + (lane + 64 * e) * 272 + (16 * wave + 8 * hq) * 2) = o; }
}
__device__ __forceinline__ void tile_store(const TileDesc& t, LAS unsigned char* lds, int wave, int lane) {
#pragma unroll
    for (int j = 0; j < 8; ++j) { const int nl = 32 * wave + 4 * j + (lane >> 4), n = t.n0 + nl;
        const u32x4 o = *(const LAS u32x4*)(lds + nl * 272 + 16 * (lane & 15));
        const int dsw = n < DFF ? (n >> 7) * 256 + (n & 127) : ((n - DFF) >> 7) * 256 + 128 + ((n - DFF) & 127);
        const int dst = t.swiglu ? dsw : n;
        *(u32x4*)(t.WT + (size_t)dst * t.K + t.k0 + 8 * (lane & 15)) = o; }
}

__device__ __forceinline__ void prep_phase(ArgsRef a, LAS unsigned char* lds, int tid, int wave, int lane, int G) {
    LAS float* sc = (LAS float*)lds;
    LAS float* R = (LAS float*)(lds + 32768);
    float* cond = (float*)(a.ws + WS_COND);
    const bool cond_blk = (G >= 256) ? (blockIdx.x < 144) : true;
    if (cond_blk) {
        const float* c_in = a.in[1];
        for (int i = tid; i < 8 * 1024; i += 512) { const float v = c_in[i]; sc[i] = v / (1.0f + expf(-v)); }
        __syncthreads();
        for (int it = blockIdx.x; it < NL * 36; it += (G >= 256 ? 144 : G)) {
            const int l = it / 36, n0 = 256 * (it % 36);
            const float* wp = a.in[2] + ((size_t)l * 1024 + 128 * wave) * NCOND + n0 + 4 * lane;
            f32x4 acc[8];
#pragma unroll
            for (int b = 0; b < 8; ++b) acc[b] = (f32x4){0.f, 0.f, 0.f, 0.f};
            f32x4 wv[8], wn[8];
#pragma unroll
            for (int kk = 0; kk < 8; ++kk) wv[kk] = __builtin_nontemporal_load((const f32x4*)(wp + (size_t)kk * NCOND));
            for (int k0 = 0; k0 < 128; k0 += 8) {
                if (k0 + 8 < 128) {
#pragma unroll
                    for (int kk = 0; kk < 8; ++kk) wn[kk] = __builtin_nontemporal_load((const f32x4*)(wp + (size_t)(k0 + 8 + kk) * NCOND));
                }
#pragma unroll
                for (int q = 0; q < 2; ++q)
#pragma unroll
                    for (int b = 0; b < 8; ++b) { const f32x4 s4 = *(const LAS f32x4*)(sc + b * 1024 + 128 * wave + k0 + 4 * q);
#pragma unroll
                        for (int e = 0; e < 4; ++e) acc[b] += wv[4 * q + e] * s4[e]; }
#pragma unroll
                for (int kk = 0; kk < 8; ++kk) wv[kk] = wn[kk];
            }
#pragma unroll
            for (int b = 0; b < 8; ++b) *(LAS f32x4*)(R + (wave * 8 + b) * 256 + 4 * lane) = acc[b];
            __syncthreads();
            { const int b = wave; f32x4 s = *(const f32x4*)(a.in[3] + (size_t)l * NCOND + n0 + 4 * lane);
#pragma unroll
              for (int w = 0; w < 8; ++w) s += *(const LAS f32x4*)(R + (w * 8 + b) * 256 + 4 * lane);
              *(f32x4*)(cond + ((size_t)l * 8 + b) * NCOND + n0 + 4 * lane) = s; }
            __syncthreads();
        }
    }
    int first, stride, count;
    if (G >= 256) { if (blockIdx.x < 144) { first = blockIdx.x * 7; stride = 1; count = 7; } else { count = (NL * TILES_PER_LAYER - 1008 + (G - 144) - 1) / (G - 144); first = 1008 + (blockIdx.x - 144) * count; stride = 1; } }
    else { first = blockIdx.x; stride = G; count = (NL * TILES_PER_LAYER + G - 1) / G; }
    for (int rp = 0; rp < PREP_TILE_REP; ++rp)
    {
        int lim = NL * TILES_PER_LAYER; if (G >= 256 && blockIdx.x < 144) lim = 1008;
        int nt = 0; for (int j = 0; j < count; ++j) if (first + j * stride < lim) nt = j + 1;
        float v[16][4];
        TileDesc cur = tile_decode(a, nt > 0 ? first : 0);
        if (nt > 0) tile_load(cur, v, wave, lane);
        for (int j = 0; j < nt; ++j) {
            tile_to_lds(v, lds, wave, lane);
            TileDesc nxt = cur;
            if (j + 1 < nt) { nxt = tile_decode(a, first + (j + 1) * stride); tile_load(nxt, v, wave, lane); }
            __syncthreads();
            tile_store(cur, lds, wave, lane);
            __syncthreads();
            cur = nxt;
        }
    }
    const int gw = blockIdx.x * 8 + wave, NGW = G * 8;
    LAS float* F = (LAS float*)(lds + wave * 2048);
    for (int item = gw; item < NL * 512; item += NGW) {
        const int l = item >> 9, r = item & 511, kb = r >> 5, n8 = r & 31, g = n8 >> 3, d0 = 8 * (n8 & 7), k = 64 * kb + lane;
        unsigned char* wl = a.ws + WS_W + (size_t)l * LW;
        const float* pw = a.in[11] + (size_t)(l * 4 + g) * 4096 + (size_t)lane * 64 + d0;
        const f32x4 p0 = *(const f32x4*)pw, p1 = *(const f32x4*)(pw + 4);
        const float* wr = a.in[8] + ((size_t)l * 1024 + k) * PIN + 512 + 64 * g;
        f32x4 wrow[16];
#pragma unroll
        for (int j = 0; j < 16; ++j) wrow[j] = *(const f32x4*)(wr + 4 * j);
        const float* ps = a.in[12] + (size_t)l * 256 + 64 * g + d0;
        const f32x4 s0 = *(const f32x4*)ps, s1 = *(const f32x4*)(ps + 4);
        *(LAS f32x4*)(F + lane * 8) = p0; *(LAS f32x4*)(F + lane * 8 + 4) = p1;
        LDS_WAIT();
        f32x4 a0 = (f32x4){0.f, 0.f, 0.f, 0.f}, a1 = a0;
#pragma unroll
        for (int j = 0; j < 16; ++j)
#pragma unroll
            for (int e = 0; e < 4; ++e) { const int c = 4 * j + e; const f32x4 f0 = *(const LAS f32x4*)(F + c * 8), f1 = *(const LAS f32x4*)(F + c * 8 + 4);
                a0 += f0 * wrow[j][e]; a1 += f1 * wrow[j][e]; }
        a0 = a0 * s0; a1 = a1 * s1;
        bf16* WT = (bf16*)(wl + OW_MIX) + (size_t)(512 + 64 * g + d0) * 1024 + k;
#pragma unroll
        for (int i = 0; i < 4; ++i) { WT[(size_t)i * 1024] = (bf16)(cvt_pk_bf16(a0[i], 0.f) & 0xffffu); WT[(size_t)(4 + i) * 1024] = (bf16)(cvt_pk_bf16(a1[i], 0.f) & 0xffffu); }
        LDS_WAIT();
    }
}

__device__ __forceinline__ void norm_phase(const float* x, const float* g, const float* sh, const float* scl, bf16* h, bf16* xb, int gw, int NGW, int lane) {
    for (int row0 = 2 * gw; row0 < M; row0 += 2 * NGW) {
        f32x4 v[2][4]; float s[2];
#pragma unroll
        for (int r = 0; r < 2; ++r) { const f32x4* xr = (const f32x4*)(x + (size_t)(row0 + r) * D) + lane;
#pragma unroll
            for (int j = 0; j < 4; ++j) v[r][j] = xr[64 * j]; }
#pragma unroll
        for (int r = 0; r < 2; ++r) { float q = 0.f;
#pragma unroll
            for (int j = 0; j < 4; ++j) q += (v[r][j][0] * v[r][j][0] + v[r][j][1] * v[r][j][1]) + (v[r][j][2] * v[r][j][2] + v[r][j][3] * v[r][j][3]);
            s[r] = q; }
        s[0] = wave_sum(s[0]); s[1] = wave_sum(s[1]);
        const size_t cb = (size_t)(row0 >> 11) * NCOND;
#pragma unroll
        for (int j = 0; j < 4; ++j) { const int col = 4 * lane + 256 * j;
            const f32x4 gg = *(const f32x4*)(g + col) * (*(const f32x4*)(scl + cb + col) + 1.0f), hh = *(const f32x4*)(sh + cb + col);
#pragma unroll
            for (int r = 0; r < 2; ++r) { const float rstd = 1.0f / sqrtf(s[r] * (1.0f / D) + EPS);
                const f32x4 y = (v[r][j] * rstd) * gg + hh;
                u32x2 w; w.x = cvt_pk_bf16(y[0], y[1]); w.y = cvt_pk_bf16(y[2], y[3]); ((u32x2*)(h + (size_t)(row0 + r) * D) + lane)[64 * j] = w;
                u32x2 wx; wx.x = cvt_pk_bf16(v[r][j][0], v[r][j][1]); wx.y = cvt_pk_bf16(v[r][j][2], v[r][j][3]); ((u32x2*)(xb + (size_t)(row0 + r) * D) + lane)[64 * j] = wx; } }
    }
}
__device__ __forceinline__ void final_norm_phase(float* x, const float* g, int gw, int NGW, int lane) {
    for (int row = gw; row < M; row += NGW) {
        f32x4* xr = (f32x4*)(x + (size_t)row * D) + lane;
        f32x4 v[4]; float s = 0.f;
#pragma unroll
        for (int j = 0; j < 4; ++j) { v[j] = xr[64 * j]; s += (v[j][0] * v[j][0] + v[j][1] * v[j][1]) + (v[j][2] * v[j][2] + v[j][3] * v[j][3]); }
        const float rstd = 1.0f / sqrtf(wave_sum(s) * (1.0f / D) + EPS);
#pragma unroll
        for (int j = 0; j < 4; ++j) { const f32x4 gg = *(const f32x4*)(g + 4 * lane + 256 * j); xr[64 * j] = v[j] * rstd * gg; }
    }
}

__device__ __forceinline__ f32x4 ld4bf(const bf16* p) { const u32x2 w = *(const u32x2*)p; return (f32x4){bf_lo(w.x), bf_hi(w.x), bf_lo(w.y), bf_hi(w.y)}; }
__device__ __forceinline__ void st4bf(bf16* p, f32x4 v) { u32x2 w; w.x = cvt_pk_bf16(v[0], v[1]); w.y = cvt_pk_bf16(v[2], v[3]); *(u32x2*)p = w; }
__device__ __forceinline__ bf16x8 pack8(f32x4 lo, f32x4 hi) { u32x4 w; w.x = cvt_pk_bf16(lo[0], lo[1]); w.y = cvt_pk_bf16(lo[2], lo[3]); w.z = cvt_pk_bf16(hi[0], hi[1]); w.w = cvt_pk_bf16(hi[2], hi[3]); return __builtin_bit_cast(bf16x8, w); }

__device__ __forceinline__ void sgu_item(ArgsRef a, int l, int it, LAS unsigned char* lds, int tid, int wave, int lane) {
    const bf16* z = (const bf16*)(a.ws + WS_Z); bf16* ycat = (bf16*)(a.ws + WS_YCAT);
    LAS bf16* vT = (LAS bf16*)lds;
    const int tok0 = it * 128;
    { const int s = tid >> 2, q = tid & 3;
      u32x4 raw[4][2];
#pragma unroll
      for (int h = 0; h < 4; ++h) { const u32x4* zp = (const u32x4*)(z + (size_t)(tok0 + s) * PIN + 256 + 64 * h + 16 * q); raw[h][0] = zp[0]; raw[h][1] = zp[1]; }
#pragma unroll
      for (int h = 0; h < 4; ++h) {
          float v[16]; float sum = 0.f;
#pragma unroll
          for (int j = 0; j < 2; ++j) { const u32x4 rw = raw[h][j]; const unsigned ww[4] = {rw.x, rw.y, rw.z, rw.w};
#pragma unroll
              for (int e = 0; e < 4; ++e) { v[8 * j + 2 * e] = gelu_tanh(bf_lo(ww[e])); v[8 * j + 2 * e + 1] = gelu_tanh(bf_hi(ww[e])); sum += v[8 * j + 2 * e] + v[8 * j + 2 * e + 1]; } }
          sum += __shfl_xor(sum, 1); sum += __shfl_xor(sum, 2);
          const float mu = sum * (1.0f / 64.0f); float q2 = 0.f;
#pragma unroll
          for (int e = 0; e < 16; ++e) { v[e] -= mu; q2 += v[e] * v[e]; }
          q2 += __shfl_xor(q2, 1); q2 += __shfl_xor(q2, 2);
          const float rs = 1.0f / sqrtf(q2 * (1.0f / 64.0f) + EPS);
#pragma unroll
          for (int e = 0; e < 16; ++e) vT[(64 * h + 16 * q + e) * 136 + s] = (bf16)(cvt_pk_bf16(v[e] * rs, 0.f) & 0xffffu);
      } }
    __syncthreads();
    const int fr = lane & 15, fq = lane >> 4, t = 16 * wave + fr, nks = (wave >> 1) + 1;
    f32x4 acc[16];
#pragma unroll
    for (int i = 0; i < 16; ++i) acc[i] = (f32x4){0.f, 0.f, 0.f, 0.f};
    {
        const float* wbase = a.in[9] + ((size_t)(l * 4) * 128 + t) * 128 + 8 * fq;
        f32x4 wq[2][4][2];
#pragma unroll
        for (int ks = 0; ks < 4; ++ks) { wq[0][ks][0] = (f32x4){0.f, 0.f, 0.f, 0.f}; wq[0][ks][1] = wq[0][ks][0];
            if (ks < nks) { wq[0][ks][0] = *(const f32x4*)(wbase + 32 * ks); wq[0][ks][1] = *(const f32x4*)(wbase + 32 * ks + 4); } }
#pragma unroll
        for (int h = 0; h < 4; ++h) {
            if (h < 3) {
#pragma unroll
                for (int ks = 0; ks < 4; ++ks) { wq[(h + 1) & 1][ks][0] = (f32x4){0.f, 0.f, 0.f, 0.f}; wq[(h + 1) & 1][ks][1] = wq[(h + 1) & 1][ks][0];
                    if (ks < nks) { wq[(h + 1) & 1][ks][0] = *(const f32x4*)(wbase + (size_t)(h + 1) * 16384 + 32 * ks); wq[(h + 1) & 1][ks][1] = *(const f32x4*)(wbase + (size_t)(h + 1) * 16384 + 32 * ks + 4); } }
            }
#pragma unroll
            for (int ks = 0; ks < 4; ++ks) if (ks < nks) {
                f32x4 w0 = wq[h & 1][ks][0], w1 = wq[h & 1][ks][1];
                const int s0 = 32 * ks + 8 * fq;
#pragma unroll
                for (int e = 0; e < 4; ++e) { if (s0 + e > t) w0[e] = 0.f; if (s0 + 4 + e > t) w1[e] = 0.f; }
                const bf16x8 wf = pack8(w0, w1);
#pragma unroll
                for (int dt = 0; dt < 4; ++dt) { const bf16x8 vf = *(const LAS bf16x8*)(vT + (64 * h + 16 * dt + fr) * 136 + 32 * ks + 8 * fq);
                    acc[h * 4 + dt] = __builtin_amdgcn_mfma_f32_16x16x32_bf16(vf, wf, acc[h * 4 + dt], 0, 0, 0); }
            }
        }
    }
    const size_t tok = (size_t)tok0 + t; float ss = 0.f;
#pragma unroll
    for (int h = 0; h < 4; ++h) { const float bias = a.in[10][(size_t)(l * 4 + h) * 128 + t];
#pragma unroll
        for (int dt = 0; dt < 4; ++dt) { const f32x4 u4 = ld4bf(z + tok * PIN + 64 * h + 16 * dt + 4 * fq); f32x4 o;
#pragma unroll
            for (int e = 0; e < 4; ++e) { o[e] = gelu_tanh(u4[e]) * (acc[h * 4 + dt][e] + bias); ss += o[e] * o[e]; }
            acc[h * 4 + dt] = o; } }
    ss += __shfl_xor(ss, 16); ss += __shfl_xor(ss, 32);
    const float rstd = 1.0f / sqrtf(ss * (1.0f / 256.0f) + EPS);
    const float* gn = a.in[24] + (size_t)l * 1024;
#pragma unroll
    for (int h = 0; h < 4; ++h)
#pragma unroll
        for (int dt = 0; dt < 4; ++dt) { const int ch = 64 * h + 16 * dt + 4 * fq; const f32x4 gg = *(const f32x4*)(gn + ch);
            st4bf(ycat + tok * 1024 + ch, acc[h * 4 + dt] * rstd * gg); }
    __syncthreads();
}

__device__ __forceinline__ void sincos_red(float ang, float& sn, float& cs) {
    const float n = rintf(ang * 0.15915494309189535f);
    float r = fmaf(-n, 6.2831854820251465f, ang); r = fmaf(-n, -1.7484556e-7f, r);
    const float h = 0.5f * r, h2 = h * h;
    const float s = h * (1.0f + h2 * (-1.6666667e-1f + h2 * (8.3333333e-3f + h2 * (-1.9841270e-4f + h2 * (2.7557319e-6f + h2 * (-2.5052108e-8f))))));
    const float c = 1.0f + h2 * (-0.5f + h2 * (4.1666667e-2f + h2 * (-1.3888889e-3f + h2 * (2.4801587e-5f + h2 * (-2.7557319e-7f + h2 * 2.0876757e-9f)))));
    sn = 2.0f * s * c; cs = 1.0f - 2.0f * s * s;
}

template <int PASS>
__device__ __forceinline__ void s5_span(const bf16* zu, bf16* ygp, LAS float* BU, LAS bf16* Xs, const bf16x8 (&bfrag)[8], const bf16x8 (&cf)[4], f32x4 dd, float are, float aim, float& xr, float& xi, int lane) {
    const int p = lane, fr = lane & 15, fq = lane >> 4;
    bf16x8 uf_n = (bf16x8){0, 0, 0, 0, 0, 0, 0, 0}; u32x2 u4_n = (u32x2){0u, 0u};
    if (fq < 2) uf_n = *(const bf16x8*)(zu + 8 * fq);
    if (PASS == 2) u4_n = *(const u32x2*)(zu + 4 * fq);
    for (int blk = 0; blk < 16; ++blk) {
        const bf16x8 uf = uf_n; const u32x2 u4w = u4_n;
        if (blk < 15) { const bf16* zn = zu + (size_t)(16 * (blk + 1)) * PIN;
            if (fq < 2) uf_n = *(const bf16x8*)(zn + 8 * fq);
            if (PASS == 2) u4_n = *(const u32x2*)(zn + 4 * fq); }
#pragma unroll
        for (int n = 0; n < 8; ++n) { const f32x4 acc = __builtin_amdgcn_mfma_f32_16x16x32_bf16(bfrag[n], uf, (f32x4){0.f, 0.f, 0.f, 0.f}, 0, 0, 0);
            *(LAS f32x4*)(BU + fr * 132 + 16 * n + 4 * fq) = acc; }
        LDS_WAIT();
#pragma unroll
        for (int t = 0; t < 16; ++t) { const float bur = BU[t * 132 + p], bui = BU[t * 132 + 64 + p];
            const float tr = are * xr - aim * xi + bur, ti = are * xi + aim * xr + bui; xr = tr; xi = ti;
            if (PASS == 2) { const unsigned w = cvt_pk_bf16(xr, xi); Xs[t * 136 + p] = (bf16)(w & 0xffffu); Xs[t * 136 + 64 + p] = (bf16)(w >> 16); } }
        if (PASS == 2) {
            LDS_WAIT();
            f32x4 acc = (f32x4){0.f, 0.f, 0.f, 0.f};
#pragma unroll
            for (int ks = 0; ks < 4; ++ks) { const bf16x8 xf = *(const LAS bf16x8*)(Xs + fr * 136 + 32 * ks + 8 * fq);
                acc = __builtin_amdgcn_mfma_f32_16x16x32_bf16(cf[ks], xf, acc, 0, 0, 0); }
            const f32x4 u4 = (f32x4){bf_lo(u4w.x), bf_hi(u4w.x), bf_lo(u4w.y), bf_hi(u4w.y)}; f32x4 y;
#pragma unroll
            for (int e = 0; e < 4; ++e) y[e] = gelu_tanh(acc[e] + dd[e] * u4[e]);
            st4bf(ygp + (size_t)(16 * blk) * 256, y);
        }
        asm volatile("s_waitcnt lgkmcnt(0)" ::: );
    }
}
__device__ __forceinline__ void s5_wg_item(ArgsRef a, int l, int bi, LAS unsigned char* lds, int wave, int lane) {
    const int g = bi & 15, b = bi >> 4, p = lane, fr = lane & 15, fq = lane >> 4;
    const bf16* z = (const bf16*)(a.ws + WS_Z);
    const int lg = l * 16 + g;
    const float dt = expf(a.in[21][lg]);
    const float lre = a.in[14][(size_t)lg * 64 + p], lim = a.in[15][(size_t)lg * 64 + p];
    const float mag = expf(lre * dt); float sn, cs; sincos_red(lim * dt, sn, cs);
    const float are = mag * cs, aim = mag * sn, nr = are - 1.0f, ni = aim, den = lre * lre + lim * lim;
    const float kre = (nr * lre + ni * lim) / den, kim = (ni * lre - nr * lim) / den;
    bf16x8 bfrag[8];
#pragma unroll
    for (int nn = 0; nn < 4; ++nn) { const int pp = 16 * nn + fr; const float kr = __shfl(kre, pp), ki = __shfl(kim, pp);
        const float* brp = a.in[16] + ((size_t)lg * 64 + pp) * 16 + 8 * (fq & 1); const float* bip = a.in[17] + ((size_t)lg * 64 + pp) * 16 + 8 * (fq & 1);
        const f32x4 br0 = *(const f32x4*)brp, br1 = *(const f32x4*)(brp + 4), bi0 = *(const f32x4*)bip, bi1 = *(const f32x4*)(bip + 4);
        bf16x8 fre = pack8(br0 * kr - bi0 * ki, br1 * kr - bi1 * ki), fim = pack8(bi0 * kr + br0 * ki, bi1 * kr + br1 * ki);
        if (fq >= 2) { fre = (bf16x8){0, 0, 0, 0, 0, 0, 0, 0}; fim = fre; }
        bfrag[nn] = fre; bfrag[nn + 4] = fim; }
    const size_t tok0 = (size_t)b * 2048 + 256 * wave;
    const bf16* zu = z + (tok0 + fr) * PIN + 1536 + 16 * g;
    bf16* ygp = (bf16*)(a.ws + WS_YG) + (tok0 + fr) * 256 + 16 * g + 4 * fq;
    LAS float* BU = (LAS float*)(lds + wave * 12800);
    LAS bf16* Xs = (LAS bf16*)(lds + wave * 12800 + 8448);
    LAS float* EX = (LAS float*)(lds + 102400);
    bf16x8 cf[4]; f32x4 dd = (f32x4){0.f, 0.f, 0.f, 0.f};
#pragma unroll
    for (int ks = 0; ks < 4; ++ks) cf[ks] = (bf16x8){0, 0, 0, 0, 0, 0, 0, 0};
    float xr = 0.f, xi = 0.f;
    s5_span<1>(zu, ygp, BU, Xs, bfrag, cf, dd, are, aim, xr, xi, lane);
    EX[wave * 128 + p] = xr; EX[wave * 128 + 64 + p] = xi;
    __syncthreads();
    {   float Ar = are, Ai = aim;
#pragma unroll
        for (int q = 0; q < 8; ++q) { const float tr = Ar * Ar - Ai * Ai, ti = 2.0f * Ar * Ai; Ar = tr; Ai = ti; }
        xr = 0.f; xi = 0.f;
#pragma unroll
        for (int w = 0; w < 7; ++w) if (w < wave) { const float er = EX[w * 128 + p], ei = EX[w * 128 + 64 + p];
            const float tr = Ar * xr - Ai * xi + er, ti = Ar * xi + Ai * xr + ei; xr = tr; xi = ti; }
    }
#pragma unroll
    for (int ks = 0; ks < 4; ++ks) { const float* cp = (ks < 2 ? a.in[18] : a.in[19]) + ((size_t)lg * 16 + fr) * 64 + 32 * (ks & 1) + 8 * fq;
        f32x4 c0 = *(const f32x4*)cp, c1 = *(const f32x4*)(cp + 4); if (ks >= 2) { c0 = -c0; c1 = -c1; } cf[ks] = pack8(c0, c1); }
    dd = *(const f32x4*)(a.in[20] + (size_t)l * 256 + 16 * g + 4 * fq);
    s5_span<2>(zu, ygp, BU, Xs, bfrag, cf, dd, are, aim, xr, xi, lane);
    __syncthreads();
}

__device__ __forceinline__ void poolconv_item(ArgsRef a, int l, int idx, int lane) {
    const bf16* z = (const bf16*)(a.ws + WS_Z); bf16* ycat = (bf16*)(a.ws + WS_YCAT);
    const int tokb = idx * 8, pos0 = tokb & 2047, ch = 4 * lane, gq = lane >> 4, wq = 2 << gq;
    const float m1 = gq >= 1 ? 1.0f : 0.0f, m2 = gq >= 2 ? 1.0f : 0.0f, m3 = gq >= 3 ? 1.0f : 0.0f;
    const float* gn = a.in[24] + (size_t)l * 1024;
    {   f32x4 row[23];
        const bf16* zp = z + (size_t)tokb * PIN + 512 + ch;
#pragma unroll
        for (int r = 0; r < 23; ++r) { row[r] = (f32x4){0.f, 0.f, 0.f, 0.f}; if (pos0 - 15 + r >= 0) row[r] = ld4bf(zp + (ptrdiff_t)(r - 15) * PIN); }
        const f32x4 gg = *(const f32x4*)(gn + 256 + ch);
#pragma unroll
        for (int tt = 0; tt < 8; ++tt) {
            f32x4 sum = row[15 + tt] + row[14 + tt];
            sum += (row[13 + tt] + row[12 + tt]) * m1;
            sum += ((row[11 + tt] + row[10 + tt]) + (row[9 + tt] + row[8 + tt])) * m2;
            sum += (((row[7 + tt] + row[6 + tt]) + (row[5 + tt] + row[4 + tt])) + ((row[3 + tt] + row[2 + tt]) + (row[1 + tt] + row[tt]))) * m3;
            const int pos = pos0 + tt, cnt = (pos + 1 < wq) ? pos + 1 : wq;
            const f32x4 o = sum * (1.0f / (float)cnt) - row[15 + tt];
            const float ss = wave_sum((o[0] * o[0] + o[1] * o[1]) + (o[2] * o[2] + o[3] * o[3]));
            const float rstd = 1.0f / sqrtf(ss * (1.0f / 256.0f) + EPS);
            st4bf(ycat + (size_t)(tokb + tt) * 1024 + 256 + ch, o * rstd * gg); }
    }
    {   f32x4 prod[10], bg[8];
        const bf16* zp = z + (size_t)tokb * PIN + 768 + ch;
#pragma unroll
        for (int r = 0; r < 10; ++r) { prod[r] = (f32x4){0.f, 0.f, 0.f, 0.f}; if (pos0 - 2 + r >= 0) prod[r] = ld4bf(zp + (ptrdiff_t)(r - 2) * PIN + 256) * ld4bf(zp + (ptrdiff_t)(r - 2) * PIN + 512); }
#pragma unroll
        for (int tt = 0; tt < 8; ++tt) bg[tt] = ld4bf(zp + (size_t)tt * PIN);
        const f32x4 w0 = *(const f32x4*)(a.in[13] + ((size_t)l * 3 + 0) * 256 + ch), w1 = *(const f32x4*)(a.in[13] + ((size_t)l * 3 + 1) * 256 + ch), w2 = *(const f32x4*)(a.in[13] + ((size_t)l * 3 + 2) * 256 + ch);
        const f32x4 gg = *(const f32x4*)(gn + 512 + ch);
#pragma unroll
        for (int tt = 0; tt < 8; ++tt) {
            const f32x4 o = bg[tt] * (w0 * prod[tt] + w1 * prod[tt + 1] + w2 * prod[tt + 2]);
            const float ss = wave_sum((o[0] * o[0] + o[1] * o[1]) + (o[2] * o[2] + o[3] * o[3]));
            const float rstd = 1.0f / sqrtf(ss * (1.0f / 256.0f) + EPS);
            st4bf(ycat + (size_t)(tokb + tt) * 1024 + 512 + ch, o * rstd * gg); }
    }
}

__device__ __forceinline__ void glu_item(ArgsRef a, int l, int it, LAS unsigned char* lds, int tid, int wave, int lane) {
    const bf16* yg = (const bf16*)(a.ws + WS_YG) + (size_t)it * 64 * 256; bf16* ycat = (bf16*)(a.ws + WS_YCAT) + (size_t)it * 64 * 1024 + 768;
    const bf16* Bt = (const bf16*)(a.ws + WS_W + (size_t)l * LW + OW_GLU);
    LAS unsigned char* T = lds;
    LAS float* P = (LAS float*)(lds + 34816);
    const int fr = lane & 15, fq = lane >> 4, n0 = 32 * wave;
    u32x4 st[4];
#pragma unroll
    for (int j = 0; j < 4; ++j) { const int idx = tid + 512 * j; st[j] = *(const u32x4*)(yg + (size_t)(idx >> 5) * 256 + 8 * (idx & 31)); }
    bf16x8 bfr[2][8];
#pragma unroll
    for (int nt = 0; nt < 2; ++nt)
#pragma unroll
        for (int ks = 0; ks < 8; ++ks) bfr[nt][ks] = *(const bf16x8*)(Bt + (size_t)(n0 + 16 * nt + fr) * 256 + 32 * ks + 8 * fq);
#pragma unroll
    for (int j = 0; j < 4; ++j) { const int idx = tid + 512 * j; *(LAS u32x4*)(T + (idx >> 5) * 528 + 16 * (idx & 31)) = st[j]; }
    __syncthreads();
    f32x4 acc[4][2];
#pragma unroll
    for (int tt = 0; tt < 4; ++tt) { acc[tt][0] = (f32x4){0.f, 0.f, 0.f, 0.f}; acc[tt][1] = acc[tt][0]; }
#pragma unroll
    for (int ks = 0; ks < 8; ++ks)
#pragma unroll
        for (int tt = 0; tt < 4; ++tt) { const bf16x8 af = *(const LAS bf16x8*)(T + (16 * tt + fr) * 528 + (32 * ks + 8 * fq) * 2);
            acc[tt][0] = __builtin_amdgcn_mfma_f32_16x16x32_bf16(bfr[0][ks], af, acc[tt][0], 0, 0, 0);
            acc[tt][1] = __builtin_amdgcn_mfma_f32_16x16x32_bf16(bfr[1][ks], af, acc[tt][1], 0, 0, 0); }
    const f32x4 gb0 = *(const f32x4*)(a.in[23] + (size_t)l * 256 + n0 + 4 * fq), gb1 = *(const f32x4*)(a.in[23] + (size_t)l * 256 + n0 + 16 + 4 * fq);
#pragma unroll
    for (int tt = 0; tt < 4; ++tt) { float ss = 0.f;
#pragma unroll
        for (int nt = 0; nt < 2; ++nt) { const u32x2 yw = *(const LAS u32x2*)(T + (16 * tt + fr) * 528 + (n0 + 16 * nt + 4 * fq) * 2);
            const f32x4 y = (f32x4){bf_lo(yw.x), bf_hi(yw.x), bf_lo(yw.y), bf_hi(yw.y)}; const f32x4 g4 = nt ? gb1 : gb0; f32x4 o;
#pragma unroll
            for (int e = 0; e < 4; ++e) { o[e] = y[e] * pg8::sigmoid_f(acc[tt][nt][e] + g4[e]); ss += o[e] * o[e]; }
            acc[tt][nt] = o; }
        ss += __shfl_xor(ss, 16); ss += __shfl_xor(ss, 32);
        if (fq == 0) P[(16 * tt + fr) * 8 + wave] = ss; }
    __syncthreads();
    const float* gn = a.in[24] + (size_t)l * 1024 + 768;
    const f32x4 gg0 = *(const f32x4*)(gn + n0 + 4 * fq), gg1 = *(const f32x4*)(gn + n0 + 16 + 4 * fq);
#pragma unroll
    for (int tt = 0; tt < 4; ++tt) { const int t = 16 * tt + fr; const f32x4 p0 = *(const LAS f32x4*)(P + t * 8), p1 = *(const LAS f32x4*)(P + t * 8 + 4);
        const float rstd = __builtin_amdgcn_rsqf((((p0[0] + p0[1]) + (p0[2] + p0[3])) + ((p1[0] + p1[1]) + (p1[2] + p1[3]))) * (1.0f / 256.0f) + EPS);
        st4bf(ycat + (size_t)t * 1024 + n0 + 4 * fq, acc[tt][0] * rstd * gg0); st4bf(ycat + (size_t)t * 1024 + n0 + 16 + 4 * fq, acc[tt][1] * rstd * gg1); }
    __syncthreads();
}

#define XB_TMO      128
#define XB_XCNT(j)  (256  + 64 * (j))
#define XB_XSUB(j)  (1280 + 64 * (j))
#define XB_XGEN(j)  (2304 + 64 * (j))
#define XB_TOP      3328
#define XB_TOPGEN   3392
#define XCD_BAR_WORDS 3456
#define XB_SPIN_CAP (1u << 18)

__device__ __forceinline__ unsigned xb_ld(unsigned* p)              { return __hip_atomic_load(p, __ATOMIC_RELAXED, __HIP_MEMORY_SCOPE_AGENT); }
__device__ __forceinline__ unsigned xb_add(unsigned* p, unsigned v) { return __hip_atomic_fetch_add(p, v, __ATOMIC_RELAXED, __HIP_MEMORY_SCOPE_AGENT); }
__device__ __forceinline__ unsigned xb_xcc_id() { return (unsigned)__builtin_amdgcn_s_getreg((3 << 11) | 20) & 0xFu; }
#define XB_SPIN(cond, bar) do { unsigned _sp = 0; while (cond) { __builtin_amdgcn_s_sleep(1); \
    if ((++_sp & 255u) == 0u) { if (xb_ld(&(bar)[XB_TMO])) break; if (_sp > XB_SPIN_CAP) { atomicAdd(&(bar)[XB_TMO], 1u); break; } } } } while (0)

struct XcdBarrier {
    unsigned* bar; unsigned x;
    volatile LAS unsigned* st;
};

__device__ __forceinline__ XcdBarrier xcd_barrier_post(unsigned* bar, volatile LAS unsigned* st) {
    XcdBarrier b; b.bar = bar; b.x = xb_xcc_id(); b.st = st;
    if (threadIdx.x == 0) (void)xb_add(&bar[XB_XCNT(b.x)], 1u);
    return b;
}
__device__ __forceinline__ void xcd_barrier_complete(unsigned* bar, unsigned x, unsigned& nloc, unsigned& nx) {
    const unsigned G = gridDim.x * gridDim.y * gridDim.z;
    unsigned sum, cnt, mine, sp = 0u;
    for (;;) {
        sum = 0u; cnt = 0u; mine = 0u;
#pragma unroll 1
        for (unsigned j = 0; j < 16; ++j) { const unsigned c = xb_ld(&bar[XB_XCNT(j)]); sum += c; cnt += (c > 0u) ? 1u : 0u; mine = (j == x) ? c : mine; }
        if (sum == G) break;
        __builtin_amdgcn_s_sleep(1);
        if ((++sp & 255u) == 0u) { if (xb_ld(&bar[XB_TMO])) break; if (sp > XB_SPIN_CAP) { atomicAdd(&bar[XB_TMO], 1u); break; } }
    }
    nloc = mine > 0u ? mine : 1u; nx = cnt > 0u ? cnt : 1u;
}

__device__ __forceinline__ void xcd_barrier(const XcdBarrier& b) {
    asm volatile("s_waitcnt vmcnt(0)" ::: "memory");
    __syncthreads();
    if (threadIdx.x == 0) {
        unsigned* bar = b.bar;
        __builtin_amdgcn_s_waitcnt(0);
        unsigned nloc = b.st[0], nx = b.st[1];
        if (nloc == 0u) { xcd_barrier_complete(bar, b.x, nloc, nx); b.st[0] = nloc; b.st[1] = nx; }
        const unsigned old = xb_add(&bar[XB_XSUB(b.x)], 1u);
        const unsigned gen = old / nloc;
        if (old + 1u == (gen + 1u) * nloc) {
            __builtin_amdgcn_fence(__ATOMIC_RELEASE, "agent");
            asm volatile("s_waitcnt vmcnt(0)" ::: "memory");
            const unsigned og = xb_add(&bar[XB_TOP], 1u);
            const unsigned tg = og / nx;
            if (og + 1u == (tg + 1u) * nx) xb_add(&bar[XB_TOPGEN], 1u);
            else XB_SPIN(xb_ld(&bar[XB_TOPGEN]) == tg, bar);
            __builtin_amdgcn_fence(__ATOMIC_ACQUIRE, "agent");
            xb_add(&bar[XB_XGEN(b.x)], 1u);
            asm volatile("s_waitcnt vmcnt(0)" ::: "memory");
        } else {
            XB_SPIN(xb_ld(&bar[XB_XGEN(b.x)]) == gen, bar);
            __builtin_amdgcn_fence(__ATOMIC_ACQUIRE, "agent");
            asm volatile("s_waitcnt vmcnt(0)" ::: "memory");
        }
    }
    __syncthreads();
}

#ifndef SYNC_REP
#define SYNC_REP 1
#endif
#ifndef REP_MASK
#define REP_MASK 0
#endif
#ifndef PHM
#define PHM 0xfff
#endif
#ifndef PER_PHASE_LAUNCH
#define PER_PHASE_LAUNCH 0
#endif
__global__ void __launch_bounds__(512) mega(Args a_) {
    extern __shared__ __attribute__((aligned(16))) unsigned char lds_raw[];
    LAS unsigned char* lds = (LAS unsigned char*)lds_raw;
    const int G = gridDim.x, NGW = G * 8;
    const int ph_lo = a_.ph_lo, ph_hi = a_.ph_hi;
    const bool multi = (ph_hi - ph_lo) > 1;
    unsigned char* const ws0 = a_.ws;
    volatile LAS unsigned* MISC = (volatile LAS unsigned*)(lds + 131072 + 320);
    if (threadIdx.x < 32) MISC[threadIdx.x] = 0u;
    __syncthreads();
    XcdBarrier bar; bar.bar = (unsigned*)(ws0 + WS_BAR); bar.x = 0; bar.st = nullptr;
    if (multi) bar = xcd_barrier_post((unsigned*)(ws0 + WS_BAR), MISC + 8);
    if (ph_lo < 0) cg::this_grid().sync();
    unsigned long long tacc = 0ull;
    for (int ph = ph_lo; ph < ph_hi; ++ph) {
        const unsigned long long tph0 = TPROBE ? __builtin_amdgcn_s_memrealtime() : 0ull;
        int tid = threadIdx.x; asm volatile("" : "+v"(tid));
        const int lane = tid & 63, wave = __builtin_amdgcn_readfirstlane(tid >> 6), gw = blockIdx.x * 8 + wave;
        const Args __attribute__((address_space(4)))* ap = (const Args __attribute__((address_space(4)))*)__builtin_amdgcn_kernarg_segment_ptr(); asm volatile("" : "+s"(ap));
        ArgsRef a = *ap;
        unsigned char* ws = a.ws;
        float* cond = (float*)(ws + WS_COND); float* SS = (float*)(ws + WS_SS); const float* SHW = (const float*)(ws + WS_SHW);
        bf16* H = (bf16*)(ws + WS_H); bf16* ACT = (bf16*)(ws + WS_ACT); bf16* Z = (bf16*)(ws + WS_Z); bf16* YG = (bf16*)(ws + WS_YG); bf16* YCAT = (bf16*)(ws + WS_YCAT);
        if (ph == 0) { for (int rp = 0; rp < PREP_REP; ++rp) { if (rp) { XcdBarrier b3 = bar; asm volatile("" : "+s"(b3.bar)); xcd_barrier(b3); } prep_phase(a, lds, tid, wave, lane, G); } }
        else if (ph == 1) norm_phase(a.in[0], a.in[4], cond, cond + 1024, H, (bf16*)(ws + WS_XB), gw, NGW, lane);
        else {
            const int l = (ph - 2) / NSLOT, slot = (ph - 2) % NSLOT, s = (int)((SLOT_MAP >> (4 * slot)) & 15ull); const bool rep = ((SLOT_REP >> slot) & 1u) != 0u;
            unsigned char* wl = ws + WS_W + (size_t)l * LW;
            const float* cl = cond + (size_t)l * 8 * NCOND;
            if ((PHM & 8) && (s == 0 || s == 7)) {
                pg8::Gemm gm{H, (const bf16*)(wl + (s == 0 ? OW_IN1 : OW_IN2)), M, 2 * DFF, D}; pg8::StaticOrder S; S.init(M, 2 * DFF, G, (int)blockIdx.x);
                pg8::EpiSwiglu E{ACT, DFF};
                pg8::gemm_phase<pg8::EpiSwiglu, pg8::StaticOrder>(lds, gm, S, E, nullptr, tid);
            } else if ((PHM & 16) && (s == 1 || s == 6 || s == 8)) {
                const bf16* A = (s == 6) ? YCAT : ACT; const int K = (s == 6) ? D : DFF;
                const bf16* Bt = (const bf16*)(wl + (s == 1 ? OW_OUT1 : (s == 6 ? OW_MO : OW_OUT2)));
                pg8::Gemm gm{A, Bt, M, D, K}; pg8::StaticOrder S; S.init(M, D, G, (int)blockIdx.x);
                bf16* XB = (bf16*)(ws + WS_XB);
                const float* gnext = (s == 1) ? a.in[7] + (size_t)l * D : (s == 6 ? a.in[26] + (size_t)l * D : (l == NL - 1 ? a.in[29] : a.in[4] + (size_t)(l + 1) * D));
                const float* shnext = (s == 1) ? cl + 3 * 1024 : (s == 6 ? cl + 6 * 1024 : cl + (size_t)8 * NCOND);
                const float* scnext = shnext + 1024;
                bf16* xa = (s == 8 && l == NL - 1) ? (bf16*)nullptr : H;
                const float gs = __builtin_bit_cast(float, __builtin_amdgcn_readfirstlane(s == 6 ? 0x3f800000 : 0x3f000000));
                const unsigned need = 32u * (unsigned)(l * 3 + (s == 1 ? 0 : (s == 6 ? 1 : 2)) + 1);
                pg8::EpiResid E{XB, XB, a.out, cl + (s == 1 ? 2 : (s == 6 ? 5 : 8)) * 1024, gnext, scnext, shnext, xa, (unsigned*)(ws + WS_SS), (unsigned*)(ws + WS_BAR + 16384), gs, need};
                pg8::gemm_phase<pg8::EpiResid, pg8::StaticOrder>(lds, gm, S, E, nullptr, tid);
            } else if ((PHM & 32) && s == 2) {
                pg8::Gemm gm{H, (const bf16*)(wl + OW_MIX), M, PIN, D}; pg8::StaticOrder S; S.init(M, PIN, G, (int)blockIdx.x);
                pg8::EpiZ E{Z, PIN};
                pg8::gemm_phase<pg8::EpiZ, pg8::StaticOrder>(lds, gm, S, E, nullptr, tid);
            } else if ((PHM & 64) && s == 3) {
                int w_first = gw, w_stride = NGW;
                if (G >= 256) { w_first = (blockIdx.x < 128) ? blockIdx.x * 8 + wave : 2048; w_stride = 1024; }
                for (int it = blockIdx.x; it < 256; it += G) { if (it < 128) { for (int rq = 0; rq < SGU_REP; ++rq) sgu_item(a, l, it, lds, tid, wave, lane); } else { for (int rq = 0; rq < S5_REP; ++rq) s5_wg_item(a, l, it - 128, lds, wave, lane); } }
                for (int rq = 0; rq < PC_REP; ++rq) for (int idx = w_first; idx < 2048; idx += w_stride) poolconv_item(a, l, idx, lane);
            } else if ((PHM & 256) && s == 5) {
                for (int it = blockIdx.x; it < M / 64; it += G) glu_item(a, l, it, lds, tid, wave, lane);
            }
        }
        if (ph + 1 < ph_hi) { XcdBarrier b2 = bar; asm volatile("" : "+s"(b2.bar)); xcd_barrier(b2); }
        if (TPROBE) { int ty; if (ph == 0) ty = 0; else if (ph == 1) ty = 1; else { const int s_ = (int)((SLOT_MAP >> (4 * ((ph - 2) % NSLOT))) & 15ull); ty = (s_ == 0 || s_ == 7) ? 2 : ((s_ == 1 || s_ == 6 || s_ == 8) ? 3 : (s_ == 2 ? 4 : (s_ == 3 ? 5 : 6))); }
            if ((TPROBE >> ty) & 1) tacc += __builtin_amdgcn_s_memrealtime() - tph0; }
    }
    if (TPROBE) { const unsigned long long te = __builtin_amdgcn_s_memrealtime(); while (__builtin_amdgcn_s_memrealtime() - te < tacc) __builtin_amdgcn_s_sleep(8); }
}

extern "C" void kernel_launch(void* const* d_in, const int* in_sizes, int n_in, void* d_out, int out_size, void* d_ws, size_t ws_size, hipStream_t stream) {
    static int grid = 0;
    if (grid == 0) {
        int dev = 0, cus = 0;
        if (n_in != 30 || ws_size < WS_END || hipGetDevice(&dev) != hipSuccess || hipDeviceGetAttribute(&cus, hipDeviceAttributeMultiprocessorCount, dev) != hipSuccess) { grid = -1; return; }
        if (hipFuncSetAttribute((const void*)mega, hipFuncAttributeMaxDynamicSharedMemorySize, LDS_BYTES) != hipSuccess) { grid = -1; return; }
        int per_cu = 0;
        if (hipOccupancyMaxActiveBlocksPerMultiprocessor(&per_cu, (const void*)mega, 512, LDS_BYTES) != hipSuccess || per_cu < 1) per_cu = 1;
        (void)hipGetLastError();
        grid = cus;
    }
    if (grid < 0) return;
    Args a{};
    for (int i = 0; i < 30; ++i) a.in[i] = (const float*)d_in[i];
    a.out = (float*)d_out; a.ws = (unsigned char*)d_ws;
#if PER_PHASE_LAUNCH
    for (int ph = 0; ph < NPH; ++ph) { a.ph_lo = ph; a.ph_hi = ph + 1; hipLaunchKernelGGL(mega, dim3(grid), dim3(512), LDS_BYTES, stream, a); }
#else
    (void)hipMemsetAsync((char*)d_ws + WS_BAR, 0, BAR_BYTES, stream);
    a.ph_lo = 0; a.ph_hi = NPH;
    void* args[] = {&a};
    (void)hipLaunchCooperativeKernel((const void*)mega, dim3(grid), dim3(512), args, LDS_BYTES, stream);
#endif
}
```

```cpp
#include <hip/hip_runtime.h>
#include <hip/hip_cooperative_groups.h>
namespace cg = cooperative_groups;
namespace pg8 {
#define PG8_LAS __attribute__((address_space(3)))
typedef unsigned short bf16_t;
typedef short bf16x8 __attribute__((ext_vector_type(8)));
typedef float f32x4 __attribute__((ext_vector_type(4)));
typedef unsigned u32x4 __attribute__((ext_vector_type(4)));
constexpr int BM = 256, BK = 64, HALF = 128, HTB = HALF * BK * 2  , STAGE_BYTES = 8 * HTB, NXCD = 8, WGM = 8;

__host__ __device__ __forceinline__ int lds_byte(int r, int c) { const int st = (r >> 4) * 2 + (c >> 5), rr = r & 15, cc = c & 31, ob = rr * 64 + cc * 2; return st * 1024 + (ob ^ (((ob >> 9) & 1) << 5)); }
__host__ __device__ __forceinline__ void stage_rc(int b, int& R, int& C) { const int st = b / 1024, sb = b % 1024, swz = sb ^ (((sb >> 9) & 1) << 5); R = (st >> 1) * 16 + swz / 64; C = (st & 1) * 32 + (swz % 64) / 2; }
__host__ __device__ __forceinline__ int perm32(int rho) { const int n = rho >> 4, i = rho & 15; return 8 * (i >> 2) + 4 * n + (i & 3); }

struct Unit { int pm, pn; };
struct Gemm { const bf16_t* A; const bf16_t* Bt; int M, N, K; };

struct StaticOrder {
    int nM, nN, nwg, G, c;
    __host__ __device__ void init(int M, int N, int G_, int c_) { nM = M / BM; nN = N / BM; nwg = nM * nN; G = G_; c = c_; }
    __host__ __device__ bool next(int i, Unit& u) const {
        const long L = (long)i * G + c; if (L >= nwg) return false;
        int wgid = (int)L; { const int q = nwg / NXCD, r = nwg % NXCD, xcd = wgid % NXCD, off = wgid / NXCD; wgid = (xcd < r ? xcd * (q + 1) : r * (q + 1) + (xcd - r) * q) + off; }
        const int nig = WGM * nN, gid = wgid / nig, fm = gid * WGM, gsz = (nM - fm) < WGM ? (nM - fm) : WGM;
        u.pm = fm + ((wgid % nig) % gsz); u.pn = (wgid % nig) / gsz; return true;
    }
    __device__ __forceinline__ void a_ready(const Unit&) const {}
    __device__ __forceinline__ void done(const Unit&) const {}
};
__device__ __forceinline__ unsigned cvt_pk_bf16(float lo, float hi) { unsigned r; asm volatile("v_cvt_pk_bf16_f32 %0, %1, %2" : "=v"(r) : "v"(lo), "v"(hi)); return r; }
typedef float f32x2 __attribute__((ext_vector_type(2)));
typedef unsigned u32x2 __attribute__((ext_vector_type(2)));
__device__ __forceinline__ float silu_f(float a) { return a * __builtin_amdgcn_rcpf(1.0f + __expf(-a)); }
__device__ __forceinline__ float sigmoid_f(float a) { return __builtin_amdgcn_rcpf(1.0f + __expf(-a)); }
__device__ __forceinline__ float gelu_tanh(float y) { const float z = 1.5957691216f * (y + 0.044715f * y * y * y); return y * __builtin_amdgcn_rcpf(1.0f + __expf(-z)); }
__device__ __forceinline__ float bf_lo(unsigned w) { return __uint_as_float(w << 16); }
__device__ __forceinline__ float bf_hi(unsigned w) { return __uint_as_float(w & 0xffff0000u); }

struct EpiZ {
    static constexpr bool PERM = true, AFTER_DRAIN = false;
    bf16_t* O; int ldc;
    __device__ __forceinline__ void operator()(const f32x4 (&acc)[2][2][4][2], const Unit& u, int wr, int wc, int fr, int fq) const {
        const int row0 = u.pm * BM + wr * 64 + fr, col0 = u.pn * BM + wc * 32 + 8 * fq;
#pragma unroll
        for (int ai = 0; ai < 2; ++ai)
#pragma unroll
            for (int m = 0; m < 4; ++m) { bf16_t* rowp = O + (size_t)(row0 + ai * HALF + m * 16) * ldc + col0;
#pragma unroll
                for (int bj = 0; bj < 2; ++bj) { const f32x4 v0 = acc[ai][bj][m][0], v1 = acc[ai][bj][m][1];
                    u32x4 w; w.x = cvt_pk_bf16(v0[0], v0[1]); w.y = cvt_pk_bf16(v0[2], v0[3]); w.z = cvt_pk_bf16(v1[0], v1[1]); w.w = cvt_pk_bf16(v1[2], v1[3]);
                    *(u32x4*)(rowp + bj * HALF) = w; } }
    }
};
struct EpiSwiglu {
    static constexpr bool PERM = true, AFTER_DRAIN = false;
    bf16_t* O; int ldc;
    __device__ __forceinline__ void operator()(const f32x4 (&acc)[2][2][4][2], const Unit& u, int wr, int wc, int fr, int fq) const {
        const int row0 = u.pm * BM + wr * 64 + fr, col0 = u.pn * HALF + wc * 32 + 8 * fq;
#pragma unroll
        for (int ai = 0; ai < 2; ++ai)
#pragma unroll
            for (int m = 0; m < 4; ++m) { bf16_t* rowp = O + (size_t)(row0 + ai * HALF + m * 16) * ldc + col0;
                const f32x4 a0 = acc[ai][0][m][0], a1 = acc[ai][0][m][1], b0 = acc[ai][1][m][0], b1 = acc[ai][1][m][1];
                const f32x4 t0 = a0 * -1.4426950408889634f, t1 = a1 * -1.4426950408889634f;
                f32x4 e0, e1;
#pragma unroll
                for (int j = 0; j < 4; ++j) { e0[j] = __builtin_amdgcn_exp2f(t0[j]); e1[j] = __builtin_amdgcn_exp2f(t1[j]); }
                const f32x4 d0 = e0 + 1.0f, d1 = e1 + 1.0f; f32x4 r0, r1;
#pragma unroll
                for (int j = 0; j < 4; ++j) { r0[j] = __builtin_amdgcn_rcpf(d0[j]); r1[j] = __builtin_amdgcn_rcpf(d1[j]); }
                const f32x4 v0 = (a0 * b0) * r0, v1 = (a1 * b1) * r1;
                u32x4 w; w.x = cvt_pk_bf16(v0[0], v0[1]); w.y = cvt_pk_bf16(v0[2], v0[3]); w.z = cvt_pk_bf16(v1[0], v1[1]); w.w = cvt_pk_bf16(v1[2], v1[3]);
                __builtin_nontemporal_store(w, (u32x4*)rowp); }
    }
};
struct EpiResid {
    static constexpr bool PERM = true, AFTER_DRAIN = true;
    const bf16_t* xin; bf16_t* xout; float* fout; const float* gate; const float* gnext; const float* scnext; const float* shnext; bf16_t* xa; unsigned* xbuf; unsigned* cnt; float gs; unsigned need;
    __device__ __forceinline__ void fused(f32x4 (&acc)[2][2][4][2], const Unit& u, int wr, int wc, int fr, int fq, PG8_LAS unsigned char* lds, int wid, int lane) const {
        PG8_LAS float* P = (PG8_LAS float*)lds;
        PG8_LAS float* S = (PG8_LAS float*)(lds + 4096);
        const int row0 = u.pm * BM + wr * 64 + fr, col0 = u.pn * BM + wc * 32 + 8 * fq;
        const size_t cb = (size_t)(u.pm >> 3) * 9216 + col0;
        float sq[8];
#pragma unroll
        for (int i = 0; i < 8; ++i) sq[i] = 0.f;
#pragma unroll
        for (int bj = 0; bj < 2; ++bj) { const int co = bj * HALF;
            const f32x4 gv0 = *(const f32x4*)(gate + cb + co) * gs, gv1 = *(const f32x4*)(gate + cb + co + 4) * gs;
#pragma unroll
            for (int ai = 0; ai < 2; ++ai)
#pragma unroll
                for (int m = 0; m < 4; ++m) { const size_t off = (size_t)(row0 + ai * HALF + m * 16) * 1024 + col0 + co;
                    const u32x4 xw = *(const u32x4*)(xin + off);
                    const f32x4 xi0 = (f32x4){bf_lo(xw.x), bf_hi(xw.x), bf_lo(xw.y), bf_hi(xw.y)}, xi1 = (f32x4){bf_lo(xw.z), bf_hi(xw.z), bf_lo(xw.w), bf_hi(xw.w)};
                    const f32x4 xn0 = xi0 + gv0 * acc[ai][bj][m][0], xn1 = xi1 + gv1 * acc[ai][bj][m][1];
                    if (xa) { u32x4 ow; ow.x = cvt_pk_bf16(xn0[0], xn0[1]); ow.y = cvt_pk_bf16(xn0[2], xn0[3]); ow.z = cvt_pk_bf16(xn1[0], xn1[1]); ow.w = cvt_pk_bf16(xn1[2], xn1[3]);
                        *(u32x4*)(xout + off) = ow; }
                    acc[ai][bj][m][0] = xn0; acc[ai][bj][m][1] = xn1;
                    const f32x4 s2 = xn0 * xn0 + xn1 * xn1;
                    sq[ai * 4 + m] += (s2[0] + s2[1]) + (s2[2] + s2[3]); }
            asm volatile("" ::: "memory"); }
#pragma unroll
        for (int i = 0; i < 8; ++i) { float q = sq[i]; q += __shfl_xor(q, 16); q += __shfl_xor(q, 32);
            if (fq == 0) P[((i >> 2) * HALF + wr * 64 + (i & 3) * 16 + fr) * 4 + wc] = q; }
        asm volatile("s_waitcnt lgkmcnt(0)" ::: "memory"); __builtin_amdgcn_s_barrier(); asm volatile("" ::: "memory");
        const int row = wid * 32 + (lane & 31);
        if (lane < 32) { const f32x4 p = *(const PG8_LAS f32x4*)(P + row * 4); const float s = (p[0] + p[1]) + (p[2] + p[3]);
            __hip_atomic_store(xbuf + ((size_t)(u.pm * BM + row) * 4 + u.pn), __float_as_uint(s), __ATOMIC_RELAXED, __HIP_MEMORY_SCOPE_AGENT); }
        asm volatile("s_waitcnt vmcnt(0)" ::: "memory");
        if (lane == 0) __hip_atomic_fetch_add(cnt + 64 * u.pm, 1u, __ATOMIC_RELAXED, __HIP_MEMORY_SCOPE_AGENT);
        if (wid == 0) {
            unsigned spins = 0;
            while ((unsigned)__builtin_amdgcn_readfirstlane(__hip_atomic_load(cnt + 64 * u.pm, __ATOMIC_RELAXED, __HIP_MEMORY_SCOPE_AGENT)) < need) { __builtin_amdgcn_s_sleep(2); if (++spins > (1u << 22)) break; }
            __builtin_amdgcn_fence(__ATOMIC_ACQUIRE, "agent");
        }
        asm volatile("s_waitcnt vmcnt(0) lgkmcnt(0)" ::: "memory"); __builtin_amdgcn_s_barrier(); asm volatile("" ::: "memory");
        if (lane < 32) { const unsigned* slot = xbuf + (size_t)(u.pm * BM + row) * 4; float t = 0.f;
#pragma unroll
            for (int k = 0; k < 4; ++k) t += __uint_as_float(__hip_atomic_load(slot + k, __ATOMIC_RELAXED, __HIP_MEMORY_SCOPE_AGENT));
            S[row] = __builtin_amdgcn_rsqf(t * (1.0f / 1024.0f) + 1e-6f); }
        asm volatile("s_waitcnt vmcnt(0) lgkmcnt(0)" ::: "memory"); __builtin_amdgcn_s_barrier(); asm volatile("" ::: "memory");
        if (xa == nullptr) {
#pragma unroll
            for (int bj = 0; bj < 2; ++bj) { const int co = bj * HALF; const f32x4 g0 = *(const f32x4*)(gnext + col0 + co), g1 = *(const f32x4*)(gnext + col0 + co + 4);
#pragma unroll
                for (int ai = 0; ai < 2; ++ai)
#pragma unroll
                    for (int m = 0; m < 4; ++m) { const int r = ai * HALF + wr * 64 + m * 16 + fr; const float rs = S[r]; float* op = fout + (size_t)(u.pm * BM + r) * 1024 + col0 + co;
                        *(f32x4*)op = acc[ai][bj][m][0] * rs * g0; *(f32x4*)(op + 4) = acc[ai][bj][m][1] * rs * g1; } }
            asm volatile("s_waitcnt lgkmcnt(0)" ::: "memory"); __builtin_amdgcn_s_barrier(); asm volatile("" ::: "memory");
            return;
        }
#pragma unroll
        for (int bj = 0; bj < 2; ++bj) { const int co = bj * HALF;
            const f32x4 gm0 = *(const f32x4*)(gnext + col0 + co) * (*(const f32x4*)(scnext + cb + co) + 1.0f), gm1 = *(const f32x4*)(gnext + col0 + co + 4) * (*(const f32x4*)(scnext + cb + co + 4) + 1.0f);
            const f32x4 sh0 = *(const f32x4*)(shnext + cb + co), sh1 = *(const f32x4*)(shnext + cb + co + 4);
#pragma unroll
            for (int ai = 0; ai < 2; ++ai)
#pragma unroll
                for (int m = 0; m < 4; ++m) { const int r = ai * HALF + wr * 64 + m * 16 + fr; const float rs = S[r];
                    const f32x4 y0 = acc[ai][bj][m][0] * rs * gm0 + sh0, y1 = acc[ai][bj][m][1] * rs * gm1 + sh1;
                    u32x4 w; w.x = cvt_pk_bf16(y0[0], y0[1]); w.y = cvt_pk_bf16(y0[2], y0[3]); w.z = cvt_pk_bf16(y1[0], y1[1]); w.w = cvt_pk_bf16(y1[2], y1[3]);
                    *(u32x4*)(xa + (size_t)(u.pm * BM + r) * 1024 + col0 + co) = w; } }
        asm volatile("s_waitcnt lgkmcnt(0)" ::: "memory"); __builtin_amdgcn_s_barrier(); asm volatile("" ::: "memory");
    }
};
struct EpiGlu {
    static constexpr bool PERM = false, AFTER_DRAIN = true;
    const bf16_t* yg; const float* glu_b; const float* gn; bf16_t* ycat;
    __device__ __forceinline__ void fused(f32x4 (&acc)[2][2][4][2], const Unit& u, int wr, int wc, int fr, int fq, PG8_LAS unsigned char* lds, int wid, int lane) const {
        PG8_LAS float* P = (PG8_LAS float*)lds;
        const int col0 = wc * 32 + 4 * fq;
        f32x4 gb[2][2];
#pragma unroll
        for (int bj = 0; bj < 2; ++bj)
#pragma unroll
            for (int n = 0; n < 2; ++n) gb[bj][n] = *(const f32x4*)(glu_b + col0 + bj * HALF + n * 16);
#pragma unroll
        for (int ai = 0; ai < 2; ++ai)
#pragma unroll
            for (int m = 0; m < 4; ++m) { const int r = ai * HALF + wr * 64 + m * 16 + fr; const bf16_t* yp = yg + (size_t)(u.pm * BM + r) * 256 + col0; float s = 0.f;
#pragma unroll
                for (int bj = 0; bj < 2; ++bj)
#pragma unroll
                    for (int n = 0; n < 2; ++n) { const u32x2 yw = *(const u32x2*)(yp + bj * HALF + n * 16);
                        const f32x4 y = (f32x4){bf_lo(yw.x), bf_hi(yw.x), bf_lo(yw.y), bf_hi(yw.y)}; const f32x4 a = acc[ai][bj][m][n] + gb[bj][n]; f32x4 o;
#pragma unroll
                        for (int j = 0; j < 4; ++j) { o[j] = y[j] * sigmoid_f(a[j]); s += o[j] * o[j]; }
                        acc[ai][bj][m][n] = o; }
                s += __shfl_xor(s, 16); s += __shfl_xor(s, 32);
                if (fq == 0) P[r * 4 + wc] = s; }
        asm volatile("s_waitcnt lgkmcnt(0)" ::: "memory"); __builtin_amdgcn_s_barrier(); asm volatile("" ::: "memory");
        f32x4 gg[2][2];
#pragma unroll
        for (int bj = 0; bj < 2; ++bj)
#pragma unroll
            for (int n = 0; n < 2; ++n) gg[bj][n] = *(const f32x4*)(gn + col0 + bj * HALF + n * 16);
#pragma unroll
        for (int ai = 0; ai < 2; ++ai)
#pragma unroll
            for (int m = 0; m < 4; ++m) { const int r = ai * HALF + wr * 64 + m * 16 + fr; const f32x4 pp = *(const PG8_LAS f32x4*)(P + r * 4);
                const float rstd = 1.0f / sqrtf(((pp[0] + pp[1]) + (pp[2] + pp[3])) * (1.0f / 256.0f) + 1e-6f);
                bf16_t* op = ycat + (size_t)(u.pm * BM + r) * 1024 + 768 + col0;
#pragma unroll
                for (int bj = 0; bj < 2; ++bj)
#pragma unroll
                    for (int n = 0; n < 2; ++n) { const f32x4 o = acc[ai][bj][m][n] * rstd * gg[bj][n]; u32x2 w; w.x = cvt_pk_bf16(o[0], o[1]); w.y = cvt_pk_bf16(o[2], o[3]);
                        *(u32x2*)(op + bj * HALF + n * 16) = w; } }
        asm volatile("s_waitcnt lgkmcnt(0)" ::: "memory"); __builtin_amdgcn_s_barrier(); asm volatile("" ::: "memory");
    }
};

template <class Epi, class Sched, bool STAMP = false>
__device__ __forceinline__ void gemm_phase(PG8_LAS unsigned char* lds, const Gemm g, const Sched& S, const Epi& E, unsigned long long* stamps, const int tid) {
    const int wid = __builtin_amdgcn_readfirstlane(tid >> 6), lane = tid & 63, wr = wid >> 2, wc = wid & 3, fr = lane & 15, fq = lane >> 4;
    const int K = g.K, nt = K / BK;
    int ts_lo = 0, ts_hi = 0, nts = 0; const unsigned long long rt_entry = STAMP ? (unsigned long long)wall_clock64() : 0ull;
#define PG8_STAMP() do { if (STAMP && wid == 0 && nts < 64) { const unsigned long long _c = (unsigned long long)clock64(); \
        ts_lo = (lane == nts) ? (int)(unsigned)_c : ts_lo; ts_hi = (lane == nts) ? (int)(unsigned)(_c >> 32) : ts_hi; ++nts; } } while (0)
    PG8_STAMP();
    unsigned voffA[2], voffB[2];
#pragma unroll
    for (int i = 0; i < 2; ++i) { int R, C; stage_rc(tid * 16 + i * 8192, R, C); const int Rb = Epi::PERM ? ((R & ~31) + perm32(R & 31)) : R;
        voffA[i] = (unsigned)(R * K + C) * 2u; voffB[i] = (unsigned)(Rb * K + C) * 2u; }
    const size_t kstep = (size_t)(BK * 2);
    const size_t hstep = (size_t)HALF * K * 2;
    const size_t tstep = 2 * hstep;
    const unsigned ldsw = (unsigned)wid * 1024u;
    const int aoff = lds_byte(wr * 64 + fr, fq * 8), boff = lds_byte(wc * 32 + fr, fq * 8);
#define PG8_SA(b, h) (((b) * 2 + (h)) * HTB)
#define PG8_SB(b, h) ((4 + (b) * 2 + (h)) * HTB)
#define PG8_STAGE(bufoff, gbase, voff) do { _Pragma("unroll") for (int _i = 0; _i < 2; ++_i) \
        __builtin_amdgcn_global_load_lds((const unsigned*)((const char*)(gbase) + (voff)[_i]), (PG8_LAS unsigned*)(lds + (bufoff) + ldsw + _i * 8192), 16, 0, 0); } while (0)
#define PG8_LDA(dst, b, h) do { _Pragma("unroll") for (int m = 0; m < 4; ++m) _Pragma("unroll") for (int k = 0; k < 2; ++k) dst[m][k] = *(const PG8_LAS bf16x8*)(lds + PG8_SA(b, h) + aoff + m * 2048 + k * 1024); } while (0)
#define PG8_LDB(dst, b, h) do { _Pragma("unroll") for (int n = 0; n < 2; ++n) _Pragma("unroll") for (int k = 0; k < 2; ++k) dst[n][k] = *(const PG8_LAS bf16x8*)(lds + PG8_SB(b, h) + boff + n * 2048 + k * 1024); } while (0)
#define PG8_MMA(ai, bj, At, Bt) do { __builtin_amdgcn_s_setprio(1); _Pragma("unroll") for (int m = 0; m < 4; ++m) _Pragma("unroll") for (int n = 0; n < 2; ++n) _Pragma("unroll") for (int k = 0; k < 2; ++k) \
        acc[ai][bj][m][n] = __builtin_amdgcn_mfma_f32_16x16x32_bf16(Bt[n][k], At[m][k], acc[ai][bj][m][n], 0, 0, 0); __builtin_amdgcn_s_setprio(0); } while (0)
#define PG8_WAIT_V(n) asm volatile("s_waitcnt vmcnt(" #n ")" ::: "memory")
#define PG8_WAIT_L(n) asm volatile("s_waitcnt lgkmcnt(" #n ")" ::: "memory")
#define PG8_BAR __builtin_amdgcn_s_barrier()
#define PG8_SCHED __builtin_amdgcn_sched_barrier(0)
    Unit cur, nxt; int ui = 0;
    if (!S.next(0, cur)) return;
    f32x4 acc[2][2][4][2];
#pragma unroll
    for (int a = 0; a < 2; ++a)
#pragma unroll
        for (int b = 0; b < 2; ++b)
#pragma unroll
            for (int m = 0; m < 4; ++m)
#pragma unroll
                for (int n = 0; n < 2; ++n) acc[a][b][m][n] = (f32x4){0.f, 0.f, 0.f, 0.f};
    bf16x8 At[4][2], B0[2][2], B1[2][2];
    const char* cA = (const char*)g.A + (size_t)cur.pm * tstep; const char* cB = (const char*)g.Bt + (size_t)cur.pn * tstep;
    S.a_ready(cur);
    PG8_STAGE(PG8_SB(0, 0), cB, voffB); PG8_STAGE(PG8_SA(0, 0), cA, voffA); PG8_STAGE(PG8_SB(0, 1), cB + hstep, voffB); PG8_STAGE(PG8_SA(0, 1), cA + hstep, voffA);
    if (wr == 1) PG8_BAR;
    PG8_WAIT_V(4); PG8_BAR;
    PG8_STAGE(PG8_SB(1, 0), cB + kstep, voffB); PG8_STAGE(PG8_SA(1, 0), cA + kstep, voffA); PG8_STAGE(PG8_SB(1, 1), cB + hstep + kstep, voffB);
    PG8_WAIT_V(6); PG8_BAR;
    PG8_STAMP();
    for (;;) {
        const bool has_next = S.next(ui + 1, nxt);
        const char* nA = has_next ? (const char*)g.A + (size_t)nxt.pm * tstep : cA; const char* nB = has_next ? (const char*)g.Bt + (size_t)nxt.pn * tstep : cB;
        for (int t = 0; t < nt; t += 2) {
            const bool last = (t == nt - 2);
            const char* a1 = cA + (size_t)(t + 1) * kstep;
            const char* a2 = last ? nA : cA + (size_t)(t + 2) * kstep; const char* b2 = last ? nB : cB + (size_t)(t + 2) * kstep;
            const char* a3 = a2 + kstep; const char* b3 = b2 + kstep;
            if (last && has_next) S.a_ready(nxt);
            PG8_LDB(B0, 0, 0); PG8_SCHED; PG8_LDA(At, 0, 0); PG8_STAGE(PG8_SA(1, 1), a1 + hstep, voffA);
            PG8_WAIT_L(8); PG8_BAR; PG8_WAIT_L(0); PG8_MMA(0, 0, At, B0); PG8_BAR; PG8_SCHED;
            PG8_LDB(B1, 0, 1); PG8_STAGE(PG8_SB(0, 0), b2, voffB);
            PG8_BAR; PG8_WAIT_L(0); PG8_MMA(0, 1, At, B1); PG8_BAR;
            PG8_LDA(At, 0, 1); PG8_STAGE(PG8_SA(0, 0), a2, voffA);
            PG8_BAR; PG8_WAIT_L(0); PG8_MMA(1, 0, At, B0); PG8_BAR; PG8_SCHED;
            PG8_STAGE(PG8_SB(0, 1), b2 + hstep, voffB);
            PG8_WAIT_V(6); PG8_BAR; PG8_MMA(1, 1, At, B1); PG8_BAR;
            PG8_LDB(B0, 1, 0); PG8_SCHED; PG8_LDA(At, 1, 0); PG8_STAGE(PG8_SA(0, 1), a2 + hstep, voffA);
            PG8_WAIT_L(8); PG8_BAR; PG8_WAIT_L(0); PG8_MMA(0, 0, At, B0); PG8_BAR; PG8_SCHED;
            PG8_LDB(B1, 1, 1); PG8_STAGE(PG8_SB(1, 0), b3, voffB);
            PG8_BAR; PG8_WAIT_L(0); PG8_MMA(0, 1, At, B1); PG8_BAR;
            PG8_LDA(At, 1, 1); PG8_STAGE(PG8_SA(1, 0), a3, voffA);
            PG8_BAR; PG8_WAIT_L(0); PG8_MMA(1, 0, At, B0); PG8_BAR; PG8_SCHED;
            PG8_STAGE(PG8_SB(1, 1), b3 + hstep, voffB);
            PG8_WAIT_V(6); PG8_BAR; PG8_MMA(1, 1, At, B1); PG8_BAR;
        }
        PG8_STAMP();
        if constexpr (!Epi::AFTER_DRAIN) { E(acc, cur, wr, wc, fr, fq); S.done(cur); }
        PG8_STAMP();
        if (!has_next) break;
#pragma unroll
        for (int a = 0; a < 2; ++a)
#pragma unroll
            for (int b = 0; b < 2; ++b)
#pragma unroll
                for (int m = 0; m < 4; ++m)
#pragma unroll
                    for (int n = 0; n < 2; ++n) acc[a][b][m][n] = (f32x4){0.f, 0.f, 0.f, 0.f};
        cur = nxt; cA = nA; cB = nB; ++ui;
    }
    PG8_WAIT_V(0);
    if (wr == 0) PG8_BAR;
    PG8_BAR;
    if constexpr (Epi::AFTER_DRAIN) { E.fused(acc, cur, wr, wc, fr, fq, lds, wid, lane); S.done(cur); }
    PG8_STAMP();
    if (STAMP && wid == 0) { stamps[lane] = lane < nts ? (((unsigned long long)(unsigned)ts_hi << 32) | (unsigned)ts_lo) : 0ull;
        if (lane == 62) stamps[62] = rt_entry; if (lane == 63) stamps[63] = (unsigned long long)wall_clock64(); }
#undef PG8_STAMP
#undef PG8_SA
#undef PG8_SB
#undef PG8_STAGE
#undef PG8_LDA
#undef PG8_LDB
#undef PG8_MMA
#undef PG8_WAIT_V
#undef PG8_WAIT_L
#undef PG8_BAR
#undef PG8_SCHED
}
}

#define LAS __attribute__((address_space(3)))
typedef unsigned short bf16;
using pg8::f32x4; using pg8::bf16x8; using pg8::u32x4; using pg8::u32x2; using pg8::cvt_pk_bf16; using pg8::bf_lo; using pg8::bf_hi; using pg8::gelu_tanh;

constexpr int M = 16384, D = 1024, DFF = 2816, PIN = 1792, NL = 4, NCOND = 9216;
constexpr float EPS = 1e-6f;
constexpr size_t MiB = (size_t)1 << 20;
constexpr size_t WS_BAR = 7 * MiB, BAR_BYTES = 32768;
constexpr size_t WS_COND = 0, WS_E = 2 * MiB, WS_W = 8 * MiB, LW = 39 * MiB;
constexpr size_t OW_IN1 = 0, OW_OUT1 = 11 * MiB, OW_MIX = OW_OUT1 + 11 * MiB / 2, OW_MO = OW_MIX + 7 * MiB / 2, OW_IN2 = OW_MO + 2 * MiB, OW_OUT2 = OW_IN2 + 11 * MiB, OW_GLU = OW_OUT2 + 11 * MiB / 2;
static_assert(OW_GLU + 131072 <= LW, "weights per layer");
constexpr size_t WS_H = 164 * MiB, WS_ACT = 196 * MiB, WS_Z = 284 * MiB, WS_YG = 340 * MiB, WS_YCAT = 348 * MiB, WS_SHW = 380 * MiB, WS_SS = 383 * MiB, WS_XB = 384 * MiB, WS_END = 416 * MiB;
constexpr int LDS_BYTES = 147456;
#ifndef SGU_REP
#define SGU_REP 1
#endif
#ifndef S5_REP
#define S5_REP 1
#endif
#ifndef PC_REP
#define PC_REP 1
#endif
#ifndef PREP_REP
#define PREP_REP 1
#endif
#ifndef PREP_TILE_REP
#define PREP_TILE_REP 1
#endif
#ifndef TPROBE
#define TPROBE 0
#endif
#ifndef SLOT_MAP
#define SLOT_MAP 0x87653210ull
#define SLOT_REP 0u
#define NSLOT 8
#endif
constexpr int NPH = 2 + NL * NSLOT;
constexpr int TILES_PER_LAYER = 176 + 88 + 48 + 32 + 176 + 88 + 2;

struct Args { const float* in[30]; float* out; unsigned char* ws; int ph_lo, ph_hi; };
typedef const Args __attribute__((address_space(4)))& ArgsRef;

__device__ __forceinline__ float wave_sum(float v) {
#pragma unroll
    for (int o = 1; o < 64; o <<= 1) v += __shfl_xor(v, o);
    return v;
}
#define LDS_WAIT() asm volatile("s_waitcnt lgkmcnt(0)" ::: "memory")

struct TileDesc { const float* W; bf16* WT; int K, N, k0, n0, swiglu; };
__device__ __forceinline__ TileDesc tile_decode(ArgsRef a, int item) {
    const int l = item / TILES_PER_LAYER; int r = item % TILES_PER_LAYER;
    unsigned char* wl = a.ws + WS_W + (size_t)l * LW; TileDesc t;
    if (r < 176) t = TileDesc{a.in[5] + (size_t)l * 1024 * 5632, (bf16*)(wl + OW_IN1), 1024, 5632, 128 * (r / 22), 256 * (r % 22), 1};
    else if ((r -= 176) < 88) t = TileDesc{a.in[6] + (size_t)l * DFF * 1024, (bf16*)(wl + OW_OUT1), DFF, 1024, 128 * (r / 4), 256 * (r % 4), 0};
    else if ((r -= 88) < 48) { const int nb = r % 6; t = TileDesc{a.in[8] + (size_t)l * 1024 * PIN, (bf16*)(wl + OW_MIX), 1024, PIN, 128 * (r / 6), 256 * (nb < 2 ? nb : nb + 1), 0}; }
    else if ((r -= 48) < 32) t = TileDesc{a.in[25] + (size_t)l * 1024 * 1024, (bf16*)(wl + OW_MO), 1024, 1024, 128 * (r / 4), 256 * (r % 4), 0};
    else if ((r -= 32) < 176) t = TileDesc{a.in[27] + (size_t)l * 1024 * 5632, (bf16*)(wl + OW_IN2), 1024, 5632, 128 * (r / 22), 256 * (r % 22), 1};
    else if ((r -= 176) < 88) t = TileDesc{a.in[28] + (size_t)l * DFF * 1024, (bf16*)(wl + OW_OUT2), DFF, 1024, 128 * (r / 4), 256 * (r % 4), 0};
    else { r -= 88; t = TileDesc{a.in[22] + (size_t)l * 65536, (bf16*)(wl + OW_GLU), 256, 256, 128 * r, 0, 0}; }
    return t;
}
__device__ __forceinline__ void tile_load(const TileDesc& t, float (&v)[16][4], int wave, int lane) {
    const float* wp = t.W + (size_t)(t.k0 + 16 * wave) * t.N + t.n0 + lane;
#pragma unroll
    for (int r = 0; r < 16; ++r)
#pragma unroll
        for (int e = 0; e < 4; ++e) v[r][e] = __builtin_nontemporal_load(wp + (size_t)r * t.N + 64 * e);
}
__device__ __forceinline__ void tile_to_lds(const float (&v)[16][4], LAS unsigned char* lds, int wave, int lane) {
#pragma unroll
    for (int e = 0; e < 4; ++e)
#pragma unroll
        for (int hq = 0; hq < 2; ++hq) { u32x4 o; o.x = cvt_pk_bf16(v[8 * hq][e], v[8 * hq + 1][e]); o.y = cvt_pk_bf16(v[8 * hq + 2][e], v[8 * hq + 3][e]); o.z = cvt_pk_bf16(v[8 * hq + 4][e], v[8 * hq + 5][e]); o.w = cvt_pk_bf16(v[8 * hq + 6][e], v[8 * hq + 7][e]);
            *(LAS u32x4*)(lds + (lane + 64 * e) * 272 + (16 * wave + 8 * hq) * 2) = o; }
}
__device__ __forceinline__ void tile_store(const TileDesc& t, LAS unsigned char* lds, int wave, int lane) {
#pragma unroll
    for (int j = 0; j < 8; ++j) { const int nl = 32 * wave + 4 * j + (lane >> 4), n = t.n0 + nl;
        const u32x4 o = *(const LAS u32x4*)(lds + nl * 272 + 16 * (lane & 15));
        const int dsw = n < DFF ? (n >> 7) * 256 + (n & 127) : ((n - DFF) >> 7) * 256 + 128 + ((n - DFF) & 127);
        const int dst = t.swiglu ? dsw : n;
        *(u32x4*)(t.WT + (size_t)dst * t.K + t.k0 + 8 * (lane & 15)) = o; }
}

__device__ __forceinline__ void prep_phase(ArgsRef a, LAS unsigned char* lds, int tid, int wave, int lane, int G) {
    LAS float* sc = (LAS float*)lds;
    LAS float* R = (LAS float*)(lds + 32768);
    float* cond = (float*)(a.ws + WS_COND);
    const bool cond_blk = (G >= 256) ? (blockIdx.x < 144) : true;
    if (cond_blk) {
        const float* c_in = a.in[1];
        for (int i = tid; i < 8 * 1024; i += 512) { const float v = c_in[i]; sc[i] = v / (1.0f + expf(-v)); }
        __syncthreads();
        for (int it = blockIdx.x; it < NL * 36; it += (G >= 256 ? 144 : G)) {
            const int l = it / 36, n0 = 256 * (it % 36);
            const float* wp = a.in[2] + ((size_t)l * 1024 + 128 * wave) * NCOND + n0 + 4 * lane;
            f32x4 acc[8];
#pragma unroll
            for (int b = 0; b < 8; ++b) acc[b] = (f32x4){0.f, 0.f, 0.f, 0.f};
            f32x4 wv[8], wn[8];
#pragma unroll
            for (int kk = 0; kk < 8; ++kk) wv[kk] = __builtin_nontemporal_load((const f32x4*)(wp + (size_t)kk * NCOND));
            for (int k0 = 0; k0 < 128; k0 += 8) {
                if (k0 + 8 < 128) {
#pragma unroll
                    for (int kk = 0; kk < 8; ++kk) wn[kk] = __builtin_nontemporal_load((const f32x4*)(wp + (size_t)(k0 + 8 + kk) * NCOND));
                }
#pragma unroll
                for (int q = 0; q < 2; ++q)
#pragma unroll
                    for (int b = 0; b < 8; ++b) { const f32x4 s4 = *(const LAS f32x4*)(sc + b * 1024 + 128 * wave + k0 + 4 * q);
#pragma unroll
                        for (int e = 0; e < 4; ++e) acc[b] += wv[4 * q + e] * s4[e]; }
#pragma unroll
                for (int kk = 0; kk < 8; ++kk) wv[kk] = wn[kk];
            }
#pragma unroll
            for (int b = 0; b < 8; ++b) *(LAS f32x4*)(R + (wave * 8 + b) * 256 + 4 * lane) = acc[b];
            __syncthreads();
            { const int b = wave; f32x4 s = *(const f32x4*)(a.in[3] + (size_t)l * NCOND + n0 + 4 * lane);
#pragma unroll
              for (int w = 0; w < 8; ++w) s += *(const LAS f32x4*)(R + (w * 8 + b) * 256 + 4 * lane);
              *(f32x4*)(cond + ((size_t)l * 8 + b) * NCOND + n0 + 4 * lane) = s; }
            __syncthreads();
        }
    }
    int first, stride, count;
    if (G >= 256) { if (blockIdx.x < 144) { first = blockIdx.x * 7; stride = 1; count = 7; } else { count = (NL * TILES_PER_LAYER - 1008 + (G - 144) - 1) / (G - 144); first = 1008 + (blockIdx.x - 144) * count; stride = 1; } }
    else { first = blockIdx.x; stride = G; count = (NL * TILES_PER_LAYER + G - 1) / G; }
    for (int rp = 0; rp < PREP_TILE_REP; ++rp)
    {
        int lim = NL * TILES_PER_LAYER; if (G >= 256 && blockIdx.x < 144) lim = 1008;
        int nt = 0; for (int j = 0; j < count; ++j) if (first + j * stride < lim) nt = j + 1;
        float v[16][4];
        TileDesc cur = tile_decode(a, nt > 0 ? first : 0);
        if (nt > 0) tile_load(cur, v, wave, lane);
        for (int j = 0; j < nt; ++j) {
            tile_to_lds(v, lds, wave, lane);
            TileDesc nxt = cur;
            if (j + 1 < nt) { nxt = tile_decode(a, first + (j + 1) * stride); tile_load(nxt, v, wave, lane); }
            __syncthreads();
            tile_store(cur, lds, wave, lane);
            __syncthreads();
            cur = nxt;
        }
    }
    const int gw = blockIdx.x * 8 + wave, NGW = G * 8;
    LAS float* F = (LAS float*)(lds + wave * 2048);
    for (int item = gw; item < NL * 512; item += NGW) {
        const int l = item >> 9, r = item & 511, kb = r >> 5, n8 = r & 31, g = n8 >> 3, d0 = 8 * (n8 & 7), k = 64 * kb + lane;
        unsigned char* wl = a.ws + WS_W + (size_t)l * LW;
        const float* pw = a.in[11] + (size_t)(l * 4 + g) * 4096 + (size_t)lane * 64 + d0;
        const f32x4 p0 = *(const f32x4*)pw, p1 = *(const f32x4*)(pw + 4);
        const float* wr = a.in[8] + ((size_t)l * 1024 + k) * PIN + 512 + 64 * g;
        f32x4 wrow[16];
#pragma unroll
        for (int j = 0; j < 16; ++j) wrow[j] = *(const f32x4*)(wr + 4 * j);
        const float* ps = a.in[12] + (size_t)l * 256 + 64 * g + d0;
        const f32x4 s0 = *(const f32x4*)ps, s1 = *(const f32x4*)(ps + 4);
        *(LAS f32x4*)(F + lane * 8) = p0; *(LAS f32x4*)(F + lane * 8 + 4) = p1;
        LDS_WAIT();
        f32x4 a0 = (f32x4){0.f, 0.f, 0.f, 0.f}, a1 = a0;
#pragma unroll
        for (int j = 0; j < 16; ++j)
#pragma unroll
            for (int e = 0; e < 4; ++e) { const int c = 4 * j + e; const f32x4 f0 = *(const LAS f32x4*)(F + c * 8), f1 = *(const LAS f32x4*)(F + c * 8 + 4);
                a0 += f0 * wrow[j][e]; a1 += f1 * wrow[j][e]; }
        a0 = a0 * s0; a1 = a1 * s1;
        bf16* WT = (bf16*)(wl + OW_MIX) + (size_t)(512 + 64 * g + d0) * 1024 + k;
#pragma unroll
        for (int i = 0; i < 4; ++i) { WT[(size_t)i * 1024] = (bf16)(cvt_pk_bf16(a0[i], 0.f) & 0xffffu); WT[(size_t)(4 + i) * 1024] = (bf16)(cvt_pk_bf16(a1[i], 0.f) & 0xffffu); }
        LDS_WAIT();
    }
}

__device__ __forceinline__ void norm_phase(const float* x, const float* g, const float* sh, const float* scl, bf16* h, bf16* xb, int gw, int NGW, int lane) {
    for (int row0 = 2 * gw; row0 < M; row0 += 2 * NGW) {
        f32x4 v[2][4]; float s[2];
#pragma unroll
        for (int r = 0; r < 2; ++r) { const f32x4* xr = (const f32x4*)(x + (size_t)(row0 + r) * D) + lane;
#pragma unroll
            for (int j = 0; j < 4; ++j) v[r][j] = xr[64 * j]; }
#pragma unroll
        for (int r = 0; r < 2; ++r) { float q = 0.f;
#pragma unroll
            for (int j = 0; j < 4; ++j) q += (v[r][j][0] * v[r][j][0] + v[r][j][1] * v[r][j][1]) + (v[r][j][2] * v[r][j][2] + v[r][j][3] * v[r][j][3]);
            s[r] = q; }
        s[0] = wave_sum(s[0]); s[1] = wave_sum(s[1]);
        const size_t cb = (size_t)(row0 >> 11) * NCOND;
#pragma unroll
        for (int j = 0; j < 4; ++j) { const int col = 4 * lane + 256 * j;
            const f32x4 gg = *(const f32x4*)(g + col) * (*(const f32x4*)(scl + cb + col) + 1.0f), hh = *(const f32x4*)(sh + cb + col);
#pragma unroll
            for (int r = 0; r < 2; ++r) { const float rstd = 1.0f / sqrtf(s[r] * (1.0f / D) + EPS);
                const f32x4 y = (v[r][j] * rstd) * gg + hh;
                u32x2 w; w.x = cvt_pk_bf16(y[0], y[1]); w.y = cvt_pk_bf16(y[2], y[3]); ((u32x2*)(h + (size_t)(row0 + r) * D) + lane)[64 * j] = w;
                u32x2 wx; wx.x = cvt_pk_bf16(v[r][j][0], v[r][j][1]); wx.y = cvt_pk_bf16(v[r][j][2], v[r][j][3]); ((u32x2*)(xb + (size_t)(row0 + r) * D) + lane)[64 * j] = wx; } }
    }
}
__device__ __forceinline__ void final_norm_phase(float* x, const float* g, int gw, int NGW, int lane) {
    for (int row = gw; row < M; row += NGW) {
        f32x4* xr = (f32x4*)(x + (size_t)row * D) + lane;
        f32x4 v[4]; float s = 0.f;
#pragma unroll
        for (int j = 0; j < 4; ++j) { v[j] = xr[64 * j]; s += (v[j][0] * v[j][0] + v[j][1] * v[j][1]) + (v[j][2] * v[j][2] + v[j][3] * v[j][3]); }
        const float rstd = 1.0f / sqrtf(wave_sum(s) * (1.0f / D) + EPS);
#pragma unroll
        for (int j = 0; j < 4; ++j) { const f32x4 gg = *(const f32x4*)(g + 4 * lane + 256 * j); xr[64 * j] = v[j] * rstd * gg; }
    }
}

__device__ __forceinline__ f32x4 ld4bf(const bf16* p) { const u32x2 w = *(const u32x2*)p; return (f32x4){bf_lo(w.x), bf_hi(w.x), bf_lo(w.y), bf_hi(w.y)}; }
__device__ __forceinline__ void st4bf(bf16* p, f32x4 v) { u32x2 w; w.x = cvt_pk_bf16(v[0], v[1]); w.y = cvt_pk_bf16(v[2], v[3]); *(u32x2*)p = w; }
__device__ __forceinline__ bf16x8 pack8(f32x4 lo, f32x4 hi) { u32x4 w; w.x = cvt_pk_bf16(lo[0], lo[1]); w.y = cvt_pk_bf16(lo[2], lo[3]); w.z = cvt_pk_bf16(hi[0], hi[1]); w.w = cvt_pk_bf16(hi[2], hi[3]); return __builtin_bit_cast(bf16x8, w); }

__device__ __forceinline__ void sgu_item(ArgsRef a, int l, int it, LAS unsigned char* lds, int tid, int wave, int lane) {
    const bf16* z = (const bf16*)(a.ws + WS_Z); bf16* ycat = (bf16*)(a.ws + WS_YCAT);
    LAS bf16* vT = (LAS bf16*)lds;
    const int tok0 = it * 128;
    { const int s = tid >> 2, q = tid & 3;
      u32x4 raw[4][2];
#pragma unroll
      for (int h = 0; h < 4; ++h) { const u32x4* zp = (const u32x4*)(z + (size_t)(tok0 + s) * PIN + 256 + 64 * h + 16 * q); raw[h][0] = zp[0]; raw[h][1] = zp[1]; }
#pragma unroll
      for (int h = 0; h < 4; ++h) {
          float v[16]; float sum = 0.f;
#pragma unroll
          for (int j = 0; j < 2; ++j) { const u32x4 rw = raw[h][j]; const unsigned ww[4] = {rw.x, rw.y, rw.z, rw.w};
#pragma unroll
              for (int e = 0; e < 4; ++e) { v[8 * j + 2 * e] = gelu_tanh(bf_lo(ww[e])); v[8 * j + 2 * e + 1] = gelu_tanh(bf_hi(ww[e])); sum += v[8 * j + 2 * e] + v[8 * j + 2 * e + 1]; } }
          sum += __shfl_xor(sum, 1); sum += __shfl_xor(sum, 2);
          const float mu = sum * (1.0f / 64.0f); float q2 = 0.f;
#pragma unroll
          for (int e = 0; e < 16; ++e) { v[e] -= mu; q2 += v[e] * v[e]; }
          q2 += __shfl_xor(q2, 1); q2 += __shfl_xor(q2, 2);
          const float rs = 1.0f / sqrtf(q2 * (1.0f / 64.0f) + EPS);
#pragma unroll
          for (int e = 0; e < 16; ++e) vT[(64 * h + 16 * q + e) * 136 + s] = (bf16)(cvt_pk_bf16(v[e] * rs, 0.f) & 0xffffu);
      } }
    __syncthreads();
    const int fr = lane & 15, fq = lane >> 4, t = 16 * wave + fr, nks = (wave >> 1) + 1;
    f32x4 acc[16];
#pragma unroll
    for (int i = 0; i < 16; ++i) acc[i] = (f32x4){0.f, 0.f, 0.f, 0.f};
    {
        const float* wbase = a.in[9] + ((size_t)(l * 4) * 128 + t) * 128 + 8 * fq;
        f32x4 wq[2][4][2];
#pragma unroll
        for (int ks = 0; ks < 4; ++ks) { wq[0][ks][0] = (f32x4){0.f, 0.f, 0.f, 0.f}; wq[0][ks][1] = wq[0][ks][0];
            if (ks < nks) { wq[0][ks][0] = *(const f32x4*)(wbase + 32 * ks); wq[0][ks][1] = *(const f32x4*)(wbase + 32 * ks + 4); } }
#pragma unroll
        for (int h = 0; h < 4; ++h) {
            if (h < 3) {
#pragma unroll
                for (int ks = 0; ks < 4; ++ks) { wq[(h + 1) & 1][ks][0] = (f32x4){0.f, 0.f, 0.f, 0.f}; wq[(h + 1) & 1][ks][1] = wq[(h + 1) & 1][ks][0];
                    if (ks < nks) { wq[(h + 1) & 1][ks][0] = *(const f32x4*)(wbase + (size_t)(h + 1) * 16384 + 32 * ks); wq[(h + 1) & 1][ks][1] = *(const f32x4*)(wbase + (size_t)(h + 1) * 16384 + 32 * ks + 4); } }
            }
#pragma unroll
            for (int ks = 0; ks < 4; ++ks) if (ks < nks) {
                f32x4 w0 = wq[h & 1][ks][0], w1 = wq[h & 1][ks][1];
                const int s0 = 32 * ks + 8 * fq;
#pragma unroll
                for (int e = 0; e < 4; ++e) { if (s0 + e > t) w0[e] = 0.f; if (s0 + 4 + e > t) w1[e] = 0.f; }
                const bf16x8 wf = pack8(w0, w1);
#pragma unroll
                for (int dt = 0; dt < 4; ++dt) { const bf16x8 vf = *(const LAS bf16x8*)(vT + (64 * h + 16 * dt + fr) * 136 + 32 * ks + 8 * fq);
                    acc[h * 4 + dt] = __builtin_amdgcn_mfma_f32_16x16x32_bf16(vf, wf, acc[h * 4 + dt], 0, 0, 0); }
            }
        }
    }
    const size_t tok = (size_t)tok0 + t; float ss = 0.f;
#pragma unroll
    for (int h = 0; h < 4; ++h) { const float bias = a.in[10][(size_t)(l * 4 + h) * 128 + t];
#pragma unroll
        for (int dt = 0; dt < 4; ++dt) { const f32x4 u4 = ld4bf(z + tok * PIN + 64 * h + 16 * dt + 4 * fq); f32x4 o;
#pragma unroll
            for (int e = 0; e < 4; ++e) { o[e] = gelu_tanh(u4[e]) * (acc[h * 4 + dt][e] + bias); ss += o[e] * o[e]; }
            acc[h * 4 + dt] = o; } }
    ss += __shfl_xor(ss, 16); ss += __shfl_xor(ss, 32);
    const float rstd = 1.0f / sqrtf(ss * (1.0f / 256.0f) + EPS);
    const float* gn = a.in[24] + (size_t)l * 1024;
#pragma unroll
    for (int h = 0; h < 4; ++h)
#pragma unroll
        for (int dt = 0; dt < 4; ++dt) { const int ch = 64 * h + 16 * dt + 4 * fq; const f32x4 gg = *(const f32x4*)(gn + ch);
            st4bf(ycat + tok * 1024 + ch, acc[h * 4 + dt] * rstd * gg); }
    __syncthreads();
}

__device__ __forceinline__ void sincos_red(float ang, float& sn, float& cs) {
    const float n = rintf(ang * 0.15915494309189535f);
    float r = fmaf(-n, 6.2831854820251465f, ang); r = fmaf(-n, -1.7484556e-7f, r);
    const float h = 0.5f * r, h2 = h * h;
    const float s = h * (1.0f + h2 * (-1.6666667e-1f + h2 * (8.3333333e-3f + h2 * (-1.9841270e-4f + h2 * (2.7557319e-6f + h2 * (-2.5052108e-8f))))));
    const float c = 1.0f + h2 * (-0.5f + h2 * (4.1666667e-2f + h2 * (-1.3888889e-3f + h2 * (2.4801587e-5f + h2 * (-2.7557319e-7f + h2 * 2.0876757e-9f)))));
    sn = 2.0f * s * c; cs = 1.0f - 2.0f * s * s;
}

template <int PASS>
__device__ __forceinline__ void s5_span(const bf16* zu, bf16* ygp, LAS float* BU, LAS bf16* Xs, const bf16x8 (&bfrag)[8], const bf16x8 (&cf)[4], f32x4 dd, float are, float aim, float& xr, float& xi, int lane) {
    const int p = lane, fr = lane & 15, fq = lane >> 4;
    bf16x8 uf_n = (bf16x8){0, 0, 0, 0, 0, 0, 0, 0}; u32x2 u4_n = (u32x2){0u, 0u};
    if (fq < 2) uf_n = *(const bf16x8*)(zu + 8 * fq);
    if (PASS == 2) u4_n = *(const u32x2*)(zu + 4 * fq);
    for (int blk = 0; blk < 16; ++blk) {
        const bf16x8 uf = uf_n; const u32x2 u4w = u4_n;
        if (blk < 15) { const bf16* zn = zu + (size_t)(16 * (blk + 1)) * PIN;
            if (fq < 2) uf_n = *(const bf16x8*)(zn + 8 * fq);
            if (PASS == 2) u4_n = *(const u32x2*)(zn + 4 * fq); }
#pragma unroll
        for (int n = 0; n < 8; ++n) { const f32x4 acc = __builtin_amdgcn_mfma_f32_16x16x32_bf16(bfrag[n], uf, (f32x4){0.f, 0.f, 0.f, 0.f}, 0, 0, 0);
            *(LAS f32x4*)(BU + fr * 132 + 16 * n + 4 * fq) = acc; }
        LDS_WAIT();
#pragma unroll
        for (int t = 0; t < 16; ++t) { const float bur = BU[t * 132 + p], bui = BU[t * 132 + 64 + p];
            const float tr = are * xr - aim * xi + bur, ti = are * xi + aim * xr + bui; xr = tr; xi = ti;
            if (PASS == 2) { const unsigned w = cvt_pk_bf16(xr, xi); Xs[t * 136 + p] = (bf16)(w & 0xffffu); Xs[t * 136 + 64 + p] = (bf16)(w >> 16); } }
        if (PASS == 2) {
            LDS_WAIT();
            f32x4 acc = (f32x4){0.f, 0.f, 0.f, 0.f};
#pragma unroll
            for (int ks = 0; ks < 4; ++ks) { const bf16x8 xf = *(const LAS bf16x8*)(Xs + fr * 136 + 32 * ks + 8 * fq);
                acc = __builtin_amdgcn_mfma_f32_16x16x32_bf16(cf[ks], xf, acc, 0, 0, 0); }
            const f32x4 u4 = (f32x4){bf_lo(u4w.x), bf_hi(u4w.x), bf_lo(u4w.y), bf_hi(u4w.y)}; f32x4 y;
#pragma unroll
            for (int e = 0; e < 4; ++e) y[e] = gelu_tanh(acc[e] + dd[e] * u4[e]);
            st4bf(ygp + (size_t)(16 * blk) * 256, y);
        }
        asm volatile("s_waitcnt lgkmcnt(0)" ::: );
    }
}
__device__ __forceinline__ void s5_wg_item(ArgsRef a, int l, int bi, LAS unsigned char* lds, int wave, int lane) {
    const int g = bi & 15, b = bi >> 4, p = lane, fr = lane & 15, fq = lane >> 4;
    const bf16* z = (const bf16*)(a.ws + WS_Z);
    const int lg = l * 16 + g;
    const float dt = expf(a.in[21][lg]);
    const float lre = a.in[14][(size_t)lg * 64 + p], lim = a.in[15][(size_t)lg * 64 + p];
    const float mag = expf(lre * dt); float sn, cs; sincos_red(lim * dt, sn, cs);
    const float are = mag * cs, aim = mag * sn, nr = are - 1.0f, ni = aim, den = lre * lre + lim * lim;
    const float kre = (nr * lre + ni * lim) / den, kim = (ni * lre - nr * lim) / den;
    bf16x8 bfrag[8];
#pragma unroll
    for (int nn = 0; nn < 4; ++nn) { const int pp = 16 * nn + fr; const float kr = __shfl(kre, pp), ki = __shfl(kim, pp);
        const float* brp = a.in[16] + ((size_t)lg * 64 + pp) * 16 + 8 * (fq & 1); const float* bip = a.in[17] + ((size_t)lg * 64 + pp) * 16 + 8 * (fq & 1);
        const f32x4 br0 = *(const f32x4*)brp, br1 = *(const f32x4*)(brp + 4), bi0 = *(const f32x4*)bip, bi1 = *(const f32x4*)(bip + 4);
        bf16x8 fre = pack8(br0 * kr - bi0 * ki, br1 * kr - bi1 * ki), fim = pack8(bi0 * kr + br0 * ki, bi1 * kr + br1 * ki);
        if (fq >= 2) { fre = (bf16x8){0, 0, 0, 0, 0, 0, 0, 0}; fim = fre; }
        bfrag[nn] = fre; bfrag[nn + 4] = fim; }
    const size_t tok0 = (size_t)b * 2048 + 256 * wave;
    const bf16* zu = z + (tok0 + fr) * PIN + 1536 + 16 * g;
    bf16* ygp = (bf16*)(a.ws + WS_YG) + (tok0 + fr) * 256 + 16 * g + 4 * fq;
    LAS float* BU = (LAS float*)(lds + wave * 12800);
    LAS bf16* Xs = (LAS bf16*)(lds + wave * 12800 + 8448);
    LAS float* EX = (LAS float*)(lds + 102400);
    bf16x8 cf[4]; f32x4 dd = (f32x4){0.f, 0.f, 0.f, 0.f};
#pragma unroll
    for (int ks = 0; ks < 4; ++ks) cf[ks] = (bf16x8){0, 0, 0, 0, 0, 0, 0, 0};
    float xr = 0.f, xi = 0.f;
    s5_span<1>(zu, ygp, BU, Xs, bfrag, cf, dd, are, aim, xr, xi, lane);
    EX[wave * 128 + p] = xr; EX[wave * 128 + 64 + p] = xi;
    __syncthreads();
    {   float Ar = are, Ai = aim;
#pragma unroll
        for (int q = 0; q < 8; ++q) { const float tr = Ar * Ar - Ai * Ai, ti = 2.0f * Ar * Ai; Ar = tr; Ai = ti; }
        xr = 0.f; xi = 0.f;
#pragma unroll
        for (int w = 0; w < 7; ++w) if (w < wave) { const float er = EX[w * 128 + p], ei = EX[w * 128 + 64 + p];
            const float tr = Ar * xr - Ai * xi + er, ti = Ar * xi + Ai * xr + ei; xr = tr; xi = ti; }
    }
#pragma unroll
    for (int ks = 0; ks < 4; ++ks) { const float* cp = (ks < 2 ? a.in[18] : a.in[19]) + ((size_t)lg * 16 + fr) * 64 + 32 * (ks & 1) + 8 * fq;
        f32x4 c0 = *(const f32x4*)cp, c1 = *(const f32x4*)(cp + 4); if (ks >= 2) { c0 = -c0; c1 = -c1; } cf[ks] = pack8(c0, c1); }
    dd = *(const f32x4*)(a.in[20] + (size_t)l * 256 + 16 * g + 4 * fq);
    s5_span<2>(zu, ygp, BU, Xs, bfrag, cf, dd, are, aim, xr, xi, lane);
    __syncthreads();
}

__device__ __forceinline__ void poolconv_item(ArgsRef a, int l, int idx, int lane) {
    const bf16* z = (const bf16*)(a.ws + WS_Z); bf16* ycat = (bf16*)(a.ws + WS_YCAT);
    const int tokb = idx * 8, pos0 = tokb & 2047, ch = 4 * lane, gq = lane >> 4, wq = 2 << gq;
    const float m1 = gq >= 1 ? 1.0f : 0.0f, m2 = gq >= 2 ? 1.0f : 0.0f, m3 = gq >= 3 ? 1.0f : 0.0f;
    const float* gn = a.in[24] + (size_t)l * 1024;
    {   f32x4 row[23];
        const bf16* zp = z + (size_t)tokb * PIN + 512 + ch;
#pragma unroll
        for (int r = 0; r < 23; ++r) { row[r] = (f32x4){0.f, 0.f, 0.f, 0.f}; if (pos0 - 15 + r >= 0) row[r] = ld4bf(zp + (ptrdiff_t)(r - 15) * PIN); }
        const f32x4 gg = *(const f32x4*)(gn + 256 + ch);
#pragma unroll
        for (int tt = 0; tt < 8; ++tt) {
            f32x4 sum = row[15 + tt] + row[14 + tt];
            sum += (row[13 + tt] + row[12 + tt]) * m1;
            sum += ((row[11 + tt] + row[10 + tt]) + (row[9 + tt] + row[8 + tt])) * m2;
            sum += (((row[7 + tt] + row[6 + tt]) + (row[5 + tt] + row[4 + tt])) + ((row[3 + tt] + row[2 + tt]) + (row[1 + tt] + row[tt]))) * m3;
            const int pos = pos0 + tt, cnt = (pos + 1 < wq) ? pos + 1 : wq;
            const f32x4 o = sum * (1.0f / (float)cnt) - row[15 + tt];
            const float ss = wave_sum((o[0] * o[0] + o[1] * o[1]) + (o[2] * o[2] + o[3] * o[3]));
            const float rstd = 1.0f / sqrtf(ss * (1.0f / 256.0f) + EPS);
            st4bf(ycat + (size_t)(tokb + tt) * 1024 + 256 + ch, o * rstd * gg); }
    }
    {   f32x4 prod[10], bg[8];
        const bf16* zp = z + (size_t)tokb * PIN + 768 + ch;
#pragma unroll
        for (int r = 0; r < 10; ++r) { prod[r] = (f32x4){0.f, 0.f, 0.f, 0.f}; if (pos0 - 2 + r >= 0) prod[r] = ld4bf(zp + (ptrdiff_t)(r - 2) * PIN + 256) * ld4bf(zp + (ptrdiff_t)(r - 2) * PIN + 512); }
#pragma unroll
        for (int tt = 0; tt < 8; ++tt) bg[tt] = ld4bf(zp + (size_t)tt * PIN);
        const f32x4 w0 = *(const f32x4*)(a.in[13] + ((size_t)l * 3 + 0) * 256 + ch), w1 = *(const f32x4*)(a.in[13] + ((size_t)l * 3 + 1) * 256 + ch), w2 = *(const f32x4*)(a.in[13] + ((size_t)l * 3 + 2) * 256 + ch);
        const f32x4 gg = *(const f32x4*)(gn + 512 + ch);
#pragma unroll
        for (int tt = 0; tt < 8; ++tt) {
            const f32x4 o = bg[tt] * (w0 * prod[tt] + w1 * prod[tt + 1] + w2 * prod[tt + 2]);
            const float ss = wave_sum((o[0] * o[0] + o[1] * o[1]) + (o[2] * o[2] + o[3] * o[3]));
            const float rstd = 1.0f / sqrtf(ss * (1.0f / 256.0f) + EPS);
            st4bf(ycat + (size_t)(tokb + tt) * 1024 + 512 + ch, o * rstd * gg); }
    }
}

__device__ __forceinline__ void glu_item(ArgsRef a, int l, int it, LAS unsigned char* lds, int tid, int wave, int lane) {
    const bf16* yg = (const bf16*)(a.ws + WS_YG) + (size_t)it * 64 * 256; bf16* ycat = (bf16*)(a.ws + WS_YCAT) + (size_t)it * 64 * 1024 + 768;
    const bf16* Bt = (const bf16*)(a.ws + WS_W + (size_t)l * LW + OW_GLU);
    LAS unsigned char* T = lds;
    LAS float* P = (LAS float*)(lds + 34816);
    const int fr = lane & 15, fq = lane >> 4, n0 = 32 * wave;
    u32x4 st[4];
#pragma unroll
    for (int j = 0; j < 4; ++j) { const int idx = tid + 512 * j; st[j] = *(const u32x4*)(yg + (size_t)(idx >> 5) * 256 + 8 * (idx & 31)); }
    bf16x8 bfr[2][8];
#pragma unroll
    for (int nt = 0; nt < 2; ++nt)
#pragma unroll
        for (int ks = 0; ks < 8; ++ks) bfr[nt][ks] = *(const bf16x8*)(Bt + (size_t)(n0 + 16 * nt + fr) * 256 + 32 * ks + 8 * fq);
#pragma unroll
    for (int j = 0; j < 4; ++j) { const int idx = tid + 512 * j; *(LAS u32x4*)(T + (idx >> 5) * 528 + 16 * (idx & 31)) = st[j]; }
    __syncthreads();
    f32x4 acc[4][2];
#pragma unroll
    for (int tt = 0; tt < 4; ++tt) { acc[tt][0] = (f32x4){0.f, 0.f, 0.f, 0.f}; acc[tt][1] = acc[tt][0]; }
#pragma unroll
    for (int ks = 0; ks < 8; ++ks)
#pragma unroll
        for (int tt = 0; tt < 4; ++tt) { const bf16x8 af = *(const LAS bf16x8*)(T + (16 * tt + fr) * 528 + (32 * ks + 8 * fq) * 2);
            acc[tt][0] = __builtin_amdgcn_mfma_f32_16x16x32_bf16(bfr[0][ks], af, acc[tt][0], 0, 0, 0);
            acc[tt][1] = __builtin_amdgcn_mfma_f32_16x16x32_bf16(bfr[1][ks], af, acc[tt][1], 0, 0, 0); }
    const f32x4 gb0 = *(const f32x4*)(a.in[23] + (size_t)l * 256 + n0 + 4 * fq), gb1 = *(const f32x4*)(a.in[23] + (size_t)l * 256 + n0 + 16 + 4 * fq);
#pragma unroll
    for (int tt = 0; tt < 4; ++tt) { float ss = 0.f;
#pragma unroll
        for (int nt = 0; nt < 2; ++nt) { const u32x2 yw = *(const LAS u32x2*)(T + (16 * tt + fr) * 528 + (n0 + 16 * nt + 4 * fq) * 2);
            const f32x4 y = (f32x4){bf_lo(yw.x), bf_hi(yw.x), bf_lo(yw.y), bf_hi(yw.y)}; const f32x4 g4 = nt ? gb1 : gb0; f32x4 o;
#pragma unroll
            for (int e = 0; e < 4; ++e) { o[e] = y[e] * pg8::sigmoid_f(acc[tt][nt][e] + g4[e]); ss += o[e] * o[e]; }
            acc[tt][nt] = o; }
        ss += __shfl_xor(ss, 16); ss += __shfl_xor(ss, 32);
        if (fq == 0) P[(16 * tt + fr) * 8 + wave] = ss; }
    __syncthreads();
    const float* gn = a.in[24] + (size_t)l * 1024 + 768;
    const f32x4 gg0 = *(const f32x4*)(gn + n0 + 4 * fq), gg1 = *(const f32x4*)(gn + n0 + 16 + 4 * fq);
#pragma unroll
    for (int tt = 0; tt < 4; ++tt) { const int t = 16 * tt + fr; const f32x4 p0 = *(const LAS f32x4*)(P + t * 8), p1 = *(const LAS f32x4*)(P + t * 8 + 4);
        const float rstd = __builtin_amdgcn_rsqf((((p0[0] + p0[1]) + (p0[2] + p0[3])) + ((p1[0] + p1[1]) + (p1[2] + p1[3]))) * (1.0f / 256.0f) + EPS);
        st4bf(ycat + (size_t)t * 1024 + n0 + 4 * fq, acc[tt][0] * rstd * gg0); st4bf(ycat + (size_t)t * 1024 + n0 + 16 + 4 * fq, acc[tt][1] * rstd * gg1); }
    __syncthreads();
}

#define XB_TMO      128
#define XB_XCNT(j)  (256  + 64 * (j))
#define XB_XSUB(j)  (1280 + 64 * (j))
#define XB_XGEN(j)  (2304 + 64 * (j))
#define XB_TOP      3328
#define XB_TOPGEN   3392
#define XCD_BAR_WORDS 3456
#define XB_SPIN_CAP (1u << 18)

__device__ __forceinline__ unsigned xb_ld(unsigned* p)              { return __hip_atomic_load(p, __ATOMIC_RELAXED, __HIP_MEMORY_SCOPE_AGENT); }
__device__ __forceinline__ unsigned xb_add(unsigned* p, unsigned v) { return __hip_atomic_fetch_add(p, v, __ATOMIC_RELAXED, __HIP_MEMORY_SCOPE_AGENT); }
__device__ __forceinline__ unsigned xb_xcc_id() { return (unsigned)__builtin_amdgcn_s_getreg((3 << 11) | 20) & 0xFu; }
#define XB_SPIN(cond, bar) do { unsigned _sp = 0; while (cond) { __builtin_amdgcn_s_sleep(1); \
    if ((++_sp & 255u) == 0u) { if (xb_ld(&(bar)[XB_TMO])) break; if (_sp > XB_SPIN_CAP) { atomicAdd(&(bar)[XB_TMO], 1u); break; } } } } while (0)

struct XcdBarrier {
    unsigned* bar; unsigned x;
    volatile LAS unsigned* st;
};

__device__ __forceinline__ XcdBarrier xcd_barrier_post(unsigned* bar, volatile LAS unsigned* st) {
    XcdBarrier b; b.bar = bar; b.x = xb_xcc_id(); b.st = st;
    if (threadIdx.x == 0) (void)xb_add(&bar[XB_XCNT(b.x)], 1u);
    return b;
}
__device__ __forceinline__ void xcd_barrier_complete(unsigned* bar, unsigned x, unsigned& nloc, unsigned& nx) {
    const unsigned G = gridDim.x * gridDim.y * gridDim.z;
    unsigned sum, cnt, mine, sp = 0u;
    for (;;) {
        sum = 0u; cnt = 0u; mine = 0u;
#pragma unroll 1
        for (unsigned j = 0; j < 16; ++j) { const unsigned c = xb_ld(&bar[XB_XCNT(j)]); sum += c; cnt += (c > 0u) ? 1u : 0u; mine = (j == x) ? c : mine; }
        if (sum == G) break;
        __builtin_amdgcn_s_sleep(1);
        if ((++sp & 255u) == 0u) { if (xb_ld(&bar[XB_TMO])) break; if (sp > XB_SPIN_CAP) { atomicAdd(&bar[XB_TMO], 1u); break; } }
    }
    nloc = mine > 0u ? mine : 1u; nx = cnt > 0u ? cnt : 1u;
}

__device__ __forceinline__ void xcd_barrier(const XcdBarrier& b) {
    asm volatile("s_waitcnt vmcnt(0)" ::: "memory");
    __syncthreads();
    if (threadIdx.x == 0) {
        unsigned* bar = b.bar;
        __builtin_amdgcn_s_waitcnt(0);
        unsigned nloc = b.st[0], nx = b.st[1];
        if (nloc == 0u) { xcd_barrier_complete(bar, b.x, nloc, nx); b.st[0] = nloc; b.st[1] = nx; }
        const unsigned old = xb_add(&bar[XB_XSUB(b.x)], 1u);
        const unsigned gen = old / nloc;
        if (old + 1u == (gen + 1u) * nloc) {
            __builtin_amdgcn_fence(__ATOMIC_RELEASE, "agent");
            asm volatile("s_waitcnt vmcnt(0)" ::: "memory");
            const unsigned og = xb_add(&bar[XB_TOP], 1u);
            const unsigned tg = og / nx;
            if (og + 1u == (tg + 1u) * nx) xb_add(&bar[XB_TOPGEN], 1u);
            else XB_SPIN(xb_ld(&bar[XB_TOPGEN]) == tg, bar);
            __builtin_amdgcn_fence(__ATOMIC_ACQUIRE, "agent");
            xb_add(&bar[XB_XGEN(b.x)], 1u);
            asm volatile("s_waitcnt vmcnt(0)" ::: "memory");
        } else {
            XB_SPIN(xb_ld(&bar[XB_XGEN(b.x)]) == gen, bar);
            __builtin_amdgcn_fence(__ATOMIC_ACQUIRE, "agent");
            asm volatile("s_waitcnt vmcnt(0)" ::: "memory");
        }
    }
    __syncthreads();
}

#ifndef SYNC_REP
#define SYNC_REP 1
#endif
#ifndef REP_MASK
#define REP_MASK 0
#endif
#ifndef PHM
#define PHM 0xfff
#endif
#ifndef PER_PHASE_LAUNCH
#define PER_PHASE_LAUNCH 0
#endif
__global__ void __launch_bounds__(512) mega(Args a_) {
    extern __shared__ __attribute__((aligned(16))) unsigned char lds_raw[];
    LAS unsigned char* lds = (LAS unsigned char*)lds_raw;
    const int G = gridDim.x, NGW = G * 8;
    const int ph_lo = a_.ph_lo, ph_hi = a_.ph_hi;
    const bool multi = (ph_hi - ph_lo) > 1;
    unsigned char* const ws0 = a_.ws;
    volatile LAS unsigned* MISC = (volatile LAS unsigned*)(lds + 131072 + 320);
    if (threadIdx.x < 32) MISC[threadIdx.x] = 0u;
    __syncthreads();
    XcdBarrier bar; bar.bar = (unsigned*)(ws0 + WS_BAR); bar.x = 0; bar.st = nullptr;
    if (multi) bar = xcd_barrier_post((unsigned*)(ws0 + WS_BAR), MISC + 8);
    if (ph_lo < 0) cg::this_grid().sync();
    unsigned long long tacc = 0ull;
    for (int ph = ph_lo; ph < ph_hi; ++ph) {
        const unsigned long long tph0 = TPROBE ? __builtin_amdgcn_s_memrealtime() : 0ull;
        int tid = threadIdx.x; asm volatile("" : "+v"(tid));
        const int lane = tid & 63, wave = __builtin_amdgcn_readfirstlane(tid >> 6), gw = blockIdx.x * 8 + wave;
        const Args __attribute__((address_space(4)))* ap = (const Args __attribute__((address_space(4)))*)__builtin_amdgcn_kernarg_segment_ptr(); asm volatile("" : "+s"(ap));
        ArgsRef a = *ap;
        unsigned char* ws = a.ws;
        float* cond = (float*)(ws + WS_COND); float* SS = (float*)(ws + WS_SS); const float* SHW = (const float*)(ws + WS_SHW);
        bf16* H = (bf16*)(ws + WS_H); bf16* ACT = (bf16*)(ws + WS_ACT); bf16* Z = (bf16*)(ws + WS_Z); bf16* YG = (bf16*)(ws + WS_YG); bf16* YCAT = (bf16*)(ws + WS_YCAT);
        if (ph == 0) { for (int rp = 0; rp < PREP_REP; ++rp) { if (rp) { XcdBarrier b3 = bar; asm volatile("" : "+s"(b3.bar)); xcd_barrier(b3); } prep_phase(a, lds, tid, wave, lane, G); } }
        else if (ph == 1) norm_phase(a.in[0], a.in[4], cond, cond + 1024, H, (bf16*)(ws + WS_XB), gw, NGW, lane);
        else {
            const int l = (ph - 2) / NSLOT, slot = (ph - 2) % NSLOT, s = (int)((SLOT_MAP >> (4 * slot)) & 15ull); const bool rep = ((SLOT_REP >> slot) & 1u) != 0u;
            unsigned char* wl = ws + WS_W + (size_t)l * LW;
            const float* cl = cond + (size_t)l * 8 * NCOND;
            if ((PHM & 8) && (s == 0 || s == 7)) {
                pg8::Gemm gm{H, (const bf16*)(wl + (s == 0 ? OW_IN1 : OW_IN2)), M, 2 * DFF, D}; pg8::StaticOrder S; S.init(M, 2 * DFF, G, (int)blockIdx.x);
                pg8::EpiSwiglu E{ACT, DFF};
                pg8::gemm_phase<pg8::EpiSwiglu, pg8::StaticOrder>(lds, gm, S, E, nullptr, tid);
            } else if ((PHM & 16) && (s == 1 || s == 6 || s == 8)) {
                const bf16* A = (s == 6) ? YCAT : ACT; const int K = (s == 6) ? D : DFF;
                const bf16* Bt = (const bf16*)(wl + (s == 1 ? OW_OUT1 : (s == 6 ? OW_MO : OW_OUT2)));
                pg8::Gemm gm{A, Bt, M, D, K}; pg8::StaticOrder S; S.init(M, D, G, (int)blockIdx.x);
                bf16* XB = (bf16*)(ws + WS_XB);
                const float* gnext = (s == 1) ? a.in[7] + (size_t)l * D : (s == 6 ? a.in[26] + (size_t)l * D : (l == NL - 1 ? a.in[29] : a.in[4] + (size_t)(l + 1) * D));
                const float* shnext = (s == 1) ? cl + 3 * 1024 : (s == 6 ? cl + 6 * 1024 : cl + (size_t)8 * NCOND);
                const float* scnext = shnext + 1024;
                bf16* xa = (s == 8 && l == NL - 1) ? (bf16*)nullptr : H;
                const float gs = __builtin_bit_cast(float, __builtin_amdgcn_readfirstlane(s == 6 ? 0x3f800000 : 0x3f000000));
                const unsigned need = 32u * (unsigned)(l * 3 + (s == 1 ? 0 : (s == 6 ? 1 : 2)) + 1);
                pg8::EpiResid E{XB, XB, a.out, cl + (s == 1 ? 2 : (s == 6 ? 5 : 8)) * 1024, gnext, scnext, shnext, xa, (unsigned*)(ws + WS_SS), (unsigned*)(ws + WS_BAR + 16384), gs, need};
                pg8::gemm_phase<pg8::EpiResid, pg8::StaticOrder>(lds, gm, S, E, nullptr, tid);
            } else if ((PHM & 32) && s == 2) {
                pg8::Gemm gm{H, (const bf16*)(wl + OW_MIX), M, PIN, D}; pg8::StaticOrder S; S.init(M, PIN, G, (int)blockIdx.x);
                pg8::EpiZ E{Z, PIN};
                pg8::gemm_phase<pg8::EpiZ, pg8::StaticOrder>(lds, gm, S, E, nullptr, tid);
            } else if ((PHM & 64) && s == 3) {
                int w_first = gw, w_stride = NGW;
                if (G >= 256) { w_first = (blockIdx.x < 128) ? blockIdx.x * 8 + wave : 2048; w_stride = 1024; }
                for (int it = blockIdx.x; it < 256; it += G) { if (it < 128) { for (int rq = 0; rq < SGU_REP; ++rq) sgu_item(a, l, it, lds, tid, wave, lane); } else { for (int rq = 0; rq < S5_REP; ++rq) s5_wg_item(a, l, it - 128, lds, wave, lane); } }
                for (int rq = 0; rq < PC_REP; ++rq) for (int idx = w_first; idx < 2048; idx += w_stride) poolconv_item(a, l, idx, lane);
            } else if ((PHM & 256) && s == 5) {
                for (int it = blockIdx.x; it < M / 64; it += G) glu_item(a, l, it, lds, tid, wave, lane);
            }
        }
        if (ph + 1 < ph_hi) { XcdBarrier b2 = bar; asm volatile("" : "+s"(b2.bar)); xcd_barrier(b2); }
        if (TPROBE) { int ty; if (ph == 0) ty = 0; else if (ph == 1) ty = 1; else { const int s_ = (int)((SLOT_MAP >> (4 * ((ph - 2) % NSLOT))) & 15ull); ty = (s_ == 0 || s_ == 7) ? 2 : ((s_ == 1 || s_ == 6 || s_ == 8) ? 3 : (s_ == 2 ? 4 : (s_ == 3 ? 5 : 6))); }
            if ((TPROBE >> ty) & 1) tacc += __builtin_amdgcn_s_memrealtime() - tph0; }
    }
    if (TPROBE) { const unsigned long long te = __builtin_amdgcn_s_memrealtime(); while (__builtin_amdgcn_s_memrealtime() - te < tacc) __builtin_amdgcn_s_sleep(8); }
}

extern "C" void kernel_launch(void* const* d_in, const int* in_sizes, int n_in, void* d_out, int out_size, void* d_ws, size_t ws_size, hipStream_t stream) {
    static int grid = 0;
    if (grid == 0) {
        int dev = 0, cus = 0;
        if (n_in != 30 || ws_size < WS_END || hipGetDevice(&dev) != hipSuccess || hipDeviceGetAttribute(&cus, hipDeviceAttributeMultiprocessorCount, dev) != hipSuccess) { grid = -1; return; }
        if (hipFuncSetAttribute((const void*)mega, hipFuncAttributeMaxDynamicSharedMemorySize, LDS_BYTES) != hipSuccess) { grid = -1; return; }
        int per_cu = 0;
        if (hipOccupancyMaxActiveBlocksPerMultiprocessor(&per_cu, (const void*)mega, 512, LDS_BYTES) != hipSuccess || per_cu < 1) per_cu = 1;
        (void)hipGetLastError();
        grid = cus;
    }
    if (grid < 0) return;
    Args a{};
    for (int i = 0; i < 30; ++i) a.in[i] = (const float*)d_in[i];
    a.out = (float*)d_out; a.ws = (unsigned char*)d_ws;
#if PER_PHASE_LAUNCH
    for (int ph = 0; ph < NPH; ++ph) { a.ph_lo = ph; a.ph_hi = ph + 1; hipLaunchKernelGGL(mega, dim3(grid), dim3(512), LDS_BYTES, stream, a); }
#else
    (void)hipMemsetAsync((char*)d_ws + WS_BAR, 0, BAR_BYTES, stream);
    a.ph_lo = 0; a.ph_hi = NPH;
    void* args[] = {&a};
    (void)hipLaunchCooperativeKernel((const void*)mega, dim3(grid), dim3(512), args, LDS_BYTES, stream);
#endif
}
```

```cpp
#include <hip/hip_runtime.h>
#include <hip/hip_cooperative_groups.h>
namespace cg = cooperative_groups;
namespace pg8 {
#define PG8_LAS __attribute__((address_space(3)))
typedef unsigned short bf16_t;
typedef short bf16x8 __attribute__((ext_vector_type(8)));
typedef float f32x4 __attribute__((ext_vector_type(4)));
typedef unsigned u32x4 __attribute__((ext_vector_type(4)));
constexpr int BM = 256, BK = 64, HALF = 128, HTB = HALF * BK * 2  , STAGE_BYTES = 8 * HTB, NXCD = 8, WGM = 8;

__host__ __device__ __forceinline__ int lds_byte(int r, int c) { const int st = (r >> 4) * 2 + (c >> 5), rr = r & 15, cc = c & 31, ob = rr * 64 + cc * 2; return st * 1024 + (ob ^ (((ob >> 9) & 1) << 5)); }
__host__ __device__ __forceinline__ void stage_rc(int b, int& R, int& C) { const int st = b / 1024, sb = b % 1024, swz = sb ^ (((sb >> 9) & 1) << 5); R = (st >> 1) * 16 + swz / 64; C = (st & 1) * 32 + (swz % 64) / 2; }
__host__ __device__ __forceinline__ int perm32(int rho) { const int n = rho >> 4, i = rho & 15; return 8 * (i >> 2) + 4 * n + (i & 3); }

struct Unit { int pm, pn; };
struct Gemm { const bf16_t* A; const bf16_t* Bt; int M, N, K; };

struct StaticOrder {
    int nM, nN, nwg, G, c;
    __host__ __device__ void init(int M, int N, int G_, int c_) { nM = M / BM; nN = N / BM; nwg = nM * nN; G = G_; c = c_; }
    __host__ __device__ bool next(int i, Unit& u) const {
        const long L = (long)i * G + c; if (L >= nwg) return false;
        int wgid = (int)L; { const int q = nwg / NXCD, r = nwg % NXCD, xcd = wgid % NXCD, off = wgid / NXCD; wgid = (xcd < r ? xcd * (q + 1) : r * (q + 1) + (xcd - r) * q) + off; }
        const int nig = WGM * nN, gid = wgid / nig, fm = gid * WGM, gsz = (nM - fm) < WGM ? (nM - fm) : WGM;
        u.pm = fm + ((wgid % nig) % gsz); u.pn = (wgid % nig) / gsz; return true;
    }
    __device__ __forceinline__ void a_ready(const Unit&) const {}
    __device__ __forceinline__ void done(const Unit&) const {}
};
__device__ __forceinline__ unsigned cvt_pk_bf16(float lo, float hi) { unsigned r; asm volatile("v_cvt_pk_bf16_f32 %0, %1, %2" : "=v"(r) : "v"(lo), "v"(hi)); return r; }
typedef float f32x2 __attribute__((ext_vector_type(2)));
typedef unsigned u32x2 __attribute__((ext_vector_type(2)));
__device__ __forceinline__ float silu_f(float a) { return a * __builtin_amdgcn_rcpf(1.0f + __expf(-a)); }
__device__ __forceinline__ float sigmoid_f(float a) { return __builtin_amdgcn_rcpf(1.0f + __expf(-a)); }
__device__ __forceinline__ float gelu_tanh(float y) { const float z = 1.5957691216f * (y + 0.044715f * y * y * y); return y * __builtin_amdgcn_rcpf(1.0f + __expf(-z)); }
__device__ __forceinline__ float bf_lo(unsigned w) { return __uint_as_float(w << 16); }
__device__ __forceinline__ float bf_hi(unsigned w) { return __uint_as_float(w & 0xffff0000u); }

struct EpiZ {
    static constexpr bool PERM = true, AFTER_DRAIN = false;
    bf16_t* O; int ldc;
    __device__ __forceinline__ void operator()(const f32x4 (&acc)[2][2][4][2], const Unit& u, int wr, int wc, int fr, int fq) const {
        const int row0 = u.pm * BM + wr * 64 + fr, col0 = u.pn * BM + wc * 32 + 8 * fq;
#pragma unroll
        for (int ai = 0; ai < 2; ++ai)
#pragma unroll
            for (int m = 0; m < 4; ++m) { bf16_t* rowp = O + (size_t)(row0 + ai * HALF + m * 16) * ldc + col0;
#pragma unroll
                for (int bj = 0; bj < 2; ++bj) { const f32x4 v0 = acc[ai][bj][m][0], v1 = acc[ai][bj][m][1];
                    u32x4 w; w.x = cvt_pk_bf16(v0[0], v0[1]); w.y = cvt_pk_bf16(v0[2], v0[3]); w.z = cvt_pk_bf16(v1[0], v1[1]); w.w = cvt_pk_bf16(v1[2], v1[3]);
                    *(u32x4*)(rowp + bj * HALF) = w; } }
    }
};
struct EpiSwiglu {
    static constexpr bool PERM = true, AFTER_DRAIN = false;
    bf16_t* O; int ldc;
    __device__ __forceinline__ void operator()(const f32x4 (&acc)[2][2][4][2], const Unit& u, int wr, int wc, int fr, int fq) const {
        const int row0 = u.pm * BM + wr * 64 + fr, col0 = u.pn * HALF + wc * 32 + 8 * fq;
#pragma unroll
        for (int ai = 0; ai < 2; ++ai)
#pragma unroll
            for (int m = 0; m < 4; ++m) { bf16_t* rowp = O + (size_t)(row0 + ai * HALF + m * 16) * ldc + col0;
                const f32x4 a0 = acc[ai][0][m][0], a1 = acc[ai][0][m][1], b0 = acc[ai][1][m][0], b1 = acc[ai][1][m][1];
                const f32x4 t0 = a0 * -1.4426950408889634f, t1 = a1 * -1.4426950408889634f;
                f32x4 e0, e1;
#pragma unroll
                for (int j = 0; j < 4; ++j) { e0[j] = __builtin_amdgcn_exp2f(t0[j]); e1[j] = __builtin_amdgcn_exp2f(t1[j]); }
                const f32x4 d0 = e0 + 1.0f, d1 = e1 + 1.0f; f32x4 r0, r1;
#pragma unroll
                for (int j = 0; j < 4; ++j) { r0[j] = __builtin_amdgcn_rcpf(d0[j]); r1[j] = __builtin_amdgcn_rcpf(d1[j]); }
                const f32x4 v0 = (a0 * b0) * r0, v1 = (a1 * b1) * r1;
                u32x4 w; w.x = cvt_pk_bf16(v0[0], v0[1]); w.y = cvt_pk_bf16(v0[2], v0[3]); w.z = cvt_pk_bf16(v1[0], v1[1]); w.w = cvt_pk_bf16(v1[2], v1[3]);
                __builtin_nontemporal_store(w, (u32x4*)rowp); }
    }
};
struct EpiResid {
    static constexpr bool PERM = true, AFTER_DRAIN = true;
    const bf16_t* xin; bf16_t* xout; float* fout; const float* gate; const float* gnext; const float* scnext; const float* shnext; bf16_t* xa; unsigned* xbuf; unsigned* cnt; float gs; unsigned need;
    __device__ __forceinline__ void fused(f32x4 (&acc)[2][2][4][2], const Unit& u, int wr, int wc, int fr, int fq, PG8_LAS unsigned char* lds, int wid, int lane) const {
        PG8_LAS float* P = (PG8_LAS float*)lds;
        PG8_LAS float* S = (PG8_LAS float*)(lds + 4096);
        const int row0 = u.pm * BM + wr * 64 + fr, col0 = u.pn * BM + wc * 32 + 8 * fq;
        const size_t cb = (size_t)(u.pm >> 3) * 9216 + col0;
        float sq[8];
#pragma unroll
        for (int i = 0; i < 8; ++i) sq[i] = 0.f;
#pragma unroll
        for (int bj = 0; bj < 2; ++bj) { const int co = bj * HALF;
            const f32x4 gv0 = *(const f32x4*)(gate + cb + co) * gs, gv1 = *(const f32x4*)(gate + cb + co + 4) * gs;
#pragma unroll
            for (int ai = 0; ai < 2; ++ai)
#pragma unroll
                for (int m = 0; m < 4; ++m) { const size_t off = (size_t)(row0 + ai * HALF + m * 16) * 1024 + col0 + co;
                    const u32x4 xw = *(const u32x4*)(xin + off);
                    const f32x4 xi0 = (f32x4){bf_lo(xw.x), bf_hi(xw.x), bf_lo(xw.y), bf_hi(xw.y)}, xi1 = (f32x4){bf_lo(xw.z), bf_hi(xw.z), bf_lo(xw.w), bf_hi(xw.w)};
                    const f32x4 xn0 = xi0 + gv0 * acc[ai][bj][m][0], xn1 = xi1 + gv1 * acc[ai][bj][m][1];
                    if (xa) { u32x4 ow; ow.x = cvt_pk_bf16(xn0[0], xn0[1]); ow.y = cvt_pk_bf16(xn0[2], xn0[3]); ow.z = cvt_pk_bf16(xn1[0], xn1[1]); ow.w = cvt_pk_bf16(xn1[2], xn1[3]);
                        *(u32x4*)(xout + off) = ow; }
                    acc[ai][bj][m][0] = xn0; acc[ai][bj][m][1] = xn1;
                    const f32x4 s2 = xn0 * xn0 + xn1 * xn1;
                    sq[ai * 4 + m] += (s2[0] + s2[1]) + (s2[2] + s2[3]); }
            asm volatile("" ::: "memory"); }
#pragma unroll
        for (int i = 0; i < 8; ++i) { float q = sq[i]; q += __shfl_xor(q, 16); q += __shfl_xor(q, 32);
            if (fq == 0) P[((i >> 2) * HALF + wr * 64 + (i & 3) * 16 + fr) * 4 + wc] = q; }
        asm volatile("s_waitcnt lgkmcnt(0)" ::: "memory"); __builtin_amdgcn_s_barrier(); asm volatile("" ::: "memory");
        const int row = wid * 32 + (lane & 31);
        if (lane < 32) { const f32x4 p = *(const PG8_LAS f32x4*)(P + row * 4); const float s = (p[0] + p[1]) + (p[2] + p[3]);
            __hip_atomic_store(xbuf + ((size_t)(u.pm * BM + row) * 4 + u.pn), __float_as_uint(s), __ATOMIC_RELAXED, __HIP_MEMORY_SCOPE_AGENT); }
        asm volatile("s_waitcnt vmcnt(0)" ::: "memory");
        if (lane == 0) __hip_atomic_fetch_add(cnt + 64 * u.pm, 1u, __ATOMIC_RELAXED, __HIP_MEMORY_SCOPE_AGENT);
        if (wid == 0) {
            unsigned spins = 0;
            while ((unsigned)__builtin_amdgcn_readfirstlane(__hip_atomic_load(cnt + 64 * u.pm, __ATOMIC_RELAXED, __HIP_MEMORY_SCOPE_AGENT)) < need) { __builtin_amdgcn_s_sleep(2); if (++spins > (1u << 22)) break; }
            __builtin_amdgcn_fence(__ATOMIC_ACQUIRE, "agent");
        }
        asm volatile("s_waitcnt vmcnt(0) lgkmcnt(0)" ::: "memory"); __builtin_amdgcn_s_barrier(); asm volatile("" ::: "memory");
        if (lane < 32) { const unsigned* slot = xbuf + (size_t)(u.pm * BM + row) * 4; float t = 0.f;
#pragma unroll
            for (int k = 0; k < 4; ++k) t += __uint_as_float(__hip_atomic_load(slot + k, __ATOMIC_RELAXED, __HIP_MEMORY_SCOPE_AGENT));
            S[row] = __builtin_amdgcn_rsqf(t * (1.0f / 1024.0f) + 1e-6f); }
        asm volatile("s_waitcnt vmcnt(0) lgkmcnt(0)" ::: "memory"); __builtin_amdgcn_s_barrier(); asm volatile("" ::: "memory");
        if (xa == nullptr) {
#pragma unroll
            for (int bj = 0; bj < 2; ++bj) { const int co = bj * HALF; const f32x4 g0 = *(const f32x4*)(gnext + col0 + co), g1 = *(const f32x4*)(gnext + col0 + co + 4);
#pragma unroll
                for (int ai = 0; ai < 2; ++ai)
#pragma unroll
                    for (int m = 0; m < 4; ++m) { const int r = ai * HALF + wr * 64 + m * 16 + fr; const float rs = S[r]; float* op = fout + (size_t)(u.pm * BM + r) * 1024 + col0 + co;
                        *(f32x4*)op = acc[ai][bj][m][0] * rs * g0; *(f32x4*)(op + 4) = acc[ai][bj][m][1] * rs * g1; } }
            asm volatile("s_waitcnt lgkmcnt(0)" ::: "memory"); __builtin_amdgcn_s_barrier(); asm volatile("" ::: "memory");
            return;
        }
#pragma unroll
        for (int bj = 0; bj < 2; ++bj) { const int co = bj * HALF;
            const f32x4 gm0 = *(const f32x4*)(gnext + col0 + co) * (*(const f32x4*)(scnext + cb + co) + 1.0f), gm1 = *(const f32x4*)(gnext + col0 + co + 4) * (*(const f32x4*)(scnext + cb + co + 4) + 1.0f);
            const f32x4 sh0 = *(const f32x4*)(shnext + cb + co), sh1 = *(const f32x4*)(shnext + cb + co + 4);
#pragma unroll
            for (int ai = 0; ai < 2; ++ai)
#pragma unroll
                for (int m = 0; m < 4; ++m) { const int r = ai * HALF + wr * 64 + m * 16 + fr; const float rs = S[r];
                    const f32x4 y0 = acc[ai][bj][m][0] * (gm0 * rs) + sh0, y1 = acc[ai][bj][m][1] * (gm1 * rs) + sh1;
                    u32x4 w; w.x = cvt_pk_bf16(y0[0], y0[1]); w.y = cvt_pk_bf16(y0[2], y0[3]); w.z = cvt_pk_bf16(y1[0], y1[1]); w.w = cvt_pk_bf16(y1[2], y1[3]);
                    *(u32x4*)(xa + (size_t)(u.pm * BM + r) * 1024 + col0 + co) = w; } }
        asm volatile("s_waitcnt lgkmcnt(0)" ::: "memory"); __builtin_amdgcn_s_barrier(); asm volatile("" ::: "memory");
    }
};
struct EpiGlu {
    static constexpr bool PERM = false, AFTER_DRAIN = true;
    const bf16_t* yg; const float* glu_b; const float* gn; bf16_t* ycat;
    __device__ __forceinline__ void fused(f32x4 (&acc)[2][2][4][2], const Unit& u, int wr, int wc, int fr, int fq, PG8_LAS unsigned char* lds, int wid, int lane) const {
        PG8_LAS float* P = (PG8_LAS float*)lds;
        const int col0 = wc * 32 + 4 * fq;
        f32x4 gb[2][2];
#pragma unroll
        for (int bj = 0; bj < 2; ++bj)
#pragma unroll
            for (int n = 0; n < 2; ++n) gb[bj][n] = *(const f32x4*)(glu_b + col0 + bj * HALF + n * 16);
#pragma unroll
        for (int ai = 0; ai < 2; ++ai)
#pragma unroll
            for (int m = 0; m < 4; ++m) { const int r = ai * HALF + wr * 64 + m * 16 + fr; const bf16_t* yp = yg + (size_t)(u.pm * BM + r) * 256 + col0; float s = 0.f;
#pragma unroll
                for (int bj = 0; bj < 2; ++bj)
#pragma unroll
                    for (int n = 0; n < 2; ++n) { const u32x2 yw = *(const u32x2*)(yp + bj * HALF + n * 16);
                        const f32x4 y = (f32x4){bf_lo(yw.x), bf_hi(yw.x), bf_lo(yw.y), bf_hi(yw.y)}; const f32x4 a = acc[ai][bj][m][n] + gb[bj][n]; f32x4 o;
#pragma unroll
                        for (int j = 0; j < 4; ++j) { o[j] = y[j] * sigmoid_f(a[j]); s += o[j] * o[j]; }
                        acc[ai][bj][m][n] = o; }
                s += __shfl_xor(s, 16); s += __shfl_xor(s, 32);
                if (fq == 0) P[r * 4 + wc] = s; }
        asm volatile("s_waitcnt lgkmcnt(0)" ::: "memory"); __builtin_amdgcn_s_barrier(); asm volatile("" ::: "memory");
        f32x4 gg[2][2];
#pragma unroll
        for (int bj = 0; bj < 2; ++bj)
#pragma unroll
            for (int n = 0; n < 2; ++n) gg[bj][n] = *(const f32x4*)(gn + col0 + bj * HALF + n * 16);
#pragma unroll
        for (int ai = 0; ai < 2; ++ai)
#pragma unroll
            for (int m = 0; m < 4; ++m) { const int r = ai * HALF + wr * 64 + m * 16 + fr; const f32x4 pp = *(const PG8_LAS f32x4*)(P + r * 4);
                const float rstd = 1.0f / sqrtf(((pp[0] + pp[1]) + (pp[2] + pp[3])) * (1.0f / 256.0f) + 1e-6f);
                bf16_t* op = ycat + (size_t)(u.pm * BM + r) * 1024 + 768 + col0;
#pragma unroll
                for (int bj = 0; bj < 2; ++bj)
#pragma unroll
                    for (int n = 0; n < 2; ++n) { const f32x4 o = acc[ai][bj][m][n] * rstd * gg[bj][n]; u32x2 w; w.x = cvt_pk_bf16(o[0], o[1]); w.y = cvt_pk_bf16(o[2], o[3]);
                        *(u32x2*)(op + bj * HALF + n * 16) = w; } }
        asm volatile("s_waitcnt lgkmcnt(0)" ::: "memory"); __builtin_amdgcn_s_barrier(); asm volatile("" ::: "memory");
    }
};

template <class Epi, class Sched, bool STAMP = false>
__device__ __forceinline__ void gemm_phase(PG8_LAS unsigned char* lds, const Gemm g, const Sched& S, const Epi& E, unsigned long long* stamps, const int tid) {
    const int wid = __builtin_amdgcn_readfirstlane(tid >> 6), lane = tid & 63, wr = wid >> 2, wc = wid & 3, fr = lane & 15, fq = lane >> 4;
    const int K = g.K, nt = K / BK;
    int ts_lo = 0, ts_hi = 0, nts = 0; const unsigned long long rt_entry = STAMP ? (unsigned long long)wall_clock64() : 0ull;
#define PG8_STAMP() do { if (STAMP && wid == 0 && nts < 64) { const unsigned long long _c = (unsigned long long)clock64(); \
        ts_lo = (lane == nts) ? (int)(unsigned)_c : ts_lo; ts_hi = (lane == nts) ? (int)(unsigned)(_c >> 32) : ts_hi; ++nts; } } while (0)
    PG8_STAMP();
    unsigned voffA[2], voffB[2];
#pragma unroll
    for (int i = 0; i < 2; ++i) { int R, C; stage_rc(tid * 16 + i * 8192, R, C); const int Rb = Epi::PERM ? ((R & ~31) + perm32(R & 31)) : R;
        voffA[i] = (unsigned)(R * K + C) * 2u; voffB[i] = (unsigned)(Rb * K + C) * 2u; }
    const size_t kstep = (size_t)(BK * 2);
    const size_t hstep = (size_t)HALF * K * 2;
    const size_t tstep = 2 * hstep;
    const unsigned ldsw = (unsigned)wid * 1024u;
    const int aoff = lds_byte(wr * 64 + fr, fq * 8), boff = lds_byte(wc * 32 + fr, fq * 8);
#define PG8_SA(b, h) (((b) * 2 + (h)) * HTB)
#define PG8_SB(b, h) ((4 + (b) * 2 + (h)) * HTB)
#define PG8_STAGE(bufoff, gbase, voff) do { _Pragma("unroll") for (int _i = 0; _i < 2; ++_i) \
        __builtin_amdgcn_global_load_lds((const unsigned*)((const char*)(gbase) + (voff)[_i]), (PG8_LAS unsigned*)(lds + (bufoff) + ldsw + _i * 8192), 16, 0, 0); } while (0)
#define PG8_LDA(dst, b, h) do { _Pragma("unroll") for (int m = 0; m < 4; ++m) _Pragma("unroll") for (int k = 0; k < 2; ++k) dst[m][k] = *(const PG8_LAS bf16x8*)(lds + PG8_SA(b, h) + aoff + m * 2048 + k * 1024); } while (0)
#define PG8_LDB(dst, b, h) do { _Pragma("unroll") for (int n = 0; n < 2; ++n) _Pragma("unroll") for (int k = 0; k < 2; ++k) dst[n][k] = *(const PG8_LAS bf16x8*)(lds + PG8_SB(b, h) + boff + n * 2048 + k * 1024); } while (0)
#define PG8_MMA(ai, bj, At, Bt) do { __builtin_amdgcn_s_setprio(1); _Pragma("unroll") for (int m = 0; m < 4; ++m) _Pragma("unroll") for (int n = 0; n < 2; ++n) _Pragma("unroll") for (int k = 0; k < 2; ++k) \
        acc[ai][bj][m][n] = __builtin_amdgcn_mfma_f32_16x16x32_bf16(Bt[n][k], At[m][k], acc[ai][bj][m][n], 0, 0, 0); __builtin_amdgcn_s_setprio(0); } while (0)
#define PG8_WAIT_V(n) asm volatile("s_waitcnt vmcnt(" #n ")" ::: "memory")
#define PG8_WAIT_L(n) asm volatile("s_waitcnt lgkmcnt(" #n ")" ::: "memory")
#define PG8_BAR __builtin_amdgcn_s_barrier()
#define PG8_SCHED __builtin_amdgcn_sched_barrier(0)
    Unit cur, nxt; int ui = 0;
    if (!S.next(0, cur)) return;
    f32x4 acc[2][2][4][2];
#pragma unroll
    for (int a = 0; a < 2; ++a)
#pragma unroll
        for (int b = 0; b < 2; ++b)
#pragma unroll
            for (int m = 0; m < 4; ++m)
#pragma unroll
                for (int n = 0; n < 2; ++n) acc[a][b][m][n] = (f32x4){0.f, 0.f, 0.f, 0.f};
    bf16x8 At[4][2], B0[2][2], B1[2][2];
    const char* cA = (const char*)g.A + (size_t)cur.pm * tstep; const char* cB = (const char*)g.Bt + (size_t)cur.pn * tstep;
    S.a_ready(cur);
    PG8_STAGE(PG8_SB(0, 0), cB, voffB); PG8_STAGE(PG8_SA(0, 0), cA, voffA); PG8_STAGE(PG8_SB(0, 1), cB + hstep, voffB); PG8_STAGE(PG8_SA(0, 1), cA + hstep, voffA);
    if (wr == 1) PG8_BAR;
    PG8_WAIT_V(4); PG8_BAR;
    PG8_STAGE(PG8_SB(1, 0), cB + kstep, voffB); PG8_STAGE(PG8_SA(1, 0), cA + kstep, voffA); PG8_STAGE(PG8_SB(1, 1), cB + hstep + kstep, voffB);
    PG8_WAIT_V(6); PG8_BAR;
    PG8_STAMP();
    for (;;) {
        const bool has_next = S.next(ui + 1, nxt);
        const char* nA = has_next ? (const char*)g.A + (size_t)nxt.pm * tstep : cA; const char* nB = has_next ? (const char*)g.Bt + (size_t)nxt.pn * tstep : cB;
        for (int t = 0; t < nt; t += 2) {
            const bool last = (t == nt - 2);
            const char* a1 = cA + (size_t)(t + 1) * kstep;
            const char* a2 = last ? nA : cA + (size_t)(t + 2) * kstep; const char* b2 = last ? nB : cB + (size_t)(t + 2) * kstep;
            const char* a3 = a2 + kstep; const char* b3 = b2 + kstep;
            if (last && has_next) S.a_ready(nxt);
            PG8_LDB(B0, 0, 0); PG8_SCHED; PG8_LDA(At, 0, 0); PG8_STAGE(PG8_SA(1, 1), a1 + hstep, voffA);
            PG8_WAIT_L(8); PG8_BAR; PG8_WAIT_L(0); PG8_MMA(0, 0, At, B0); PG8_BAR; PG8_SCHED;
            PG8_LDB(B1, 0, 1); PG8_STAGE(PG8_SB(0, 0), b2, voffB);
            PG8_BAR; PG8_WAIT_L(0); PG8_MMA(0, 1, At, B1); PG8_BAR;
            PG8_LDA(At, 0, 1); PG8_STAGE(PG8_SA(0, 0), a2, voffA);
            PG8_BAR; PG8_WAIT_L(0); PG8_MMA(1, 0, At, B0); PG8_BAR; PG8_SCHED;
            PG8_STAGE(PG8_SB(0, 1), b2 + hstep, voffB);
            PG8_WAIT_V(6); PG8_BAR; PG8_MMA(1, 1, At, B1); PG8_BAR;
            PG8_LDB(B0, 1, 0); PG8_SCHED; PG8_LDA(At, 1, 0); PG8_STAGE(PG8_SA(0, 1), a2 + hstep, voffA);
            PG8_WAIT_L(8); PG8_BAR; PG8_WAIT_L(0); PG8_MMA(0, 0, At, B0); PG8_BAR; PG8_SCHED;
            PG8_LDB(B1, 1, 1); PG8_STAGE(PG8_SB(1, 0), b3, voffB);
            PG8_BAR; PG8_WAIT_L(0); PG8_MMA(0, 1, At, B1); PG8_BAR;
            PG8_LDA(At, 1, 1); PG8_STAGE(PG8_SA(1, 0), a3, voffA);
            PG8_BAR; PG8_WAIT_L(0); PG8_MMA(1, 0, At, B0); PG8_BAR; PG8_SCHED;
            PG8_STAGE(PG8_SB(1, 1), b3 + hstep, voffB);
            PG8_WAIT_V(6); PG8_BAR; PG8_MMA(1, 1, At, B1); PG8_BAR;
        }
        PG8_STAMP();
        if constexpr (!Epi::AFTER_DRAIN) { E(acc, cur, wr, wc, fr, fq); S.done(cur); }
        PG8_STAMP();
        if (!has_next) break;
#pragma unroll
        for (int a = 0; a < 2; ++a)
#pragma unroll
            for (int b = 0; b < 2; ++b)
#pragma unroll
                for (int m = 0; m < 4; ++m)
#pragma unroll
                    for (int n = 0; n < 2; ++n) acc[a][b][m][n] = (f32x4){0.f, 0.f, 0.f, 0.f};
        cur = nxt; cA = nA; cB = nB; ++ui;
    }
    PG8_WAIT_V(0);
    if (wr == 0) PG8_BAR;
    PG8_BAR;
    if constexpr (Epi::AFTER_DRAIN) { E.fused(acc, cur, wr, wc, fr, fq, lds, wid, lane); S.done(cur); }
    PG8_STAMP();
    if (STAMP && wid == 0) { stamps[lane] = lane < nts ? (((unsigned long long)(unsigned)ts_hi << 32) | (unsigned)ts_lo) : 0ull;
        if (lane == 62) stamps[62] = rt_entry; if (lane == 63) stamps[63] = (unsigned long long)wall_clock64(); }
#undef PG8_STAMP
#undef PG8_SA
#undef PG8_SB
#undef PG8_STAGE
#undef PG8_LDA
#undef PG8_LDB
#undef PG8_MMA
#undef PG8_WAIT_V
#undef PG8_WAIT_L
#undef PG8_BAR
#undef PG8_SCHED
}
}

#define LAS __attribute__((address_space(3)))
typedef unsigned short bf16;
using pg8::f32x4; using pg8::bf16x8; using pg8::u32x4; using pg8::u32x2; using pg8::cvt_pk_bf16; using pg8::bf_lo; using pg8::bf_hi; using pg8::gelu_tanh;

constexpr int M = 16384, D = 1024, DFF = 2816, PIN = 1792, NL = 4, NCOND = 9216;
constexpr float EPS = 1e-6f;
constexpr size_t MiB = (size_t)1 << 20;
constexpr size_t WS_BAR = 7 * MiB, BAR_BYTES = 32768;
constexpr size_t WS_COND = 0, WS_E = 2 * MiB, WS_W = 8 * MiB, LW = 39 * MiB;
constexpr size_t OW_IN1 = 0, OW_OUT1 = 11 * MiB, OW_MIX = OW_OUT1 + 11 * MiB / 2, OW_MO = OW_MIX + 7 * MiB / 2, OW_IN2 = OW_MO + 2 * MiB, OW_OUT2 = OW_IN2 + 11 * MiB, OW_GLU = OW_OUT2 + 11 * MiB / 2;
static_assert(OW_GLU + 131072 <= LW, "weights per layer");
constexpr size_t WS_H = 164 * MiB, WS_ACT = 196 * MiB, WS_Z = 284 * MiB, WS_YG = 340 * MiB, WS_YCAT = 348 * MiB, WS_SHW = 380 * MiB, WS_SS = 383 * MiB, WS_XB = 384 * MiB, WS_END = 416 * MiB;
constexpr int LDS_BYTES = 147456;
#ifndef SGU_REP
#define SGU_REP 1
#endif
#ifndef S5_REP
#define S5_REP 1
#endif
#ifndef PC_REP
#define PC_REP 1
#endif
#ifndef PREP_REP
#define PREP_REP 1
#endif
#ifndef PREP_TILE_REP
#define PREP_TILE_REP 1
#endif
#ifndef TPROBE
#define TPROBE 0
#endif
#ifndef SLOT_MAP
#define SLOT_MAP 0x87653210ull
#define SLOT_REP 0u
#define NSLOT 8
#endif
constexpr int NPH = 2 + NL * NSLOT;
constexpr int TILES_PER_LAYER = 176 + 88 + 48 + 32 + 176 + 88 + 2;

struct Args { const float* in[30]; float* out; unsigned char* ws; int ph_lo, ph_hi; };
typedef const Args __attribute__((address_space(4)))& ArgsRef;

__device__ __forceinline__ float wave_sum(float v) {
#pragma unroll
    for (int o = 1; o < 64; o <<= 1) v += __shfl_xor(v, o);
    return v;
}
#define LDS_WAIT() asm volatile("s_waitcnt lgkmcnt(0)" ::: "memory")

struct TileDesc { const float* W; bf16* WT; int K, N, k0, n0, swiglu; };
__device__ __forceinline__ TileDesc tile_decode(ArgsRef a, int item) {
    const int l = item / TILES_PER_LAYER; int r = item % TILES_PER_LAYER;
    unsigned char* wl = a.ws + WS_W + (size_t)l * LW; TileDesc t;
    if (r < 176) t = TileDesc{a.in[5] + (size_t)l * 1024 * 5632, (bf16*)(wl + OW_IN1), 1024, 5632, 128 * (r / 22), 256 * (r % 22), 1};
    else if ((r -= 176) < 88) t = TileDesc{a.in[6] + (size_t)l * DFF * 1024, (bf16*)(wl + OW_OUT1), DFF, 1024, 128 * (r / 4), 256 * (r % 4), 0};
    else if ((r -= 88) < 48) { const int nb = r % 6; t = TileDesc{a.in[8] + (size_t)l * 1024 * PIN, (bf16*)(wl + OW_MIX), 1024, PIN, 128 * (r / 6), 256 * (nb < 2 ? nb : nb + 1), 0}; }
    else if ((r -= 48) < 32) t = TileDesc{a.in[25] + (size_t)l * 1024 * 1024, (bf16*)(wl + OW_MO), 1024, 1024, 128 * (r / 4), 256 * (r % 4), 0};
    else if ((r -= 32) < 176) t = TileDesc{a.in[27] + (size_t)l * 1024 * 5632, (bf16*)(wl + OW_IN2), 1024, 5632, 128 * (r / 22), 256 * (r % 22), 1};
    else if ((r -= 176) < 88) t = TileDesc{a.in[28] + (size_t)l * DFF * 1024, (bf16*)(wl + OW_OUT2), DFF, 1024, 128 * (r / 4), 256 * (r % 4), 0};
    else { r -= 88; t = TileDesc{a.in[22] + (size_t)l * 65536, (bf16*)(wl + OW_GLU), 256, 256, 128 * r, 0, 0}; }
    return t;
}
__device__ __forceinline__ void tile_load(const TileDesc& t, float (&v)[16][4], int wave, int lane) {
    const float* wp = t.W + (size_t)(t.k0 + 16 * wave) * t.N + t.n0 + lane;
#pragma unroll
    for (int r = 0; r < 16; ++r)
#pragma unroll
        for (int e = 0; e < 4; ++e) v[r][e] = __builtin_nontemporal_load(wp + (size_t)r * t.N + 64 * e);
}
__device__ __forceinline__ void tile_to_lds(const float (&v)[16][4], LAS unsigned char* lds, int wave, int lane) {
#pragma unroll
    for (int e = 0; e < 4; ++e)
#pragma unroll
        for (int hq = 0; hq < 2; ++hq) { u32x4 o; o.x = cvt_pk_bf16(v[8 * hq][e], v[8 * hq + 1][e]); o.y = cvt_pk_bf16(v[8 * hq + 2][e], v[8 * hq + 3][e]); o.z = cvt_pk_bf16(v[8 * hq + 4][e], v[8 * hq + 5][e]); o.w = cvt_pk_bf16(v[8 * hq + 6][e], v[8 * hq + 7][e]);
            *(LAS u32x4*)(lds + (lane + 64 * e) * 272 + (16 * wave + 8 * hq) * 2) = o; }
}
__device__ __forceinline__ void tile_store(const TileDesc& t, LAS unsigned char* lds, int wave, int lane) {
#pragma unroll
    for (int j = 0; j < 8; ++j) { const int nl = 32 * wave + 4 * j + (lane >> 4), n = t.n0 + nl;
        const u32x4 o = *(const LAS u32x4*)(lds + nl * 272 + 16 * (lane & 15));
        const int dsw = n < DFF ? (n >> 7) * 256 + (n & 127) : ((n - DFF) >> 7) * 256 + 128 + ((n - DFF) & 127);
        const int dst = t.swiglu ? dsw : n;
        *(u32x4*)(t.WT + (size_t)dst * t.K + t.k0 + 8 * (lane & 15)) = o; }
}

__device__ __forceinline__ void prep_phase(ArgsRef a, LAS unsigned char* lds, int tid, int wave, int lane, int G) {
    LAS float* sc = (LAS float*)lds;
    LAS float* R = (LAS float*)(lds + 32768);
    float* cond = (float*)(a.ws + WS_COND);
    const bool cond_blk = (G >= 256) ? (blockIdx.x < 144) : true;
    if (cond_blk) {
        const float* c_in = a.in[1];
        for (int i = tid; i < 8 * 1024; i += 512) { const float v = c_in[i]; sc[i] = v / (1.0f + expf(-v)); }
        __syncthreads();
        for (int it = blockIdx.x; it < NL * 36; it += (G >= 256 ? 144 : G)) {
            const int l = it / 36, n0 = 256 * (it % 36);
            const float* wp = a.in[2] + ((size_t)l * 1024 + 128 * wave) * NCOND + n0 + 4 * lane;
            f32x4 acc[8];
#pragma unroll
            for (int b = 0; b < 8; ++b) acc[b] = (f32x4){0.f, 0.f, 0.f, 0.f};
            f32x4 wv[8], wn[8];
#pragma unroll
            for (int kk = 0; kk < 8; ++kk) wv[kk] = __builtin_nontemporal_load((const f32x4*)(wp + (size_t)kk * NCOND));
            for (int k0 = 0; k0 < 128; k0 += 8) {
                if (k0 + 8 < 128) {
#pragma unroll
                    for (int kk = 0; kk < 8; ++kk) wn[kk] = __builtin_nontemporal_load((const f32x4*)(wp + (size_t)(k0 + 8 + kk) * NCOND));
                }
#pragma unroll
                for (int q = 0; q < 2; ++q)
#pragma unroll
                    for (int b = 0; b < 8; ++b) { const f32x4 s4 = *(const LAS f32x4*)(sc + b * 1024 + 128 * wave + k0 + 4 * q);
#pragma unroll
                        for (int e = 0; e < 4; ++e) acc[b] += wv[4 * q + e] * s4[e]; }
#pragma unroll
                for (int kk = 0; kk < 8; ++kk) wv[kk] = wn[kk];
            }
#pragma unroll
            for (int b = 0; b < 8; ++b) *(LAS f32x4*)(R + (wave * 8 + b) * 256 + 4 * lane) = acc[b];
            __syncthreads();
            { const int b = wave; f32x4 s = *(const f32x4*)(a.in[3] + (size_t)l * NCOND + n0 + 4 * lane);
#pragma unroll
              for (int w = 0; w < 8; ++w) s += *(const LAS f32x4*)(R + (w * 8 + b) * 256 + 4 * lane);
              *(f32x4*)(cond + ((size_t)l * 8 + b) * NCOND + n0 + 4 * lane) = s; }
            __syncthreads();
        }
    }
    int first, stride, count;
    if (G >= 256) { if (blockIdx.x < 144) { first = blockIdx.x * 7; stride = 1; count = 7; } else { count = (NL * TILES_PER_LAYER - 1008 + (G - 144) - 1) / (G - 144); first = 1008 + (blockIdx.x - 144) * count; stride = 1; } }
    else { first = blockIdx.x; stride = G; count = (NL * TILES_PER_LAYER + G - 1) / G; }
    for (int rp = 0; rp < PREP_TILE_REP; ++rp)
    {
        int lim = NL * TILES_PER_LAYER; if (G >= 256 && blockIdx.x < 144) lim = 1008;
        int nt = 0; for (int j = 0; j < count; ++j) if (first + j * stride < lim) nt = j + 1;
        float v[16][4];
        TileDesc cur = tile_decode(a, nt > 0 ? first : 0);
        if (nt > 0) tile_load(cur, v, wave, lane);
        for (int j = 0; j < nt; ++j) {
            tile_to_lds(v, lds, wave, lane);
            TileDesc nxt = cur;
            if (j + 1 < nt) { nxt = tile_decode(a, first + (j + 1) * stride); tile_load(nxt, v, wave, lane); }
            __syncthreads();
            tile_store(cur, lds, wave, lane);
            __syncthreads();
            cur = nxt;
        }
    }
    const int gw = blockIdx.x * 8 + wave, NGW = G * 8;
    LAS float* F = (LAS float*)(lds + wave * 2048);
    for (int item = gw; item < NL * 512; item += NGW) {
        const int l = item >> 9, r = item & 511, kb = r >> 5, n8 = r & 31, g = n8 >> 3, d0 = 8 * (n8 & 7), k = 64 * kb + lane;
        unsigned char* wl = a.ws + WS_W + (size_t)l * LW;
        const float* pw = a.in[11] + (size_t)(l * 4 + g) * 4096 + (size_t)lane * 64 + d0;
        const f32x4 p0 = *(const f32x4*)pw, p1 = *(const f32x4*)(pw + 4);
        const float* wr = a.in[8] + ((size_t)l * 1024 + k) * PIN + 512 + 64 * g;
        f32x4 wrow[16];
#pragma unroll
        for (int j = 0; j < 16; ++j) wrow[j] = *(const f32x4*)(wr + 4 * j);
        const float* ps = a.in[12] + (size_t)l * 256 + 64 * g + d0;
        const f32x4 s0 = *(const f32x4*)ps, s1 = *(const f32x4*)(ps + 4);
        *(LAS f32x4*)(F + lane * 8) = p0; *(LAS f32x4*)(F + lane * 8 + 4) = p1;
        LDS_WAIT();
        f32x4 a0 = (f32x4){0.f, 0.f, 0.f, 0.f}, a1 = a0;
#pragma unroll
        for (int j = 0; j < 16; ++j)
#pragma unroll
            for (int e = 0; e < 4; ++e) { const int c = 4 * j + e; const f32x4 f0 = *(const LAS f32x4*)(F + c * 8), f1 = *(const LAS f32x4*)(F + c * 8 + 4);
                a0 += f0 * wrow[j][e]; a1 += f1 * wrow[j][e]; }
        a0 = a0 * s0; a1 = a1 * s1;
        bf16* WT = (bf16*)(wl + OW_MIX) + (size_t)(512 + 64 * g + d0) * 1024 + k;
#pragma unroll
        for (int i = 0; i < 4; ++i) { WT[(size_t)i * 1024] = (bf16)(cvt_pk_bf16(a0[i], 0.f) & 0xffffu); WT[(size_t)(4 + i) * 1024] = (bf16)(cvt_pk_bf16(a1[i], 0.f) & 0xffffu); }
        LDS_WAIT();
    }
}

__device__ __forceinline__ void norm_phase(const float* x, const float* g, const float* sh, const float* scl, bf16* h, bf16* xb, int gw, int NGW, int lane) {
    for (int row0 = 2 * gw; row0 < M; row0 += 2 * NGW) {
        f32x4 v[2][4]; float s[2];
#pragma unroll
        for (int r = 0; r < 2; ++r) { const f32x4* xr = (const f32x4*)(x + (size_t)(row0 + r) * D) + lane;
#pragma unroll
            for (int j = 0; j < 4; ++j) v[r][j] = xr[64 * j]; }
#pragma unroll
        for (int r = 0; r < 2; ++r) { float q = 0.f;
#pragma unroll
            for (int j = 0; j < 4; ++j) q += (v[r][j][0] * v[r][j][0] + v[r][j][1] * v[r][j][1]) + (v[r][j][2] * v[r][j][2] + v[r][j][3] * v[r][j][3]);
            s[r] = q; }
        s[0] = wave_sum(s[0]); s[1] = wave_sum(s[1]);
        const size_t cb = (size_t)(row0 >> 11) * NCOND;
#pragma unroll
        for (int j = 0; j < 4; ++j) { const int col = 4 * lane + 256 * j;
            const f32x4 gg = *(const f32x4*)(g + col) * (*(const f32x4*)(scl + cb + col) + 1.0f), hh = *(const f32x4*)(sh + cb + col);
#pragma unroll
            for (int r = 0; r < 2; ++r) { const float rstd = 1.0f / sqrtf(s[r] * (1.0f / D) + EPS);
                const f32x4 y = (v[r][j] * rstd) * gg + hh;
                u32x2 w; w.x = cvt_pk_bf16(y[0], y[1]); w.y = cvt_pk_bf16(y[2], y[3]); ((u32x2*)(h + (size_t)(row0 + r) * D) + lane)[64 * j] = w;
                u32x2 wx; wx.x = cvt_pk_bf16(v[r][j][0], v[r][j][1]); wx.y = cvt_pk_bf16(v[r][j][2], v[r][j][3]); ((u32x2*)(xb + (size_t)(row0 + r) * D) + lane)[64 * j] = wx; } }
    }
}
__device__ __forceinline__ void final_norm_phase(float* x, const float* g, int gw, int NGW, int lane) {
    for (int row = gw; row < M; row += NGW) {
        f32x4* xr = (f32x4*)(x + (size_t)row * D) + lane;
        f32x4 v[4]; float s = 0.f;
#pragma unroll
        for (int j = 0; j < 4; ++j) { v[j] = xr[64 * j]; s += (v[j][0] * v[j][0] + v[j][1] * v[j][1]) + (v[j][2] * v[j][2] + v[j][3] * v[j][3]); }
        const float rstd = 1.0f / sqrtf(wave_sum(s) * (1.0f / D) + EPS);
#pragma unroll
        for (int j = 0; j < 4; ++j) { const f32x4 gg = *(const f32x4*)(g + 4 * lane + 256 * j); xr[64 * j] = v[j] * rstd * gg; }
    }
}

__device__ __forceinline__ f32x4 ld4bf(const bf16* p) { const u32x2 w = *(const u32x2*)p; return (f32x4){bf_lo(w.x), bf_hi(w.x), bf_lo(w.y), bf_hi(w.y)}; }
__device__ __forceinline__ void st4bf(bf16* p, f32x4 v) { u32x2 w; w.x = cvt_pk_bf16(v[0], v[1]); w.y = cvt_pk_bf16(v[2], v[3]); *(u32x2*)p = w; }
__device__ __forceinline__ bf16x8 pack8(f32x4 lo, f32x4 hi) { u32x4 w; w.x = cvt_pk_bf16(lo[0], lo[1]); w.y = cvt_pk_bf16(lo[2], lo[3]); w.z = cvt_pk_bf16(hi[0], hi[1]); w.w = cvt_pk_bf16(hi[2], hi[3]); return __builtin_bit_cast(bf16x8, w); }

__device__ __forceinline__ void sgu_item(ArgsRef a, int l, int it, LAS unsigned char* lds, int tid, int wave, int lane) {
    const bf16* z = (const bf16*)(a.ws + WS_Z); bf16* ycat = (bf16*)(a.ws + WS_YCAT);
    LAS bf16* vT = (LAS bf16*)lds;
    const int tok0 = it * 128;
    { const int s = tid >> 2, q = tid & 3;
      u32x4 raw[4][2];
#pragma unroll
      for (int h = 0; h < 4; ++h) { const u32x4* zp = (const u32x4*)(z + (size_t)(tok0 + s) * PIN + 256 + 64 * h + 16 * q); raw[h][0] = zp[0]; raw[h][1] = zp[1]; }
#pragma unroll
      for (int h = 0; h < 4; ++h) {
          float v[16]; float sum = 0.f;
#pragma unroll
          for (int j = 0; j < 2; ++j) { const u32x4 rw = raw[h][j]; const unsigned ww[4] = {rw.x, rw.y, rw.z, rw.w};
#pragma unroll
              for (int e = 0; e < 4; ++e) { v[8 * j + 2 * e] = gelu_tanh(bf_lo(ww[e])); v[8 * j + 2 * e + 1] = gelu_tanh(bf_hi(ww[e])); sum += v[8 * j + 2 * e] + v[8 * j + 2 * e + 1]; } }
          sum += __shfl_xor(sum, 1); sum += __shfl_xor(sum, 2);
          const float mu = sum * (1.0f / 64.0f); float q2 = 0.f;
#pragma unroll
          for (int e = 0; e < 16; ++e) { v[e] -= mu; q2 += v[e] * v[e]; }
          q2 += __shfl_xor(q2, 1); q2 += __shfl_xor(q2, 2);
          const float rs = 1.0f / sqrtf(q2 * (1.0f / 64.0f) + EPS);
#pragma unroll
          for (int e = 0; e < 16; ++e) vT[(64 * h + 16 * q + e) * 136 + s] = (bf16)(cvt_pk_bf16(v[e] * rs, 0.f) & 0xffffu);
      } }
    __syncthreads();
    const int fr = lane & 15, fq = lane >> 4, t = 16 * wave + fr, nks = (wave >> 1) + 1;
    f32x4 acc[16];
#pragma unroll
    for (int i = 0; i < 16; ++i) acc[i] = (f32x4){0.f, 0.f, 0.f, 0.f};
    {
        const float* wbase = a.in[9] + ((size_t)(l * 4) * 128 + t) * 128 + 8 * fq;
        f32x4 wq[2][4][2];
#pragma unroll
        for (int ks = 0; ks < 4; ++ks) { wq[0][ks][0] = (f32x4){0.f, 0.f, 0.f, 0.f}; wq[0][ks][1] = wq[0][ks][0];
            if (ks < nks) { wq[0][ks][0] = *(const f32x4*)(wbase + 32 * ks); wq[0][ks][1] = *(const f32x4*)(wbase + 32 * ks + 4); } }
#pragma unroll
        for (int h = 0; h < 4; ++h) {
            if (h < 3) {
#pragma unroll
                for (int ks = 0; ks < 4; ++ks) { wq[(h + 1) & 1][ks][0] = (f32x4){0.f, 0.f, 0.f, 0.f}; wq[(h + 1) & 1][ks][1] = wq[(h + 1) & 1][ks][0];
                    if (ks < nks) { wq[(h + 1) & 1][ks][0] = *(const f32x4*)(wbase + (size_t)(h + 1) * 16384 + 32 * ks); wq[(h + 1) & 1][ks][1] = *(const f32x4*)(wbase + (size_t)(h + 1) * 16384 + 32 * ks + 4); } }
            }
#pragma unroll
            for (int ks = 0; ks < 4; ++ks) if (ks < nks) {
                f32x4 w0 = wq[h & 1][ks][0], w1 = wq[h & 1][ks][1];
                const int s0 = 32 * ks + 8 * fq;
#pragma unroll
                for (int e = 0; e < 4; ++e) { if (s0 + e > t) w0[e] = 0.f; if (s0 + 4 + e > t) w1[e] = 0.f; }
                const bf16x8 wf = pack8(w0, w1);
#pragma unroll
                for (int dt = 0; dt < 4; ++dt) { const bf16x8 vf = *(const LAS bf16x8*)(vT + (64 * h + 16 * dt + fr) * 136 + 32 * ks + 8 * fq);
                    acc[h * 4 + dt] = __builtin_amdgcn_mfma_f32_16x16x32_bf16(vf, wf, acc[h * 4 + dt], 0, 0, 0); }
            }
        }
    }
    const size_t tok = (size_t)tok0 + t; float ss = 0.f;
#pragma unroll
    for (int h = 0; h < 4; ++h) { const float bias = a.in[10][(size_t)(l * 4 + h) * 128 + t];
#pragma unroll
        for (int dt = 0; dt < 4; ++dt) { const f32x4 u4 = ld4bf(z + tok * PIN + 64 * h + 16 * dt + 4 * fq); f32x4 o;
#pragma unroll
            for (int e = 0; e < 4; ++e) { o[e] = gelu_tanh(u4[e]) * (acc[h * 4 + dt][e] + bias); ss += o[e] * o[e]; }
            acc[h * 4 + dt] = o; } }
    ss += __shfl_xor(ss, 16); ss += __shfl_xor(ss, 32);
    const float rstd = 1.0f / sqrtf(ss * (1.0f / 256.0f) + EPS);
    const float* gn = a.in[24] + (size_t)l * 1024;
#pragma unroll
    for (int h = 0; h < 4; ++h)
#pragma unroll
        for (int dt = 0; dt < 4; ++dt) { const int ch = 64 * h + 16 * dt + 4 * fq; const f32x4 gg = *(const f32x4*)(gn + ch);
            st4bf(ycat + tok * 1024 + ch, acc[h * 4 + dt] * rstd * gg); }
    __syncthreads();
}

__device__ __forceinline__ void sincos_red(float ang, float& sn, float& cs) {
    const float n = rintf(ang * 0.15915494309189535f);
    float r = fmaf(-n, 6.2831854820251465f, ang); r = fmaf(-n, -1.7484556e-7f, r);
    const float h = 0.5f * r, h2 = h * h;
    const float s = h * (1.0f + h2 * (-1.6666667e-1f + h2 * (8.3333333e-3f + h2 * (-1.9841270e-4f + h2 * (2.7557319e-6f + h2 * (-2.5052108e-8f))))));
    const float c = 1.0f + h2 * (-0.5f + h2 * (4.1666667e-2f + h2 * (-1.3888889e-3f + h2 * (2.4801587e-5f + h2 * (-2.7557319e-7f + h2 * 2.0876757e-9f)))));
    sn = 2.0f * s * c; cs = 1.0f - 2.0f * s * s;
}

template <int PASS>
__device__ __forceinline__ void s5_span(const bf16* zu, bf16* ygp, LAS float* BU, LAS bf16* Xs, const bf16x8 (&bfrag)[8], const bf16x8 (&cf)[4], f32x4 dd, float are, float aim, float& xr, float& xi, int lane) {
    const int p = lane, fr = lane & 15, fq = lane >> 4;
    bf16x8 uf_n = (bf16x8){0, 0, 0, 0, 0, 0, 0, 0}; u32x2 u4_n = (u32x2){0u, 0u};
    if (fq < 2) uf_n = *(const bf16x8*)(zu + 8 * fq);
    if (PASS == 2) u4_n = *(const u32x2*)(zu + 4 * fq);
    for (int blk = 0; blk < 16; ++blk) {
        const bf16x8 uf = uf_n; const u32x2 u4w = u4_n;
        if (blk < 15) { const bf16* zn = zu + (size_t)(16 * (blk + 1)) * PIN;
            if (fq < 2) uf_n = *(const bf16x8*)(zn + 8 * fq);
            if (PASS == 2) u4_n = *(const u32x2*)(zn + 4 * fq); }
#pragma unroll
        for (int n = 0; n < 8; ++n) { const f32x4 acc = __builtin_amdgcn_mfma_f32_16x16x32_bf16(bfrag[n], uf, (f32x4){0.f, 0.f, 0.f, 0.f}, 0, 0, 0);
            *(LAS f32x4*)(BU + fr * 132 + 16 * n + 4 * fq) = acc; }
        LDS_WAIT();
#pragma unroll
        for (int t = 0; t < 16; ++t) { const float bur = BU[t * 132 + p], bui = BU[t * 132 + 64 + p];
            const float tr = are * xr - aim * xi + bur, ti = are * xi + aim * xr + bui; xr = tr; xi = ti;
            if (PASS == 2) { const unsigned w = cvt_pk_bf16(xr, xi); Xs[t * 136 + p] = (bf16)(w & 0xffffu); Xs[t * 136 + 64 + p] = (bf16)(w >> 16); } }
        if (PASS == 2) {
            LDS_WAIT();
            f32x4 acc = (f32x4){0.f, 0.f, 0.f, 0.f};
#pragma unroll
            for (int ks = 0; ks < 4; ++ks) { const bf16x8 xf = *(const LAS bf16x8*)(Xs + fr * 136 + 32 * ks + 8 * fq);
                acc = __builtin_amdgcn_mfma_f32_16x16x32_bf16(cf[ks], xf, acc, 0, 0, 0); }
            const f32x4 u4 = (f32x4){bf_lo(u4w.x), bf_hi(u4w.x), bf_lo(u4w.y), bf_hi(u4w.y)}; f32x4 y;
#pragma unroll
            for (int e = 0; e < 4; ++e) y[e] = gelu_tanh(acc[e] + dd[e] * u4[e]);
            st4bf(ygp + (size_t)(16 * blk) * 256, y);
        }
        asm volatile("s_waitcnt lgkmcnt(0)" ::: );
    }
}
__device__ __forceinline__ void s5_wg_item(ArgsRef a, int l, int bi, LAS unsigned char* lds, int wave, int lane) {
    const int g = bi & 15, b = bi >> 4, p = lane, fr = lane & 15, fq = lane >> 4;
    const bf16* z = (const bf16*)(a.ws + WS_Z);
    const int lg = l * 16 + g;
    const float dt = expf(a.in[21][lg]);
    const float lre = a.in[14][(size_t)lg * 64 + p], lim = a.in[15][(size_t)lg * 64 + p];
    const float mag = expf(lre * dt); float sn, cs; sincos_red(lim * dt, sn, cs);
    const float are = mag * cs, aim = mag * sn, nr = are - 1.0f, ni = aim, den = lre * lre + lim * lim;
    const float kre = (nr * lre + ni * lim) / den, kim = (ni * lre - nr * lim) / den;
    bf16x8 bfrag[8];
#pragma unroll
    for (int nn = 0; nn < 4; ++nn) { const int pp = 16 * nn + fr; const float kr = __shfl(kre, pp), ki = __shfl(kim, pp);
        const float* brp = a.in[16] + ((size_t)lg * 64 + pp) * 16 + 8 * (fq & 1); const float* bip = a.in[17] + ((size_t)lg * 64 + pp) * 16 + 8 * (fq & 1);
        const f32x4 br0 = *(const f32x4*)brp, br1 = *(const f32x4*)(brp + 4), bi0 = *(const f32x4*)bip, bi1 = *(const f32x4*)(bip + 4);
        bf16x8 fre = pack8(br0 * kr - bi0 * ki, br1 * kr - bi1 * ki), fim = pack8(bi0 * kr + br0 * ki, bi1 * kr + br1 * ki);
        if (fq >= 2) { fre = (bf16x8){0, 0, 0, 0, 0, 0, 0, 0}; fim = fre; }
        bfrag[nn] = fre; bfrag[nn + 4] = fim; }
    const size_t tok0 = (size_t)b * 2048 + 256 * wave;
    const bf16* zu = z + (tok0 + fr) * PIN + 1536 + 16 * g;
    bf16* ygp = (bf16*)(a.ws + WS_YG) + (tok0 + fr) * 256 + 16 * g + 4 * fq;
    LAS float* BU = (LAS float*)(lds + wave * 12800);
    LAS bf16* Xs = (LAS bf16*)(lds + wave * 12800 + 8448);
    LAS float* EX = (LAS float*)(lds + 102400);
    bf16x8 cf[4]; f32x4 dd = (f32x4){0.f, 0.f, 0.f, 0.f};
#pragma unroll
    for (int ks = 0; ks < 4; ++ks) cf[ks] = (bf16x8){0, 0, 0, 0, 0, 0, 0, 0};
    float xr = 0.f, xi = 0.f;
    s5_span<1>(zu, ygp, BU, Xs, bfrag, cf, dd, are, aim, xr, xi, lane);
    EX[wave * 128 + p] = xr; EX[wave * 128 + 64 + p] = xi;
    __syncthreads();
    {   float Ar = are, Ai = aim;
#pragma unroll
        for (int q = 0; q < 8; ++q) { const float tr = Ar * Ar - Ai * Ai, ti = 2.0f * Ar * Ai; Ar = tr; Ai = ti; }
        xr = 0.f; xi = 0.f;
#pragma unroll
        for (int w = 0; w < 7; ++w) if (w < wave) { const float er = EX[w * 128 + p], ei = EX[w * 128 + 64 + p];
            const float tr = Ar * xr - Ai * xi + er, ti = Ar * xi + Ai * xr + ei; xr = tr; xi = ti; }
    }
#pragma unroll
    for (int ks = 0; ks < 4; ++ks) { const float* cp = (ks < 2 ? a.in[18] : a.in[19]) + ((size_t)lg * 16 + fr) * 64 + 32 * (ks & 1) + 8 * fq;
        f32x4 c0 = *(const f32x4*)cp, c1 = *(const f32x4*)(cp + 4); if (ks >= 2) { c0 = -c0; c1 = -c1; } cf[ks] = pack8(c0, c1); }
    dd = *(const f32x4*)(a.in[20] + (size_t)l * 256 + 16 * g + 4 * fq);
    s5_span<2>(zu, ygp, BU, Xs, bfrag, cf, dd, are, aim, xr, xi, lane);
    __syncthreads();
}

__device__ __forceinline__ void poolconv_item(ArgsRef a, int l, int idx, int lane) {
    const bf16* z = (const bf16*)(a.ws + WS_Z); bf16* ycat = (bf16*)(a.ws + WS_YCAT);
    const int tokb = idx * 8, pos0 = tokb & 2047, ch = 4 * lane, gq = lane >> 4, wq = 2 << gq;
    const float m1 = gq >= 1 ? 1.0f : 0.0f, m2 = gq >= 2 ? 1.0f : 0.0f, m3 = gq >= 3 ? 1.0f : 0.0f;
    const float* gn = a.in[24] + (size_t)l * 1024;
    {   f32x4 row[23];
        const bf16* zp = z + (size_t)tokb * PIN + 512 + ch;
#pragma unroll
        for (int r = 0; r < 23; ++r) { row[r] = (f32x4){0.f, 0.f, 0.f, 0.f}; if (pos0 - 15 + r >= 0) row[r] = ld4bf(zp + (ptrdiff_t)(r - 15) * PIN); }
        const f32x4 gg = *(const f32x4*)(gn + 256 + ch);
#pragma unroll
        for (int tt = 0; tt < 8; ++tt) {
            f32x4 sum = row[15 + tt] + row[14 + tt];
            sum += (row[13 + tt] + row[12 + tt]) * m1;
            sum += ((row[11 + tt] + row[10 + tt]) + (row[9 + tt] + row[8 + tt])) * m2;
            sum += (((row[7 + tt] + row[6 + tt]) + (row[5 + tt] + row[4 + tt])) + ((row[3 + tt] + row[2 + tt]) + (row[1 + tt] + row[tt]))) * m3;
            const int pos = pos0 + tt, cnt = (pos + 1 < wq) ? pos + 1 : wq;
            const f32x4 o = sum * (1.0f / (float)cnt) - row[15 + tt];
            const float ss = wave_sum((o[0] * o[0] + o[1] * o[1]) + (o[2] * o[2] + o[3] * o[3]));
            const float rstd = 1.0f / sqrtf(ss * (1.0f / 256.0f) + EPS);
            st4bf(ycat + (size_t)(tokb + tt) * 1024 + 256 + ch, o * rstd * gg); }
    }
    {   f32x4 prod[10], bg[8];
        const bf16* zp = z + (size_t)tokb * PIN + 768 + ch;
#pragma unroll
        for (int r = 0; r < 10; ++r) { prod[r] = (f32x4){0.f, 0.f, 0.f, 0.f}; if (pos0 - 2 + r >= 0) prod[r] = ld4bf(zp + (ptrdiff_t)(r - 2) * PIN + 256) * ld4bf(zp + (ptrdiff_t)(r - 2) * PIN + 512); }
#pragma unroll
        for (int tt = 0; tt < 8; ++tt) bg[tt] = ld4bf(zp + (size_t)tt * PIN);
        const f32x4 w0 = *(const f32x4*)(a.in[13] + ((size_t)l * 3 + 0) * 256 + ch), w1 = *(const f32x4*)(a.in[13] + ((size_t)l * 3 + 1) * 256 + ch), w2 = *(const f32x4*)(a.in[13] + ((size_t)l * 3 + 2) * 256 + ch);
        const f32x4 gg = *(const f32x4*)(gn + 512 + ch);
#pragma unroll
        for (int tt = 0; tt < 8; ++tt) {
            const f32x4 o = bg[tt] * (w0 * prod[tt] + w1 * prod[tt + 1] + w2 * prod[tt + 2]);
            const float ss = wave_sum((o[0] * o[0] + o[1] * o[1]) + (o[2] * o[2] + o[3] * o[3]));
            const float rstd = 1.0f / sqrtf(ss * (1.0f / 256.0f) + EPS);
            st4bf(ycat + (size_t)(tokb + tt) * 1024 + 512 + ch, o * rstd * gg); }
    }
}

__device__ __forceinline__ void glu_item(ArgsRef a, int l, int it, LAS unsigned char* lds, int tid, int wave, int lane) {
    const bf16* yg = (const bf16*)(a.ws + WS_YG) + (size_t)it * 64 * 256; bf16* ycat = (bf16*)(a.ws + WS_YCAT) + (size_t)it * 64 * 1024 + 768;
    const bf16* Bt = (const bf16*)(a.ws + WS_W + (size_t)l * LW + OW_GLU);
    LAS unsigned char* T = lds;
    LAS float* P = (LAS float*)(lds + 34816);
    const int fr = lane & 15, fq = lane >> 4, n0 = 32 * wave;
    u32x4 st[4];
#pragma unroll
    for (int j = 0; j < 4; ++j) { const int idx = tid + 512 * j; st[j] = *(const u32x4*)(yg + (size_t)(idx >> 5) * 256 + 8 * (idx & 31)); }
    bf16x8 bfr[2][8];
#pragma unroll
    for (int nt = 0; nt < 2; ++nt)
#pragma unroll
        for (int ks = 0; ks < 8; ++ks) bfr[nt][ks] = *(const bf16x8*)(Bt + (size_t)(n0 + 16 * nt + fr) * 256 + 32 * ks + 8 * fq);
#pragma unroll
    for (int j = 0; j < 4; ++j) { const int idx = tid + 512 * j; *(LAS u32x4*)(T + (idx >> 5) * 528 + 16 * (idx & 31)) = st[j]; }
    __syncthreads();
    f32x4 acc[4][2];
#pragma unroll
    for (int tt = 0; tt < 4; ++tt) { acc[tt][0] = (f32x4){0.f, 0.f, 0.f, 0.f}; acc[tt][1] = acc[tt][0]; }
#pragma unroll
    for (int ks = 0; ks < 8; ++ks)
#pragma unroll
        for (int tt = 0; tt < 4; ++tt) { const bf16x8 af = *(const LAS bf16x8*)(T + (16 * tt + fr) * 528 + (32 * ks + 8 * fq) * 2);
            acc[tt][0] = __builtin_amdgcn_mfma_f32_16x16x32_bf16(bfr[0][ks], af, acc[tt][0], 0, 0, 0);
            acc[tt][1] = __builtin_amdgcn_mfma_f32_16x16x32_bf16(bfr[1][ks], af, acc[tt][1], 0, 0, 0); }
    const f32x4 gb0 = *(const f32x4*)(a.in[23] + (size_t)l * 256 + n0 + 4 * fq), gb1 = *(const f32x4*)(a.in[23] + (size_t)l * 256 + n0 + 16 + 4 * fq);
#pragma unroll
    for (int tt = 0; tt < 4; ++tt) { float ss = 0.f;
#pragma unroll
        for (int nt = 0; nt < 2; ++nt) { const u32x2 yw = *(const LAS u32x2*)(T + (16 * tt + fr) * 528 + (n0 + 16 * nt + 4 * fq) * 2);
            const f32x4 y = (f32x4){bf_lo(yw.x), bf_hi(yw.x), bf_lo(yw.y), bf_hi(yw.y)}; const f32x4 g4 = nt ? gb1 : gb0; f32x4 o;
#pragma unroll
            for (int e = 0; e < 4; ++e) { o[e] = y[e] * pg8::sigmoid_f(acc[tt][nt][e] + g4[e]); ss += o[e] * o[e]; }
            acc[tt][nt] = o; }
        ss += __shfl_xor(ss, 16); ss += __shfl_xor(ss, 32);
        if (fq == 0) P[(16 * tt + fr) * 8 + wave] = ss; }
    __syncthreads();
    const float* gn = a.in[24] + (size_t)l * 1024 + 768;
    const f32x4 gg0 = *(const f32x4*)(gn + n0 + 4 * fq), gg1 = *(const f32x4*)(gn + n0 + 16 + 4 * fq);
#pragma unroll
    for (int tt = 0; tt < 4; ++tt) { const int t = 16 * tt + fr; const f32x4 p0 = *(const LAS f32x4*)(P + t * 8), p1 = *(const LAS f32x4*)(P + t * 8 + 4);
        const float rstd = __builtin_amdgcn_rsqf((((p0[0] + p0[1]) + (p0[2] + p0[3])) + ((p1[0] + p1[1]) + (p1[2] + p1[3]))) * (1.0f / 256.0f) + EPS);
        st4bf(ycat + (size_t)t * 1024 + n0 + 4 * fq, acc[tt][0] * rstd * gg0); st4bf(ycat + (size_t)t * 1024 + n0 + 16 + 4 * fq, acc[tt][1] * rstd * gg1); }
    __syncthreads();
}

#define XB_TMO      128
#define XB_XCNT(j)  (256  + 64 * (j))
#define XB_XSUB(j)  (1280 + 64 * (j))
#define XB_XGEN(j)  (2304 + 64 * (j))
#define XB_TOP      3328
#define XB_TOPGEN   3392
#define XCD_BAR_WORDS 3456
#define XB_SPIN_CAP (1u << 18)

__device__ __forceinline__ unsigned xb_ld(unsigned* p)              { return __hip_atomic_load(p, __ATOMIC_RELAXED, __HIP_MEMORY_SCOPE_AGENT); }
__device__ __forceinline__ unsigned xb_add(unsigned* p, unsigned v) { return __hip_atomic_fetch_add(p, v, __ATOMIC_RELAXED, __HIP_MEMORY_SCOPE_AGENT); }
__device__ __forceinline__ unsigned xb_xcc_id() { return (unsigned)__builtin_amdgcn_s_getreg((3 << 11) | 20) & 0xFu; }
#define XB_SPIN(cond, bar) do { unsigned _sp = 0; while (cond) { __builtin_amdgcn_s_sleep(1); \
    if ((++_sp & 255u) == 0u) { if (xb_ld(&(bar)[XB_TMO])) break; if (_sp > XB_SPIN_CAP) { atomicAdd(&(bar)[XB_TMO], 1u); break; } } } } while (0)

struct XcdBarrier {
    unsigned* bar; unsigned x;
    volatile LAS unsigned* st;
};

__device__ __forceinline__ XcdBarrier xcd_barrier_post(unsigned* bar, volatile LAS unsigned* st) {
    XcdBarrier b; b.bar = bar; b.x = xb_xcc_id(); b.st = st;
    if (threadIdx.x == 0) (void)xb_add(&bar[XB_XCNT(b.x)], 1u);
    return b;
}
__device__ __forceinline__ void xcd_barrier_complete(unsigned* bar, unsigned x, unsigned& nloc, unsigned& nx) {
    const unsigned G = gridDim.x * gridDim.y * gridDim.z;
    unsigned sum, cnt, mine, sp = 0u;
    for (;;) {
        sum = 0u; cnt = 0u; mine = 0u;
#pragma unroll 1
        for (unsigned j = 0; j < 16; ++j) { const unsigned c = xb_ld(&bar[XB_XCNT(j)]); sum += c; cnt += (c > 0u) ? 1u : 0u; mine = (j == x) ? c : mine; }
        if (sum == G) break;
        __builtin_amdgcn_s_sleep(1);
        if ((++sp & 255u) == 0u) { if (xb_ld(&bar[XB_TMO])) break; if (sp > XB_SPIN_CAP) { atomicAdd(&bar[XB_TMO], 1u); break; } }
    }
    nloc = mine > 0u ? mine : 1u; nx = cnt > 0u ? cnt : 1u;
}

__device__ __forceinline__ void xcd_barrier(const XcdBarrier& b) {
    asm volatile("s_waitcnt vmcnt(0)" ::: "memory");
    __syncthreads();
    if (threadIdx.x == 0) {
        unsigned* bar = b.bar;
        __builtin_amdgcn_s_waitcnt(0);
        unsigned nloc = b.st[0], nx = b.st[1];
        if (nloc == 0u) { xcd_barrier_complete(bar, b.x, nloc, nx); b.st[0] = nloc; b.st[1] = nx; }
        const unsigned old = xb_add(&bar[XB_XSUB(b.x)], 1u);
        const unsigned gen = old / nloc;
        if (old + 1u == (gen + 1u) * nloc) {
            __builtin_amdgcn_fence(__ATOMIC_RELEASE, "agent");
            asm volatile("s_waitcnt vmcnt(0)" ::: "memory");
            const unsigned og = xb_add(&bar[XB_TOP], 1u);
            const unsigned tg = og / nx;
            if (og + 1u == (tg + 1u) * nx) xb_add(&bar[XB_TOPGEN], 1u);
            else XB_SPIN(xb_ld(&bar[XB_TOPGEN]) == tg, bar);
            __builtin_amdgcn_fence(__ATOMIC_ACQUIRE, "agent");
            xb_add(&bar[XB_XGEN(b.x)], 1u);
            asm volatile("s_waitcnt vmcnt(0)" ::: "memory");
        } else {
            XB_SPIN(xb_ld(&bar[XB_XGEN(b.x)]) == gen, bar);
            __builtin_amdgcn_fence(__ATOMIC_ACQUIRE, "agent");
            asm volatile("s_waitcnt vmcnt(0)" ::: "memory");
        }
    }
    __syncthreads();
}

#ifndef SYNC_REP
#define SYNC_REP 1
#endif
#ifndef REP_MASK
#define REP_MASK 0
#endif
#ifndef PHM
#define PHM 0xfff
#endif
#ifndef PER_PHASE_LAUNCH
#define PER_PHASE_LAUNCH 0
#endif
__global__ void __launch_bounds__(512) mega(Args a_) {
    extern __shared__ __attribute__((aligned(16))) unsigned char lds_raw[];
    LAS unsigned char* lds = (LAS unsigned char*)lds_raw;
    const int G = gridDim.x, NGW = G * 8;
    const int ph_lo = a_.ph_lo, ph_hi = a_.ph_hi;
    const bool multi = (ph_hi - ph_lo) > 1;
    unsigned char* const ws0 = a_.ws;
    volatile LAS unsigned* MISC = (volatile LAS unsigned*)(lds + 131072 + 320);
    if (threadIdx.x < 32) MISC[threadIdx.x] = 0u;
    __syncthreads();
    XcdBarrier bar; bar.bar = (unsigned*)(ws0 + WS_BAR); bar.x = 0; bar.st = nullptr;
    if (multi) bar = xcd_barrier_post((unsigned*)(ws0 + WS_BAR), MISC + 8);
    if (ph_lo < 0) cg::this_grid().sync();
    unsigned long long tacc = 0ull;
    for (int ph = ph_lo; ph < ph_hi; ++ph) {
        const unsigned long long tph0 = TPROBE ? __builtin_amdgcn_s_memrealtime() : 0ull;
        int tid = threadIdx.x; asm volatile("" : "+v"(tid));
        const int lane = tid & 63, wave = __builtin_amdgcn_readfirstlane(tid >> 6), gw = blockIdx.x * 8 + wave;
        const Args __attribute__((address_space(4)))* ap = (const Args __attribute__((address_space(4)))*)__builtin_amdgcn_kernarg_segment_ptr(); asm volatile("" : "+s"(ap));
        ArgsRef a = *ap;
        unsigned char* ws = a.ws;
        float* cond = (float*)(ws + WS_COND); float* SS = (float*)(ws + WS_SS); const float* SHW = (const float*)(ws + WS_SHW);
        bf16* H = (bf16*)(ws + WS_H); bf16* ACT = (bf16*)(ws + WS_ACT); bf16* Z = (bf16*)(ws + WS_Z); bf16* YG = (bf16*)(ws + WS_YG); bf16* YCAT = (bf16*)(ws + WS_YCAT);
        if (ph == 0) { for (int rp = 0; rp < PREP_REP; ++rp) { if (rp) { XcdBarrier b3 = bar; asm volatile("" : "+s"(b3.bar)); xcd_barrier(b3); } prep_phase(a, lds, tid, wave, lane, G); } }
        else if (ph == 1) norm_phase(a.in[0], a.in[4], cond, cond + 1024, H, (bf16*)(ws + WS_XB), gw, NGW, lane);
        else {
            const int l = (ph - 2) / NSLOT, slot = (ph - 2) % NSLOT, s = (int)((SLOT_MAP >> (4 * slot)) & 15ull); const bool rep = ((SLOT_REP >> slot) & 1u) != 0u;
            unsigned char* wl = ws + WS_W + (size_t)l * LW;
            const float* cl = cond + (size_t)l * 8 * NCOND;
            if ((PHM & 8) && (s == 0 || s == 7)) {
                pg8::Gemm gm{H, (const bf16*)(wl + (s == 0 ? OW_IN1 : OW_IN2)), M, 2 * DFF, D}; pg8::StaticOrder S; S.init(M, 2 * DFF, G, (int)blockIdx.x);
                pg8::EpiSwiglu E{ACT, DFF};
                pg8::gemm_phase<pg8::EpiSwiglu, pg8::StaticOrder>(lds, gm, S, E, nullptr, tid);
            } else if ((PHM & 16) && (s == 1 || s == 6 || s == 8)) {
                const bf16* A = (s == 6) ? YCAT : ACT; const int K = (s == 6) ? D : DFF;
                const bf16* Bt = (const bf16*)(wl + (s == 1 ? OW_OUT1 : (s == 6 ? OW_MO : OW_OUT2)));
                pg8::Gemm gm{A, Bt, M, D, K}; pg8::StaticOrder S; S.init(M, D, G, (int)blockIdx.x);
                bf16* XB = (bf16*)(ws + WS_XB);
                const float* gnext = (s == 1) ? a.in[7] + (size_t)l * D : (s == 6 ? a.in[26] + (size_t)l * D : (l == NL - 1 ? a.in[29] : a.in[4] + (size_t)(l + 1) * D));
                const float* shnext = (s == 1) ? cl + 3 * 1024 : (s == 6 ? cl + 6 * 1024 : cl + (size_t)8 * NCOND);
                const float* scnext = shnext + 1024;
                bf16* xa = (s == 8 && l == NL - 1) ? (bf16*)nullptr : H;
                const float gs = __builtin_bit_cast(float, __builtin_amdgcn_readfirstlane(s == 6 ? 0x3f800000 : 0x3f000000));
                const unsigned need = 32u * (unsigned)(l * 3 + (s == 1 ? 0 : (s == 6 ? 1 : 2)) + 1);
                pg8::EpiResid E{XB, XB, a.out, cl + (s == 1 ? 2 : (s == 6 ? 5 : 8)) * 1024, gnext, scnext, shnext, xa, (unsigned*)(ws + WS_SS), (unsigned*)(ws + WS_BAR + 16384), gs, need};
                pg8::gemm_phase<pg8::EpiResid, pg8::StaticOrder>(lds, gm, S, E, nullptr, tid);
            } else if ((PHM & 32) && s == 2) {
                pg8::Gemm gm{H, (const bf16*)(wl + OW_MIX), M, PIN, D}; pg8::StaticOrder S; S.init(M, PIN, G, (int)blockIdx.x);
                pg8::EpiZ E{Z, PIN};
                pg8::gemm_phase<pg8::EpiZ, pg8::StaticOrder>(lds, gm, S, E, nullptr, tid);
            } else if ((PHM & 64) && s == 3) {
                int w_first = gw, w_stride = NGW;
                if (G >= 256) { w_first = (blockIdx.x < 128) ? blockIdx.x * 8 + wave : 2048; w_stride = 1024; }
                for (int it = blockIdx.x; it < 256; it += G) { if (it < 128) { for (int rq = 0; rq < SGU_REP; ++rq) sgu_item(a, l, it, lds, tid, wave, lane); } else { for (int rq = 0; rq < S5_REP; ++rq) s5_wg_item(a, l, it - 128, lds, wave, lane); } }
                for (int rq = 0; rq < PC_REP; ++rq) for (int idx = w_first; idx < 2048; idx += w_stride) poolconv_item(a, l, idx, lane);
            } else if ((PHM & 256) && s == 5) {
                for (int it = blockIdx.x; it < M / 64; it += G) glu_item(a, l, it, lds, tid, wave, lane);
            }
        }
        if (ph + 1 < ph_hi) { XcdBarrier b2 = bar; asm volatile("" : "+s"(b2.bar)); xcd_barrier(b2); }
        if (TPROBE) { int ty; if (ph == 0) ty = 0; else if (ph == 1) ty = 1; else { const int s_ = (int)((SLOT_MAP >> (4 * ((ph - 2) % NSLOT))) & 15ull); ty = (s_ == 0 || s_ == 7) ? 2 : ((s_ == 1 || s_ == 6 || s_ == 8) ? 3 : (s_ == 2 ? 4 : (s_ == 3 ? 5 : 6))); }
            if ((TPROBE >> ty) & 1) tacc += __builtin_amdgcn_s_memrealtime() - tph0; }
    }
    if (TPROBE) { const unsigned long long te = __builtin_amdgcn_s_memrealtime(); while (__builtin_amdgcn_s_memrealtime() - te < tacc) __builtin_amdgcn_s_sleep(8); }
}

extern "C" void kernel_launch(void* const* d_in, const int* in_sizes, int n_in, void* d_out, int out_size, void* d_ws, size_t ws_size, hipStream_t stream) {
    static int grid = 0;
    if (grid == 0) {
        int dev = 0, cus = 0;
        if (n_in != 30 || ws_size < WS_END || hipGetDevice(&dev) != hipSuccess || hipDeviceGetAttribute(&cus, hipDeviceAttributeMultiprocessorCount, dev) != hipSuccess) { grid = -1; return; }
        if (hipFuncSetAttribute((const void*)mega, hipFuncAttributeMaxDynamicSharedMemorySize, LDS_BYTES) != hipSuccess) { grid = -1; return; }
        int per_cu = 0;
        if (hipOccupancyMaxActiveBlocksPerMultiprocessor(&per_cu, (const void*)mega, 512, LDS_BYTES) != hipSuccess || per_cu < 1) per_cu = 1;
        (void)hipGetLastError();
        grid = cus;
    }
    if (grid < 0) return;
    Args a{};
    for (int i = 0; i < 30; ++i) a.in[i] = (const float*)d_in[i];
    a.out = (float*)d_out; a.ws = (unsigned char*)d_ws;
#if PER_PHASE_LAUNCH
    for (int ph = 0; ph < NPH; ++ph) { a.ph_lo = ph; a.ph_hi = ph + 1; hipLaunchKernelGGL(mega, dim3(grid), dim3(512), LDS_BYTES, stream, a); }
#else
    (void)hipMemsetAsync((char*)d_ws + WS_BAR, 0, BAR_BYTES, stream);
    a.ph_lo = 0; a.ph_hi = NPH;
    void* args[] = {&a};
    (void)hipLaunchCooperativeKernel((const void*)mega, dim3(grid), dim3(512), args, LDS_BYTES, stream);
#endif
}
```
